# Optimizing an MI355X kernel written in HIP

```python
import jax, jax.numpy as jnp
from jax import lax
import numpy as np

D_MODEL = 1024
BATCH = 4
SEQ = 4096
DEPTH = 2

GRID_W = 64
CTX_LEN = 256
GROUP_W = D_MODEL // 4
HEAD_DIM = 64
N_HEADS_GROUP = GROUP_W // HEAD_DIM
SC_KERNEL = 3
MLA_Q_RANK = 256
MLA_KV_RANK = 128
MLA_NOPE = 64
MLA_ROPE = 32
MLA_V = 64
MLA_SCALE = (MLA_NOPE + MLA_ROPE) ** -0.5
Q_BLOCK = 128
CF_KERNEL = 31
NA_ROWS = 8
NA_COLS = 16
NA_SCALE = HEAD_DIM ** -0.5
ROPE_BASE = 10000.0
MLP_HIDDEN = 4 * D_MODEL
N_MOD = 6
EPS = 1e-6

SC_END = 3 * GROUP_W
MLA_Q_END = SC_END + MLA_Q_RANK
MLA_KV_END = MLA_Q_END + MLA_KV_RANK + MLA_ROPE
CF_END = MLA_KV_END + 2 * GROUP_W
NA_Q_END = CF_END + GROUP_W
P_IN = NA_Q_END + 2 * GROUP_W

kernel_name = "hybrid_parallel_groups_dit_block"


def rmsnorm(x, g):
    xf = x.astype(jnp.float32)
    y = xf * lax.rsqrt(jnp.mean(xf * xf, axis=-1, keepdims=True) + EPS)
    return y.astype(x.dtype) * g


def layernorm(x, g, b):
    xf = x.astype(jnp.float32)
    mu = jnp.mean(xf, axis=-1, keepdims=True)
    var = jnp.mean(jnp.square(xf - mu), axis=-1, keepdims=True)
    return ((xf - mu) * lax.rsqrt(var + EPS)).astype(x.dtype) * g + b


def dwconv(x, w):
    k = w.shape[0]
    return lax.conv_general_dilated(
        x, w[:, None, :], window_strides=(1,), padding=[(k // 2, k // 2)],
        dimension_numbers=("NWC", "WIO", "NWC"), feature_group_count=x.shape[-1])


def heads(t):
    return t.reshape(*t.shape[:-1], N_HEADS_GROUP, -1)


def rope_rotate(x, ang):
    x1, x2 = jnp.split(x, 2, axis=-1)
    cos, sin = jnp.cos(ang).astype(x.dtype), jnp.sin(ang).astype(x.dtype)
    return jnp.concatenate([x1 * cos - x2 * sin, x1 * sin + x2 * cos], axis=-1)


def axial_rope(x, ang_row, ang_col):
    xr, xc = jnp.split(x, 2, axis=-1)
    return jnp.concatenate([rope_rotate(xr, ang_row), rope_rotate(xc, ang_col)], axis=-1)


def short_conv_mixer(u_sc, w_sc):
    x_in, b_gate, c_gate = jnp.split(u_sc, 3, axis=-1)
    return b_gate * dwconv(c_gate * x_in, w_sc)


def conformer_conv_mixer(u_cf, w_dw, b_dw, ln_g, ln_b, w_pw):
    a, g = jnp.split(u_cf, 2, axis=-1)
    y = dwconv(a * jax.nn.sigmoid(g), w_dw) + b_dw
    return jax.nn.silu(layernorm(y, ln_g, ln_b)) @ w_pw


def mla_queries(cq, g_q, w_uq):
    q = heads(rmsnorm(cq, g_q) @ w_uq)
    return q[..., :MLA_NOPE], q[..., MLA_NOPE:]


def mla_keys_values(u_kv, g_kv, w_ukv):
    ckv, k_rope = u_kv[..., :MLA_KV_RANK], u_kv[..., MLA_KV_RANK:]
    kv = heads(rmsnorm(ckv, g_kv) @ w_ukv)
    return kv[..., :MLA_NOPE], k_rope, kv[..., MLA_NOPE:]


def mla_attend(qn, qr, kn, kr, v):
    s = (jnp.einsum("bqhd,bkhd->bhqk", qn, kn)
         + jnp.einsum("bqhr,bkr->bhqk", qr, kr)) * MLA_SCALE
    p = jax.nn.softmax(s.astype(jnp.float32), axis=-1).astype(v.dtype)
    return jnp.einsum("bhqk,bkhd->bqhd", p, v)


def mla_latent(qn, qr, kn, kr, v):
    b, l = qn.shape[:2]
    nb = l // Q_BLOCK

    def to_blocks(t):
        return jnp.moveaxis(t.reshape(b, nb, Q_BLOCK, *t.shape[2:]), 1, 0)

    out = lax.map(lambda qs: mla_attend(qs[0], qs[1], kn, kr, v), (to_blocks(qn), to_blocks(qr)))
    return jnp.moveaxis(out, 0, 1).reshape(b, l, -1)


def dense_attend(q, k, v):
    s = jnp.einsum("bqhd,bkhd->bhqk", q, k) * NA_SCALE
    p = jax.nn.softmax(s.astype(jnp.float32), axis=-1).astype(v.dtype)
    o = jnp.einsum("bhqk,bkhd->bqhd", p, v)
    return o.reshape(*o.shape[:2], -1)


def neighbourhood_attend(q, k, v, k_c, v_c, rpb):
    b, l, h, dh = q.shape
    rows = l // GRID_W
    wh = min(NA_ROWS, rows)
    r = jnp.arange(rows)
    row_idx = jnp.clip(r - wh // 2, 0, rows - wh)[:, None] + jnp.arange(wh)[None, :]
    col = jnp.arange(GRID_W)
    col_start = jnp.clip(col - NA_COLS // 2, 0, GRID_W - NA_COLS)
    in_win = (col[None, :] >= col_start[:, None]) & (col[None, :] < col_start[:, None] + NA_COLS)
    off_r = row_idx - r[:, None] + (NA_ROWS - 1)
    off_c = jnp.clip(col[None, :] - col[:, None] + (NA_COLS - 1), 0, 2 * NA_COLS - 2)
    bias = rpb[:, off_r[:, None, :, None], off_c[None, :, None, :]]

    qg = q.reshape(b, rows, GRID_W, h, dh)
    kw = k.reshape(b, rows, GRID_W, h, dh)[:, row_idx]
    vw = v.reshape(b, rows, GRID_W, h, dh)[:, row_idx]
    s_loc = (jnp.einsum("brqhd,brikhd->bhrqik", qg, kw).astype(jnp.float32) * NA_SCALE
             + bias.astype(jnp.float32)[None])
    s_loc = jnp.where(in_win[:, None, :], s_loc, -jnp.inf)
    s_ctx = jnp.einsum("brqhd,bchd->bhrqc", qg, k_c).astype(jnp.float32) * NA_SCALE
    n_loc = wh * GRID_W
    p = jax.nn.softmax(
        jnp.concatenate([s_loc.reshape(b, h, rows, GRID_W, n_loc), s_ctx], axis=-1),
        axis=-1).astype(v.dtype)
    out = (jnp.einsum("bhrqik,brikhd->brqhd",
                      p[..., :n_loc].reshape(b, h, rows, GRID_W, wh, GRID_W), vw)
           + jnp.einsum("bhrqc,bchd->brqhd", p[..., n_loc:], v_c))
    return out.reshape(b, l, h * dh)


def sq_relu_mlp(h, w1, w2):
    return jnp.square(jax.nn.relu(h @ w1)) @ w2


def trunk_layer(x, xc, mod, mod_c, p, ang_row, ang_col, last):
    sh1, sc1, ga1, sh2, sc2, ga2 = mod
    sh1c, sc1c, ga1c, sh2c, sc2c, ga2c = mod_c
    w_in = p["w_in"]

    h = rmsnorm(x, p["g_pre_mix"]) * (1 + sc1) + sh1
    hc = rmsnorm(xc, p["g_pre_mix"]) * (1 + sc1c) + sh1c
    u = h @ w_in
    if last:
        uc_mla_kv = hc @ w_in[:, MLA_Q_END:MLA_KV_END]
        uc_na_kv = hc @ w_in[:, NA_Q_END:]
    else:
        uc = hc @ w_in
        uc_mla_kv, uc_na_kv = uc[..., MLA_Q_END:MLA_KV_END], uc[..., NA_Q_END:]

    kn_c, kr_c, v_c = mla_keys_values(uc_mla_kv, p["g_kv"], p["w_ukv"])
    nk_c, nv_c = (heads(t) for t in jnp.split(uc_na_kv, 2, axis=-1))

    y_sc = short_conv_mixer(u[..., :SC_END], p["w_sc"])
    qn, qr = mla_queries(u[..., SC_END:MLA_Q_END], p["g_q"], p["w_uq"])
    qr = axial_rope(qr, ang_row[:, None], ang_col[:, None])
    kn, kr, v = mla_keys_values(u[..., MLA_Q_END:MLA_KV_END], p["g_kv"], p["w_ukv"])
    kr = axial_rope(kr, ang_row, ang_col)
    y_mla = mla_latent(qn, qr, jnp.concatenate([kn, kn_c], axis=1),
                       jnp.concatenate([kr, kr_c], axis=1), jnp.concatenate([v, v_c], axis=1))
    y_cf = conformer_conv_mixer(u[..., MLA_KV_END:CF_END], p["cf_w_dw"], p["cf_b_dw"],
                                p["cf_ln_g"], p["cf_ln_b"], p["cf_w_pw"])
    nq, nk, nv = (heads(t) for t in jnp.split(u[..., CF_END:], 3, axis=-1))
    y_na = neighbourhood_attend(nq, nk, nv, nk_c, nv_c, p["na_rpb"])
    y = jnp.concatenate([y_sc, y_mla, y_cf, y_na], axis=-1) @ p["w_out"]
    x = x + ga1 * rmsnorm(y, p["g_post_mix"])

    if not last:
        yc_sc = short_conv_mixer(uc[..., :SC_END], p["w_sc"])
        qn_c, qr_c = mla_queries(uc[..., SC_END:MLA_Q_END], p["g_q"], p["w_uq"])
        yc_mla = mla_attend(qn_c, qr_c, kn_c, kr_c, v_c)
        yc_mla = yc_mla.reshape(*yc_mla.shape[:2], -1)
        yc_cf = conformer_conv_mixer(uc[..., MLA_KV_END:CF_END], p["cf_w_dw"], p["cf_b_dw"],
                                     p["cf_ln_g"], p["cf_ln_b"], p["cf_w_pw"])
        yc_na = dense_attend(heads(uc[..., CF_END:NA_Q_END]), nk_c, nv_c)
        yc = jnp.concatenate([yc_sc, yc_mla, yc_cf, yc_na], axis=-1) @ p["w_out"]
        xc = xc + ga1c * rmsnorm(yc, p["g_post_mix"])

    hm = rmsnorm(x, p["g_pre_mlp"]) * (1 + sc2) + sh2
    x = x + ga2 * rmsnorm(sq_relu_mlp(hm, p["w_mlp1"], p["w_mlp2"]), p["g_post_mlp"])
    if not last:
        hmc = rmsnorm(xc, p["g_pre_mlp"]) * (1 + sc2c) + sh2c
        xc = xc + ga2c * rmsnorm(sq_relu_mlp(hmc, p["w_mlp1"], p["w_mlp2"]), p["g_post_mlp"])
    return x, xc


def setup_inputs(seed: int = 0) -> dict:
    key = jax.random.key(seed)
    ks = jax.random.split(key, 25)
    f32 = jnp.float32

    def nrm(k, shape, s):
        return jax.random.normal(k, shape, f32) * s

    def gain(k, shape):
        return 1.0 + 0.1 * jax.random.normal(k, shape, f32)

    L, H = DEPTH, N_HEADS_GROUP
    return {
        "x": nrm(ks[0], (BATCH, SEQ, D_MODEL), 1.0),
        "c": nrm(ks[1], (BATCH, D_MODEL), 1.0),
        "ctx": nrm(ks[2], (BATCH, CTX_LEN, D_MODEL), 1.0),
        "c_ctx": nrm(ks[3], (D_MODEL,), 1.0),
        "w_mod": nrm(ks[4], (L, D_MODEL, N_MOD * D_MODEL), 0.5 * D_MODEL ** -0.5),
        "b_mod": nrm(ks[5], (L, N_MOD * D_MODEL), 0.02),
        "g_pre_mix": gain(ks[6], (L, D_MODEL)),
        "w_in": nrm(ks[7], (L, D_MODEL, P_IN), D_MODEL ** -0.5),
        "w_sc": nrm(ks[8], (L, SC_KERNEL, GROUP_W), SC_KERNEL ** -0.5),
        "g_q": gain(ks[9], (L, MLA_Q_RANK)),
        "w_uq": nrm(ks[10], (L, MLA_Q_RANK, H * (MLA_NOPE + MLA_ROPE)), MLA_Q_RANK ** -0.5),
        "g_kv": gain(ks[11], (L, MLA_KV_RANK)),
        "w_ukv": nrm(ks[12], (L, MLA_KV_RANK, H * (MLA_NOPE + MLA_V)), MLA_KV_RANK ** -0.5),
        "cf_w_dw": nrm(ks[13], (L, CF_KERNEL, GROUP_W), CF_KERNEL ** -0.5),
        "cf_b_dw": nrm(ks[14], (L, GROUP_W), 0.02),
        "cf_ln_g": gain(ks[15], (L, GROUP_W)),
        "cf_ln_b": nrm(ks[16], (L, GROUP_W), 0.02),
        "cf_w_pw": nrm(ks[17], (L, GROUP_W, GROUP_W), GROUP_W ** -0.5),
        "na_rpb": nrm(ks[18], (L, H, 2 * NA_ROWS - 1, 2 * NA_COLS - 1), 0.1),
        "w_out": nrm(ks[19], (L, D_MODEL, D_MODEL), D_MODEL ** -0.5),
        "g_post_mix": gain(ks[20], (L, D_MODEL)),
        "g_pre_mlp": gain(ks[21], (L, D_MODEL)),
        "w_mlp1": nrm(ks[22], (L, D_MODEL, MLP_HIDDEN), D_MODEL ** -0.5),
        "w_mlp2": nrm(ks[23], (L, MLP_HIDDEN, D_MODEL), MLP_HIDDEN ** -0.5),
        "g_post_mlp": gain(ks[24], (L, D_MODEL)),
    }


def reference(x, c, ctx, c_ctx, w_mod, b_mod, g_pre_mix, w_in, w_sc, g_q, w_uq, g_kv, w_ukv,
              cf_w_dw, cf_b_dw, cf_ln_g, cf_ln_b, cf_w_pw, na_rpb, w_out, g_post_mix,
              g_pre_mlp, w_mlp1, w_mlp2, g_post_mlp):
    l = x.shape[1]
    pos = jnp.arange(l)
    n_freq = MLA_ROPE // 4
    inv_freq = ROPE_BASE ** (-jnp.arange(n_freq, dtype=jnp.float32) / n_freq)
    ang_row = (pos // GRID_W).astype(jnp.float32)[:, None] * inv_freq
    ang_col = (pos % GRID_W).astype(jnp.float32)[:, None] * inv_freq

    xc = ctx
    for i in range(DEPTH):
        mod = [m[:, None, :] for m in jnp.split(jax.nn.silu(c) @ w_mod[i] + b_mod[i], N_MOD, axis=-1)]
        mod_c = jnp.split(jax.nn.silu(c_ctx) @ w_mod[i] + b_mod[i], N_MOD, axis=-1)
        p = {
            "g_pre_mix": g_pre_mix[i], "w_in": w_in[i], "w_sc": w_sc[i],
            "g_q": g_q[i], "w_uq": w_uq[i], "g_kv": g_kv[i], "w_ukv": w_ukv[i],
            "cf_w_dw": cf_w_dw[i], "cf_b_dw": cf_b_dw[i], "cf_ln_g": cf_ln_g[i],
            "cf_ln_b": cf_ln_b[i], "cf_w_pw": cf_w_pw[i], "na_rpb": na_rpb[i],
            "w_out": w_out[i], "g_post_mix": g_post_mix[i], "g_pre_mlp": g_pre_mlp[i],
            "w_mlp1": w_mlp1[i], "w_mlp2": w_mlp2[i], "g_post_mlp": g_post_mlp[i],
        }
        x, xc = trunk_layer(x, xc, mod, mod_c, p, ang_row, ang_col, last=(i == DEPTH - 1))
    return x
```

```cpp
#include <hip/hip_runtime.h>
#include <cstdio>
#include <cstdint>
#include <hip/hip_cooperative_groups.h>
namespace pg8 {
#define PG8_LAS __attribute__((address_space(3)))
typedef unsigned short bf16_t;
typedef short bf16x8 __attribute__((ext_vector_type(8)));
typedef float f32x4 __attribute__((ext_vector_type(4)));
typedef unsigned u32x4 __attribute__((ext_vector_type(4)));
constexpr int BM = 256, BK = 64, HALF = 128, HTB = HALF * BK * 2  , STAGE_BYTES = 8 * HTB, NXCD = 8, WGM = 8;

__host__ __device__ __forceinline__ int lds_byte(int r, int c) { const int st = (r >> 4) * 2 + (c >> 5), rr = r & 15, cc = c & 31, ob = rr * 64 + cc * 2; return st * 1024 + (ob ^ (((ob >> 9) & 1) << 5)); }
__host__ __device__ __forceinline__ void stage_rc(int b, int& R, int& C) { const int st = b / 1024, sb = b % 1024, swz = sb ^ (((sb >> 9) & 1) << 5); R = (st >> 1) * 16 + swz / 64; C = (st & 1) * 32 + (swz % 64) / 2; }
__host__ __device__ __forceinline__ int perm32(int rho) { const int n = rho >> 4, i = rho & 15; return 8 * (i >> 2) + 4 * n + (i & 3); }

struct Unit { int pm, pn; };
struct Gemm { const bf16_t* A; const bf16_t* Bt; int M, N, K, lda; };

struct StaticOrder {
    int nM, nN, nwg, G, c;
    __host__ __device__ void init(int M, int N, int G_, int c_) { nM = M / BM; nN = N / BM; nwg = nM * nN; G = G_; c = c_; }
    __host__ __device__ bool next(int i, Unit& u) const {
        const long L = (long)i * G + c; if (L >= nwg) return false;
        int wgid = (int)L; { const int q = nwg / NXCD, r = nwg % NXCD, xcd = wgid % NXCD, off = wgid / NXCD; wgid = (xcd < r ? xcd * (q + 1) : r * (q + 1) + (xcd - r) * q) + off; }
        const int nig = WGM * nN, gid = wgid / nig, fm = gid * WGM, gsz = (nM - fm) < WGM ? (nM - fm) : WGM;
        u.pm = fm + ((wgid % nig) % gsz); u.pn = (wgid % nig) / gsz; return true;
    }
    __device__ __forceinline__ void a_ready(const Unit&) const {}
    __device__ __forceinline__ void done(const Unit&) const {}
};

__device__ __forceinline__ unsigned cvt_pk_bf16(float lo, float hi) { unsigned r; asm volatile("v_cvt_pk_bf16_f32 %0, %1, %2" : "=v"(r) : "v"(lo), "v"(hi)); return r; }
typedef float f32x2 __attribute__((ext_vector_type(2)));
struct EpiF32 {
    static constexpr bool PERM = false, AFTER_DRAIN = false;
    float* C; int ldc;
    __device__ __forceinline__ void operator()(const f32x4 (&acc)[2][2][4][2], const Unit& u, int wr, int wc, int fr, int fq) const {
        const int row0 = u.pm * BM + wr * 64 + fr, col0 = u.pn * BM + wc * 32 + 4 * fq;
#pragma unroll
        for (int ai = 0; ai < 2; ++ai)
#pragma unroll
            for (int m = 0; m < 4; ++m) { float* rowp = C + (size_t)(row0 + ai * HALF + m * 16) * ldc + col0;
#pragma unroll
                for (int bj = 0; bj < 2; ++bj)
#pragma unroll
                    for (int n = 0; n < 2; ++n) *(f32x4*)(rowp + bj * HALF + n * 16) = acc[ai][bj][m][n]; }
    }
};
struct EpiBf16 {
    static constexpr bool PERM = true, AFTER_DRAIN = false;
    bf16_t* O; int ldc; int ACT;
    __device__ __forceinline__ void operator()(const f32x4 (&acc)[2][2][4][2], const Unit& u, int wr, int wc, int fr, int fq) const {
        const int row0 = u.pm * BM + wr * 64 + fr, col0 = u.pn * BM + wc * 32 + 8 * fq;
#pragma unroll
        for (int ai = 0; ai < 2; ++ai)
#pragma unroll
            for (int m = 0; m < 4; ++m) { bf16_t* rowp = O + (size_t)(row0 + ai * HALF + m * 16) * ldc + col0;
#pragma unroll
                for (int bj = 0; bj < 2; ++bj) { f32x4 v0 = acc[ai][bj][m][0], v1 = acc[ai][bj][m][1];
                    if (ACT == 2) {
#pragma unroll
                        for (int e = 0; e < 4; ++e) { const float a = fmaxf(v0[e], 0.f), b = fmaxf(v1[e], 0.f); v0[e] = a * a; v1[e] = b * b; } }
                    u32x4 w; w.x = cvt_pk_bf16(v0[0], v0[1]); w.y = cvt_pk_bf16(v0[2], v0[3]); w.z = cvt_pk_bf16(v1[0], v1[1]); w.w = cvt_pk_bf16(v1[2], v1[3]);
                    *(u32x4*)(rowp + bj * HALF) = w; } }
    }
};
struct EpiUQ {
    static constexpr bool PERM = true, AFTER_DRAIN = false;
    bf16_t* Q; const float* rstd; const float* tab; float qscale;
    __device__ __forceinline__ void operator()(const f32x4 (&acc)[2][2][4][2], const Unit& u, int wr, int wc, int fr, int fq) const {
        const int row0 = u.pm * BM + wr * 64 + fr, col0 = u.pn * BM + wc * 32 + 8 * fq;
#pragma unroll
        for (int ai = 0; ai < 2; ++ai)
#pragma unroll
            for (int m = 0; m < 4; ++m) { const int row = row0 + ai * HALF + m * 16; const float rs = rstd[row] * qscale;
                const bool latent = row < 16384; const int t = row & 4095, prow = t >> 6, pcol = t & 63;
#pragma unroll
                for (int bj = 0; bj < 2; ++bj) { const int col = col0 + bj * HALF; if (col >= 384) continue;
                    f32x4 v0 = acc[ai][bj][m][0] * rs, v1 = acc[ai][bj][m][1] * rs;
                    const int d0 = col % 96;
                    if (d0 >= 64 && latent) { const int j0 = d0 - 64, part = j0 >> 4, i0 = (j0 & 15) >> 1; const int pos = part ? pcol : prow;
                        const float* cs = tab + (pos * 8 + i0) * 2;
                        float x1, x2, c, s;
                        x1 = v0[0]; x2 = v0[1]; c = cs[0]; s = cs[1]; v0[0] = x1 * c - x2 * s; v0[1] = x1 * s + x2 * c;
                        x1 = v0[2]; x2 = v0[3]; c = cs[2]; s = cs[3]; v0[2] = x1 * c - x2 * s; v0[3] = x1 * s + x2 * c;
                        x1 = v1[0]; x2 = v1[1]; c = cs[4]; s = cs[5]; v1[0] = x1 * c - x2 * s; v1[1] = x1 * s + x2 * c;
                        x1 = v1[2]; x2 = v1[3]; c = cs[6]; s = cs[7]; v1[2] = x1 * c - x2 * s; v1[3] = x1 * s + x2 * c; }
                    u32x4 w; w.x = cvt_pk_bf16(v0[0], v0[1]); w.y = cvt_pk_bf16(v0[2], v0[3]); w.z = cvt_pk_bf16(v1[0], v1[1]); w.w = cvt_pk_bf16(v1[2], v1[3]);
                    *(u32x4*)(Q + (size_t)row * 384 + col) = w; } }
    }
};
struct EpiUKV {
    static constexpr bool PERM = true, AFTER_DRAIN = false;
    bf16_t* KM; bf16_t* VT; const float* rstd;
    __device__ __forceinline__ void operator()(const f32x4 (&acc)[2][2][4][2], const Unit& u, int wr, int wc, int fr, int fq) const {
        const int row0 = u.pm * BM + wr * 64 + fr, col0 = u.pn * BM + wc * 32 + 8 * fq;
#pragma unroll
        for (int ai = 0; ai < 2; ++ai)
#pragma unroll
            for (int m = 0; m < 4; ++m) { const int row = row0 + ai * HALF + m * 16; const float rs = rstd[row];
                int b, kk; if (row < 16384) { b = row >> 12; kk = row & 4095; } else { const int r2 = row - 16384; b = r2 >> 8; kk = 4096 + (r2 & 255); }
#pragma unroll
                for (int bj = 0; bj < 2; ++bj) { const int col = col0 + bj * HALF; const int head = col >> 7, d = col & 127;
                    const f32x4 v0 = acc[ai][bj][m][0] * rs, v1 = acc[ai][bj][m][1] * rs;
                    u32x4 w; w.x = cvt_pk_bf16(v0[0], v0[1]); w.y = cvt_pk_bf16(v0[2], v0[3]); w.z = cvt_pk_bf16(v1[0], v1[1]); w.w = cvt_pk_bf16(v1[2], v1[3]);
                    if (d < 64) { *(u32x4*)(KM + ((size_t)((b * 4 + head) * 4352 + kk)) * 96 + d) = w; }
                    else { bf16_t* vp = VT + ((size_t)((b * 4 + head) * 64 + (d - 64))) * 4352 + kk;
                        vp[0 * 4352] = (bf16_t)(w.x & 0xffffu); vp[1 * 4352] = (bf16_t)(w.x >> 16); vp[2 * 4352] = (bf16_t)(w.y & 0xffffu); vp[3 * 4352] = (bf16_t)(w.y >> 16);
                        vp[4 * 4352] = (bf16_t)(w.z & 0xffffu); vp[5 * 4352] = (bf16_t)(w.z >> 16); vp[6 * 4352] = (bf16_t)(w.w & 0xffffu); vp[7 * 4352] = (bf16_t)(w.w >> 16); } } }
    }
};
template <class Epi, class Sched, bool ALIGN_EPI = false, bool SP2 = false>
__device__ __forceinline__ void gemm_phase(PG8_LAS unsigned char* lds, const Gemm g, const Sched& S, const Epi& E) {
    int tid_ = threadIdx.x; asm volatile("" : "+v"(tid_));
    const int tid = tid_, wid = __builtin_amdgcn_readfirstlane(tid >> 6), lane = tid & 63, wr = wid >> 2, wc = wid & 3, fr = lane & 15, fq = lane >> 4;
    const int K = g.K, nt = K / BK;
    unsigned voffA, voffB;
    { int R, C; stage_rc(tid * 16, R, C); const int Rb = Epi::PERM ? ((R & ~31) + perm32(R & 31)) : R;
        voffA = (unsigned)(R * g.lda + C) * 2u; voffB = (unsigned)(Rb * K + C) * 2u; }
    const size_t pstepA = (size_t)64 * g.lda * 2, pstepB = (size_t)64 * K * 2;
    const size_t kstep = (size_t)(BK * 2);
    const size_t hstep = (size_t)HALF * K * 2;
    const size_t tstep = 2 * hstep; const size_t hstepA = (size_t)HALF * g.lda * 2, tstepA = 2 * hstepA;
    const unsigned ldsw = (unsigned)wid * 1024u;
    const int aoff = lds_byte(wr * 64 + fr, fq * 8), boff = lds_byte(wc * 32 + fr, fq * 8);
#define PG8_SA(b, h) (((b) * 2 + (h)) * HTB)
#define PG8_SB(b, h) ((4 + (b) * 2 + (h)) * HTB)
#define PG8_STAGE(bufoff, gbase, voff) do { _Pragma("unroll") for (int _i = 0; _i < 2; ++_i) \
        __builtin_amdgcn_global_load_lds((const unsigned*)((const char*)(gbase) + (size_t)_i * PG8_PSTEP_##voff + (voff)), (PG8_LAS unsigned*)(lds + (bufoff) + ldsw + _i * 8192), 16, 0, 0); } while (0)
#define PG8_PSTEP_voffA pstepA
#define PG8_PSTEP_voffB pstepB
#define PG8_LDA(dst, b, h) do { _Pragma("unroll") for (int m = 0; m < 4; ++m) _Pragma("unroll") for (int k = 0; k < 2; ++k) dst[m][k] = *(const PG8_LAS bf16x8*)(lds + PG8_SA(b, h) + aoff + m * 2048 + k * 1024); } while (0)
#define PG8_LDB(dst, b, h) do { _Pragma("unroll") for (int n = 0; n < 2; ++n) _Pragma("unroll") for (int k = 0; k < 2; ++k) dst[n][k] = *(const PG8_LAS bf16x8*)(lds + PG8_SB(b, h) + boff + n * 2048 + k * 1024); } while (0)
#define PG8_MMA(ai, bj, At, Bt) do { __builtin_amdgcn_s_setprio(1); _Pragma("unroll") for (int m = 0; m < 4; ++m) _Pragma("unroll") for (int n = 0; n < 2; ++n) _Pragma("unroll") for (int k = 0; k < 2; ++k) \
        acc[ai][bj][m][n] = __builtin_amdgcn_mfma_f32_16x16x32_bf16(Bt[n][k], At[m][k], acc[ai][bj][m][n], 0, 0, 0); __builtin_amdgcn_s_setprio(0); } while (0)
#define PG8_WAIT_V(n) asm volatile("s_waitcnt vmcnt(" #n ")" ::: "memory")
#define PG8_WAIT_L(n) asm volatile("s_waitcnt lgkmcnt(" #n ")" ::: "memory")
#define PG8_BAR __builtin_amdgcn_s_barrier()
#define PG8_SCHED __builtin_amdgcn_sched_barrier(0)
    Unit cur, nxt; int ui = 0;
    if (!S.next(0, cur)) return;
    f32x4 acc[2][2][4][2];
#pragma unroll
    for (int a = 0; a < 2; ++a)
#pragma unroll
        for (int b = 0; b < 2; ++b)
#pragma unroll
            for (int m = 0; m < 4; ++m)
#pragma unroll
                for (int n = 0; n < 2; ++n) acc[a][b][m][n] = (f32x4){0.f, 0.f, 0.f, 0.f};
    bf16x8 At[4][2], B0[2][2], B1[2][2];
    const char* cA = (const char*)g.A + (size_t)cur.pm * tstepA; const char* cB = (const char*)g.Bt + (size_t)cur.pn * tstep;
    S.a_ready(cur);
    if constexpr (SP2) {
        PG8_STAGE(PG8_SB(0, 0), cB, voffB); PG8_STAGE(PG8_SB(0, 1), cB + hstep, voffB); PG8_STAGE(PG8_SA(0, 0), cA, voffA); PG8_STAGE(PG8_SA(0, 1), cA + hstepA, voffA);
        if (wr == 1) PG8_BAR;
        PG8_WAIT_V(2); PG8_BAR;
        PG8_STAGE(PG8_SB(1, 0), cB + kstep, voffB); PG8_STAGE(PG8_SA(1, 0), cA + kstep, voffA); PG8_STAGE(PG8_SB(1, 1), cB + hstep + kstep, voffB);
        PG8_WAIT_V(6); PG8_BAR;
    } else {
        PG8_STAGE(PG8_SB(0, 0), cB, voffB); PG8_STAGE(PG8_SA(0, 0), cA, voffA); PG8_STAGE(PG8_SB(0, 1), cB + hstep, voffB); PG8_STAGE(PG8_SA(0, 1), cA + hstepA, voffA);
        if (wr == 1) PG8_BAR;
        PG8_WAIT_V(4); PG8_BAR;
        PG8_STAGE(PG8_SB(1, 0), cB + kstep, voffB); PG8_STAGE(PG8_SA(1, 0), cA + kstep, voffA); PG8_STAGE(PG8_SB(1, 1), cB + hstep + kstep, voffB);
        PG8_WAIT_V(6); PG8_BAR;
    }
    for (;;) {
        const bool has_next = S.next(ui + 1, nxt);
        const char* nA = has_next ? (const char*)g.A + (size_t)nxt.pm * tstepA : cA; const char* nB = has_next ? (const char*)g.Bt + (size_t)nxt.pn * tstep : cB;
        for (int t = 0; t < nt; t += 2) {
            const bool last = (t == nt - 2);
            const char* a1 = cA + (size_t)(t + 1) * kstep;
            const char* a2 = last ? nA : cA + (size_t)(t + 2) * kstep; const char* b2 = last ? nB : cB + (size_t)(t + 2) * kstep;
            const char* a3 = a2 + kstep; const char* b3 = b2 + kstep;
            if (last && has_next) S.a_ready(nxt);
            if constexpr (SP2) {
            PG8_LDB(B0, 0, 0); PG8_LDB(B1, 0, 1); PG8_SCHED; PG8_LDA(At, 0, 0); PG8_STAGE(PG8_SA(1, 1), a1 + hstepA, voffA);
            PG8_WAIT_V(8); PG8_WAIT_L(0); PG8_BAR; PG8_MMA(0, 0, At, B0); PG8_MMA(0, 1, At, B1); PG8_BAR; PG8_SCHED;
            PG8_LDA(At, 0, 1); PG8_STAGE(PG8_SB(0, 0), b2, voffB); PG8_STAGE(PG8_SB(0, 1), b2 + hstep, voffB); PG8_STAGE(PG8_SA(0, 0), a2, voffA);
            PG8_WAIT_V(8); PG8_WAIT_L(0); PG8_BAR; PG8_MMA(1, 0, At, B0); PG8_MMA(1, 1, At, B1); PG8_BAR; PG8_SCHED;
            PG8_LDB(B0, 1, 0); PG8_LDB(B1, 1, 1); PG8_SCHED; PG8_LDA(At, 1, 0); PG8_STAGE(PG8_SA(0, 1), a2 + hstepA, voffA);
            PG8_WAIT_V(8); PG8_WAIT_L(0); PG8_BAR; PG8_MMA(0, 0, At, B0); PG8_MMA(0, 1, At, B1); PG8_BAR; PG8_SCHED;
            PG8_LDA(At, 1, 1); PG8_STAGE(PG8_SB(1, 0), b3, voffB); PG8_STAGE(PG8_SB(1, 1), b3 + hstep, voffB); PG8_STAGE(PG8_SA(1, 0), a3, voffA);
            PG8_WAIT_V(8); PG8_WAIT_L(0); PG8_BAR; PG8_MMA(1, 0, At, B0); PG8_MMA(1, 1, At, B1); PG8_BAR; PG8_SCHED;
            } else {
            PG8_LDB(B0, 0, 0); PG8_SCHED; PG8_LDA(At, 0, 0); PG8_STAGE(PG8_SA(1, 1), a1 + hstepA, voffA);
            PG8_WAIT_L(8); PG8_BAR; PG8_WAIT_L(0); PG8_MMA(0, 0, At, B0); PG8_BAR; PG8_SCHED;
            PG8_LDB(B1, 0, 1); PG8_STAGE(PG8_SB(0, 0), b2, voffB);
            PG8_BAR; PG8_WAIT_L(0); PG8_MMA(0, 1, At, B1); PG8_BAR;
            PG8_LDA(At, 0, 1); PG8_STAGE(PG8_SA(0, 0), a2, voffA);
            PG8_BAR; PG8_WAIT_L(0); PG8_MMA(1, 0, At, B0); PG8_BAR; PG8_SCHED;
            PG8_STAGE(PG8_SB(0, 1), b2 + hstep, voffB);
            PG8_WAIT_V(6); PG8_BAR; PG8_MMA(1, 1, At, B1); PG8_BAR;
            PG8_LDB(B0, 1, 0); PG8_SCHED; PG8_LDA(At, 1, 0); PG8_STAGE(PG8_SA(0, 1), a2 + hstepA, voffA);
            PG8_WAIT_L(8); PG8_BAR; PG8_WAIT_L(0); PG8_MMA(0, 0, At, B0); PG8_BAR; PG8_SCHED;
            PG8_LDB(B1, 1, 1); PG8_STAGE(PG8_SB(1, 0), b3, voffB);
            PG8_BAR; PG8_WAIT_L(0); PG8_MMA(0, 1, At, B1); PG8_BAR;
            PG8_LDA(At, 1, 1); PG8_STAGE(PG8_SA(1, 0), a3, voffA);
            PG8_BAR; PG8_WAIT_L(0); PG8_MMA(1, 0, At, B0); PG8_BAR; PG8_SCHED;
            PG8_STAGE(PG8_SB(1, 1), b3 + hstep, voffB);
            PG8_WAIT_V(6); PG8_BAR; PG8_MMA(1, 1, At, B1); PG8_BAR;
            }
        }
        if constexpr (ALIGN_EPI) { if (wr == 0) PG8_BAR; }
        if constexpr (!Epi::AFTER_DRAIN) { E(acc, cur, wr, wc, fr, fq); S.done(cur); }
        if (!has_next) break;
#pragma unroll
        for (int a = 0; a < 2; ++a)
#pragma unroll
            for (int b = 0; b < 2; ++b)
#pragma unroll
                for (int m = 0; m < 4; ++m)
#pragma unroll
                    for (int n = 0; n < 2; ++n) acc[a][b][m][n] = (f32x4){0.f, 0.f, 0.f, 0.f};
        cur = nxt; cA = nA; cB = nB; ++ui;
        if constexpr (ALIGN_EPI) { if (wr == 1) PG8_BAR; }
    }
    PG8_WAIT_V(0);
    if constexpr (!ALIGN_EPI) { if (wr == 0) PG8_BAR; }
    PG8_BAR;
    if constexpr (Epi::AFTER_DRAIN) { E.fused(acc, cur, wr, wc, fr, fq, lds, wid, lane); S.done(cur); }
#undef PG8_SA
#undef PG8_SB
#undef PG8_STAGE
#undef PG8_LDA
#undef PG8_LDB
#undef PG8_MMA
#undef PG8_WAIT_V
#undef PG8_WAIT_L
#undef PG8_BAR
#undef PG8_SCHED
}
}

__device__ const float ROPE_TAB[1024] = {
1.000000000e+00f,0.000000000e+00f,1.000000000e+00f,0.000000000e+00f,1.000000000e+00f,0.000000000e+00f,1.000000000e+00f,0.000000000e+00f,
1.000000000e+00f,0.000000000e+00f,1.000000000e+00f,0.000000000e+00f,1.000000000e+00f,0.000000000e+00f,1.000000000e+00f,0.000000000e+00f,
5.403022766e-01f,8.414709568e-01f,9.504152536e-01f,3.109835982e-01f,9.950041771e-01f,9.983342141e-02f,9.995000362e-01f,3.161750361e-02f,
9.999499917e-01f,9.999833070e-03f,9.999949932e-01f,3.162272274e-03f,9.999995232e-01f,9.999999311e-04f,9.999999404e-01f,3.162277571e-04f,
-4.161468446e-01f,9.092974067e-01f,8.065783978e-01f,5.911270976e-01f,9.800665975e-01f,1.986693293e-01f,9.980006814e-01f,6.320339441e-02f,
9.998000264e-01f,1.999866590e-02f,9.999799728e-01f,6.324512884e-03f,9.999979734e-01f,1.999998698e-03f,9.999998212e-01f,6.324554561e-04f,
-9.899924994e-01f,1.411200017e-01f,5.827536583e-01f,8.126488924e-01f,9.553365111e-01f,2.955202162e-01f,9.955033660e-01f,9.472608566e-02f,
9.995500445e-01f,2.999549918e-02f,9.999549985e-01f,9.486690164e-03f,9.999955297e-01f,2.999995602e-03f,9.999995232e-01f,9.486831259e-04f,
-6.536436081e-01f,-7.568024993e-01f,3.011374772e-01f,9.535807371e-01f,9.210609794e-01f,3.894183338e-01f,9.920106530e-01f,1.261540651e-01f,
9.992001057e-01f,3.998933360e-02f,9.999200106e-01f,1.264877338e-02f,9.999920130e-01f,3.999989480e-03f,9.999992251e-01f,1.264910679e-03f,
2.836622000e-01f,-9.589242935e-01f,-1.034233812e-02f,9.999465346e-01f,8.775825500e-01f,4.794255495e-01f,9.875259995e-01f,1.574558765e-01f,
9.987502694e-01f,4.997916520e-02f,9.998750091e-01f,1.581072807e-02f,9.999874830e-01f,4.999979399e-03f,9.999987483e-01f,1.581138116e-03f,
9.601702690e-01f,-2.794154882e-01f,-3.207964003e-01f,9.471482038e-01f,8.253356218e-01f,5.646424890e-01f,9.820539355e-01f,1.886002719e-01f,
9.982005358e-01f,5.996400490e-02f,9.998199940e-01f,1.897252724e-02f,9.999819994e-01f,5.999964196e-03f,9.999982119e-01f,1.897365320e-03f,
7.539022565e-01f,6.569865942e-01f,-5.994374752e-01f,8.004215956e-01f,7.648422122e-01f,6.442176700e-01f,9.755998850e-01f,2.195560932e-01f,
9.975510240e-01f,6.994284689e-02f,9.997550249e-01f,2.213413455e-02f,9.999755025e-01f,6.999942940e-03f,9.999975562e-01f,2.213592408e-03f,
-1.455000341e-01f,9.893582463e-01f,-8.186324239e-01f,5.743177533e-01f,6.967067122e-01f,7.173560858e-01f,9.681702852e-01f,2.502923310e-01f,
9.968017340e-01f,7.991468906e-02f,9.996800423e-01f,2.529552206e-02f,9.999679923e-01f,7.999914698e-03f,9.999967813e-01f,2.529819263e-03f,
-9.111302495e-01f,4.121184945e-01f,-9.566441774e-01f,2.912592292e-01f,6.216099262e-01f,7.833269238e-01f,9.597726464e-01f,2.807783186e-01f,
9.959527254e-01f,8.987854421e-02f,9.995950460e-01f,2.845665626e-02f,9.999595284e-01f,8.999879472e-03f,9.999959469e-01f,2.846045885e-03f,
-8.390715122e-01f,-5.440211296e-01f,-9.997860789e-01f,-2.068356983e-02f,5.403022766e-01f,8.414709568e-01f,9.504153132e-01f,3.109835684e-01f,
9.950041771e-01f,9.983341396e-02f,9.995000362e-01f,3.161750361e-02f,9.999499917e-01f,9.999834001e-03f,9.999949932e-01f,3.162272274e-03f,
4.425697960e-03f,-9.999902248e-01f,-9.437797666e-01f,-3.305749595e-01f,4.535960853e-01f,8.912073970e-01f,9.401075840e-01f,3.408778608e-01f,
9.939560890e-01f,1.097782999e-01f,9.993950725e-01f,3.477803990e-02f,9.999395013e-01f,1.099977922e-02f,9.999939203e-01f,3.478498431e-03f,
8.438539505e-01f,-5.365729332e-01f,-7.941793799e-01f,-6.076834202e-01f,3.623577058e-01f,9.320390821e-01f,9.288598895e-01f,3.704313040e-01f,
9.928086400e-01f,1.197122037e-01f,9.992800951e-01f,3.793822229e-02f,9.999279976e-01f,1.199971233e-02f,9.999927878e-01f,3.794723889e-03f,
9.074468017e-01f,4.201670289e-01f,-5.658205152e-01f,-8.245284557e-01f,2.674987614e-01f,9.635581970e-01f,9.166833758e-01f,3.996143043e-01f,
9.915618896e-01f,1.296341419e-01f,9.991551042e-01f,4.109803215e-02f,9.999154806e-01f,1.299963426e-02f,9.999915361e-01f,4.110949114e-03f,
1.367372125e-01f,9.906073809e-01f,-2.813494802e-01f,-9.596053958e-01f,1.699671596e-01f,9.854497313e-01f,9.035902619e-01f,4.283977747e-01f,
9.902160168e-01f,1.395431161e-01f,9.990201592e-01f,4.425742477e-02f,9.999020100e-01f,1.399954315e-02f,9.999902248e-01f,4.427174106e-03f,
-7.596879005e-01f,6.502878666e-01f,3.102235124e-02f,-9.995186925e-01f,7.073719800e-02f,9.974949956e-01f,8.895936012e-01f,4.567528665e-01f,
9.887710810e-01f,1.494381279e-01f,9.988752007e-01f,4.741638154e-02f,9.998875260e-01f,1.499943808e-02f,9.999887347e-01f,4.743398633e-03f,
-9.576594830e-01f,-2.879033089e-01f,3.403181732e-01f,-9.403103590e-01f,-2.919954620e-02f,9.995735884e-01f,8.747074604e-01f,4.846512377e-01f,
9.872272611e-01f,1.593182087e-01f,9.987202883e-01f,5.057485774e-02f,9.998720288e-01f,1.599931903e-02f,9.999871850e-01f,5.059622694e-03f,
-2.751633525e-01f,-9.613974690e-01f,6.158648133e-01f,-7.878518701e-01f,-1.288445443e-01f,9.916648269e-01f,8.589466810e-01f,5.120649934e-01f,
9.855847955e-01f,1.691823453e-01f,9.985553622e-01f,5.373282731e-02f,9.998555183e-01f,1.699918136e-02f,9.999855757e-01f,5.375845823e-03f,
6.603167057e-01f,-7.509872317e-01f,8.303361535e-01f,-5.572628975e-01f,-2.272021621e-01f,9.738476276e-01f,8.423270583e-01f,5.389667153e-01f,
9.838436842e-01f,1.790295690e-01f,9.983804226e-01f,5.689026415e-02f,9.998379946e-01f,1.799902879e-02f,9.999837875e-01f,5.692068953e-03f,
9.887046218e-01f,1.498772055e-01f,9.624637961e-01f,-2.714101076e-01f,-3.232895434e-01f,9.463000894e-01f,8.248651624e-01f,5.653295517e-01f,
9.820042253e-01f,1.888588965e-01f,9.981955290e-01f,6.004713103e-02f,9.998195171e-01f,1.899885759e-02f,9.999819398e-01f,6.008291151e-03f,
4.080820680e-01f,9.129452705e-01f,9.991443753e-01f,4.135828838e-02f,-4.161468446e-01f,9.092974067e-01f,8.065784574e-01f,5.911270380e-01f,
9.800665975e-01f,1.986693144e-01f,9.980006814e-01f,6.320339441e-02f,9.998000264e-01f,1.999866776e-02f,9.999799728e-01f,6.324512884e-03f,
-5.477292538e-01f,8.366556168e-01f,9.367404580e-01f,3.500247598e-01f,-5.048462152e-01f,8.632093072e-01f,7.874851823e-01f,6.163335443e-01f,
9.780309200e-01f,2.084598988e-01f,9.977958202e-01f,6.635902822e-02f,9.997795224e-01f,2.099845745e-02f,9.999779463e-01f,6.640734151e-03f,
-9.999608397e-01f,-8.851309307e-03f,7.814403772e-01f,6.239799261e-01f,-5.885011554e-01f,8.084963560e-01f,7.676045895e-01f,6.409237385e-01f,
9.758974314e-01f,2.182296216e-01f,9.975810051e-01f,6.951400638e-02f,9.997580051e-01f,2.199822664e-02f,9.999758005e-01f,6.956954487e-03f,
-5.328330398e-01f,-8.462204337e-01f,5.486452579e-01f,8.360552788e-01f,-6.662759781e-01f,7.457052469e-01f,7.469564080e-01f,6.648730636e-01f,
9.736663699e-01f,2.279775143e-01f,9.973561764e-01f,7.266827673e-02f,9.997355342e-01f,2.299797349e-02f,9.999735355e-01f,7.273174357e-03f,
4.241790175e-01f,-9.055783749e-01f,2.614416778e-01f,9.652192593e-01f,-7.373937964e-01f,6.754631400e-01f,7.255613208e-01f,6.881574988e-01f,
9.713379741e-01f,2.377026230e-01f,9.971213937e-01f,7.582182437e-02f,9.997119904e-01f,2.399769612e-02f,9.999712110e-01f,7.589393295e-03f,
9.912028313e-01f,-1.323517561e-01f,-5.168933049e-02f,9.986631870e-01f,-8.011435866e-01f,5.984721184e-01f,7.034407258e-01f,7.107539177e-01f,
9.689124227e-01f,2.474039644e-01f,9.968766570e-01f,7.897461206e-02f,9.996874928e-01f,2.499739639e-02f,9.999687672e-01f,7.905611768e-03f,
6.469193101e-01f,7.625584602e-01f,-3.596943319e-01f,9.330701828e-01f,-8.568888307e-01f,5.155012608e-01f,6.806167960e-01f,7.326396108e-01f,
9.663899541e-01f,2.570805550e-01f,9.966219068e-01f,8.212661743e-02f,9.996620417e-01f,2.599707060e-02f,9.999662042e-01f,8.221829310e-03f,
-2.921388149e-01f,9.563759565e-01f,-6.320286393e-01f,7.749450207e-01f,-9.040721655e-01f,4.273798466e-01f,6.571123004e-01f,7.537927032e-01f,
9.637709260e-01f,2.667314112e-01f,9.963572025e-01f,8.527779579e-02f,9.996355176e-01f,2.699672058e-02f,9.999635220e-01f,8.538045920e-03f,
-9.626058936e-01f,2.709057927e-01f,-8.416849375e-01f,5.399689674e-01f,-9.422222972e-01f,3.349882066e-01f,6.329506636e-01f,7.741920948e-01f,
9.610554576e-01f,2.763556540e-01f,9.960825443e-01f,8.842811733e-02f,9.996080399e-01f,2.799634263e-02f,9.999607801e-01f,8.854261599e-03f,
-7.480575442e-01f,-6.636338830e-01f,-9.678714871e-01f,2.514453232e-01f,-9.709581733e-01f,2.392492294e-01f,6.081562042e-01f,7.938174009e-01f,
9.582439065e-01f,2.859522104e-01f,9.957979321e-01f,9.157756716e-02f,9.995795488e-01f,2.899593674e-02f,9.999579787e-01f,9.170476347e-03f,
1.542514563e-01f,-9.880316257e-01f,-9.980752468e-01f,-6.201484054e-02f,-9.899924994e-01f,1.411200017e-01f,5.827536583e-01f,8.126488924e-01f,
9.553365111e-01f,2.955201864e-01f,9.955033660e-01f,9.472609311e-02f,9.995500445e-01f,2.999550104e-02f,9.999549985e-01f,9.486690164e-03f,
9.147423506e-01f,-4.040376544e-01f,-9.293003082e-01f,-3.693250120e-01f,-9.991351366e-01f,4.158052057e-02f,5.567683578e-01f,8.306677938e-01f,
9.523335695e-01f,3.050586283e-01f,9.951988459e-01f,9.787366539e-02f,9.995195270e-01f,3.099503554e-02f,9.999519587e-01f,9.802903049e-03f,
8.342233896e-01f,5.514267087e-01f,-7.683671117e-01f,-6.400094032e-01f,-9.982947707e-01f,-5.837419257e-02f,5.302263498e-01f,8.478561044e-01f,
9.492354393e-01f,3.145665526e-01f,9.948843718e-01f,1.010202691e-01f,9.994880557e-01f,3.199454024e-02f,9.999487996e-01f,1.011911593e-02f,
-1.327674743e-02f,9.999118447e-01f,-5.312352777e-01f,-8.472243547e-01f,-9.874798059e-01f,-1.577456445e-01f,5.031541586e-01f,8.641966581e-01f,
9.460423589e-01f,3.240430057e-01f,9.945599437e-01f,1.041658595e-01f,9.994555712e-01f,3.299400955e-02f,9.999455214e-01f,1.043532696e-02f,
-8.485702872e-01f,5.290827155e-01f,-2.414211184e-01f,-9.704204202e-01f,-9.667981863e-01f,-2.555412054e-01f,4.755789042e-01f,8.796730638e-01f,
9.427546859e-01f,3.334870934e-01f,9.942255616e-01f,1.073104069e-01f,9.994220734e-01f,3.399345279e-02f,9.999421835e-01f,1.075153705e-02f,
-9.036921859e-01f,-4.281826615e-01f,7.233466953e-02f,-9.973804355e-01f,-9.364566803e-01f,-3.507832289e-01f,4.475280643e-01f,8.942698836e-01f,
9.393727183e-01f,3.428978026e-01f,9.938812256e-01f,1.104538813e-01f,9.993875623e-01f,3.499285504e-02f,9.999387264e-01f,1.106774528e-02f,
-1.279636919e-01f,-9.917788506e-01f,3.789161742e-01f,-9.254310131e-01f,-8.967583776e-01f,-4.425205588e-01f,4.190297425e-01f,9.079725146e-01f,
9.358968139e-01f,3.522742093e-01f,9.935269952e-01f,1.135962531e-01f,9.993520975e-01f,3.599222749e-02f,9.999352098e-01f,1.138395350e-02f,
7.654140592e-01f,-6.435381174e-01f,6.479216814e-01f,-7.617069483e-01f,-8.481000066e-01f,-5.298361778e-01f,3.901124299e-01f,9.207672477e-01f,
9.323273301e-01f,3.616154492e-01f,9.931628108e-01f,1.167374924e-01f,9.993155599e-01f,3.699155897e-02f,9.999315739e-01f,1.170015987e-02f,
9.550736547e-01f,2.963685691e-01f,8.526731133e-01f,-5.224447846e-01f,-7.909677625e-01f,-6.118578315e-01f,3.608050346e-01f,9.326412678e-01f,
9.286646247e-01f,3.709204793e-01f,9.927886724e-01f,1.198775545e-01f,9.992780685e-01f,3.799085692e-02f,9.999278188e-01f,1.201636530e-02f,
2.666429281e-01f,9.637953639e-01f,9.728653431e-01f,-2.313720137e-01f,-7.259322405e-01f,-6.877662539e-01f,3.311368525e-01f,9.435827136e-01f,
9.249090552e-01f,3.801884055e-01f,9.924046397e-01f,1.230164245e-01f,9.992396235e-01f,3.899011388e-02f,9.999239445e-01f,1.233256981e-02f,
-6.669380665e-01f,7.451131344e-01f,9.965789914e-01f,8.264580369e-02f,-6.536436081e-01f,-7.568024993e-01f,3.011375964e-01f,9.535806775e-01f,
9.210609794e-01f,3.894183338e-01f,9.920106530e-01f,1.261540651e-01f,9.992001057e-01f,3.998933733e-02f,9.999200106e-01f,1.264877338e-02f,
-9.873392582e-01f,-1.586226672e-01f,9.214623570e-01f,3.884676993e-01f,-5.748240352e-01f,-8.182770610e-01f,2.708370686e-01f,9.626252055e-01f,
9.171208143e-01f,3.986093104e-01f,9.916067719e-01f,1.292904317e-01f,9.991596341e-01f,4.098851606e-02f,9.999159575e-01f,1.296497509e-02f,
-3.999853134e-01f,-9.165215492e-01f,7.549653649e-01f,6.557646990e-01f,-4.902605712e-01f,-8.715758920e-01f,2.402658761e-01f,9.707071185e-01f,
9.130889177e-01f,4.077604413e-01f,9.911929369e-01f,1.324255317e-01f,9.991181493e-01f,4.198765755e-02f,9.999117851e-01f,1.328117587e-02f,
5.551133156e-01f,-8.317747712e-01f,5.135984421e-01f,8.580306768e-01f,-4.007990062e-01f,-9.161660075e-01f,2.094544172e-01f,9.778184295e-01f,
9.089657664e-01f,4.168707728e-01f,9.907692075e-01f,1.355592906e-01f,9.990756512e-01f,4.298675060e-02f,9.999075532e-01f,1.359737478e-02f,
9.998432994e-01f,1.770192571e-02f,2.212981731e-01f,9.752061963e-01f,-3.073327839e-01f,-9.516021013e-01f,1.784335226e-01f,9.839519858e-01f,
9.047516584e-01f,4.259394705e-01f,9.903355837e-01f,1.386916935e-01f,9.990321398e-01f,4.398580641e-02f,9.999032021e-01f,1.391357277e-02f,
5.253219604e-01f,8.509035110e-01f,-9.294810891e-02f,9.956709743e-01f,-2.107958049e-01f,-9.775301218e-01f,1.472342163e-01f,9.891016483e-01f,
9.004471302e-01f,4.349655211e-01f,9.898920655e-01f,1.418227106e-01f,9.989876747e-01f,4.498481750e-02f,9.998987317e-01f,1.422976889e-02f,
-4.321779311e-01f,9.017883539e-01f,-3.979767561e-01f,9.173954725e-01f,-1.121526212e-01f,-9.936909676e-01f,1.158876941e-01f,9.932623506e-01f,
8.960524797e-01f,4.439480901e-01f,9.894386530e-01f,1.449523121e-01f,9.989421964e-01f,4.598378390e-02f,9.998942018e-01f,1.454596408e-02f,
-9.923354983e-01f,1.235731244e-01f,-6.635382771e-01f,7.481423616e-01f,-1.238837745e-02f,-9.999232888e-01f,8.442528546e-02f,9.964298010e-01f,
8.915683031e-01f,4.528862834e-01f,9.889753461e-01f,1.480804533e-01f,9.988957047e-01f,4.698270187e-02f,9.998895526e-01f,1.486215740e-02f,
-6.401443481e-01f,-7.682546377e-01f,-8.632965088e-01f,5.046970844e-01f,8.749917150e-02f,-9.961646199e-01f,5.287845805e-02f,9.986009598e-01f,
8.869948983e-01f,4.617791772e-01f,9.885020852e-01f,1.512071192e-01f,9.988481998e-01f,4.798157141e-02f,9.998847842e-01f,1.517834887e-02f,
3.005925417e-01f,-9.537526369e-01f,-9.774427414e-01f,2.112006545e-01f,1.865124702e-01f,-9.824525714e-01f,2.127875760e-02f,9.997735620e-01f,
8.823328614e-01f,4.706258774e-01f,9.880189896e-01f,1.543322802e-01f,9.987997413e-01f,4.898039624e-02f,9.998799562e-01f,1.549453940e-02f,
9.649659991e-01f,-2.623748481e-01f,-9.946564436e-01f,-1.032404602e-01f,2.836622000e-01f,-9.589242935e-01f,-1.034221891e-02f,9.999465346e-01f,
8.775825500e-01f,4.794255495e-01f,9.875259995e-01f,1.574558914e-01f,9.987502694e-01f,4.997916892e-02f,9.998750091e-01f,1.581072807e-02f,
7.421541810e-01f,6.702291965e-01f,-9.132301211e-01f,-4.074441493e-01f,3.779776692e-01f,-9.258147478e-01f,-4.195285589e-02f,9.991195798e-01f,
8.727445006e-01f,4.881772399e-01f,9.870231748e-01f,1.605779380e-01f,9.986997843e-01f,5.097789690e-02f,9.998699427e-01f,1.612691768e-02f,
-1.629907787e-01f,9.866275787e-01f,-7.412399650e-01f,-6.712401509e-01f,4.685169160e-01f,-8.834545016e-01f,-7.352153957e-02f,9.972936511e-01f,
8.678191900e-01f,4.968801141e-01f,9.865104556e-01f,1.636983752e-01f,9.986482859e-01f,5.197656900e-02f,9.998648167e-01f,1.644310169e-02f,
-9.182828069e-01f,3.959251642e-01f,-4.957418144e-01f,-8.684699535e-01f,5.543745160e-01f,-8.322673440e-01f,-1.050167084e-01f,9.944704771e-01f,
8.628070951e-01f,5.055333376e-01f,9.859878421e-01f,1.668171734e-01f,9.985958338e-01f,5.297519267e-02f,9.998595715e-01f,1.675928757e-02f,
-8.293098211e-01f,-5.587890744e-01f,-2.010796219e-01f,-9.795749187e-01f,6.346929669e-01f,-7.727644444e-01f,-1.364068687e-01f,9.906529188e-01f,
8.577086926e-01f,5.141359568e-01f,9.854553938e-01f,1.699342877e-01f,9.985423684e-01f,5.397376046e-02f,9.998542070e-01f,1.707546785e-02f,
2.212675661e-02f,-9.997551441e-01f,1.135217771e-01f,-9.935355186e-01f,7.086697817e-01f,-7.055402994e-01f,-1.676606387e-01f,9.858447909e-01f,
8.525245190e-01f,5.226872563e-01f,9.849131107e-01f,1.730497181e-01f,9.984878898e-01f,5.497227982e-02f,9.998487830e-01f,1.739165001e-02f,
8.532201052e-01f,-5.215510130e-01f,4.168670774e-01f,-9.089674354e-01f,7.755658031e-01f,-6.312667131e-01f,-1.987468749e-01f,9.800508618e-01f,
8.472551107e-01f,5.311862230e-01f,9.843609333e-01f,1.761634201e-01f,9.984323978e-01f,5.597073585e-02f,9.998431802e-01f,1.770782843e-02f,
8.998668194e-01f,4.361647666e-01f,6.788702011e-01f,-7.342582941e-01f,8.347129226e-01f,-5.506852865e-01f,-2.296342701e-01f,9.732769728e-01f,
8.419010043e-01f,5.396320224e-01f,9.837989211e-01f,1.792753637e-01f,9.983759522e-01f,5.696914345e-02f,9.998375773e-01f,1.802400686e-02f,
1.191801354e-01f,9.928726554e-01f,8.735505342e-01f,-4.867334962e-01f,8.855196238e-01f,-4.646020234e-01f,-2.602920532e-01f,9.655299187e-01f,
8.364626765e-01f,5.480239391e-01f,9.832270741e-01f,1.823855042e-01f,9.983184934e-01f,5.796748772e-02f,9.998317957e-01f,1.834018156e-02f,
-7.710801959e-01f,6.367380023e-01f,9.816020727e-01f,-1.909380108e-01f,9.274784923e-01f,-3.738765717e-01f,-2.906895578e-01f,9.568174481e-01f,
8.309407234e-01f,5.563610196e-01f,9.826454520e-01f,1.854938269e-01f,9.982600212e-01f,5.896577984e-02f,9.998259544e-01f,1.865635626e-02f,
-9.524129629e-01f,-3.048106134e-01f,9.923083186e-01f,1.237909496e-01f,9.601702690e-01f,-2.794154882e-01f,-3.207964003e-01f,9.471482038e-01f,
8.253356218e-01f,5.646424294e-01f,9.820539355e-01f,1.886002868e-01f,9.982005358e-01f,5.996400863e-02f,9.998199940e-01f,1.897252724e-02f,
-2.581016421e-01f,-9.661177993e-01f,9.046075940e-01f,4.262454212e-01f,9.832684398e-01f,-1.821625978e-01f,-3.505824506e-01f,9.365318418e-01f,
8.196480274e-01f,5.728674531e-01f,9.814526439e-01f,1.917048544e-01f,9.981400967e-01f,6.096218154e-02f,9.998139739e-01f,1.928869821e-02f,
6.735071540e-01f,-7.391806841e-01f,7.271980643e-01f,6.864276528e-01f,9.965420961e-01f,-8.308912069e-02f,-3.800179660e-01f,9.249790907e-01f,
8.138784766e-01f,5.810351372e-01f,9.808415174e-01f,1.948075294e-01f,9.980786443e-01f,6.196028739e-02f,9.998078346e-01f,1.960486546e-02f,
9.858965874e-01f,1.673557013e-01f,4.776714444e-01f,8.785385489e-01f,9.998586178e-01f,1.681409031e-02f,-4.090735018e-01f,9.125014544e-01f,
8.080275059e-01f,5.891447663e-01f,9.802205563e-01f,1.979082376e-01f,9.980161786e-01f,6.295833737e-02f,9.998015761e-01f,1.992103085e-02f,
};

#define GAS __attribute__((address_space(1)))
#define LAS __attribute__((address_space(3)))
typedef unsigned short bf16;
typedef unsigned v4u __attribute__((ext_vector_type(4)));
typedef float f32x4 __attribute__((ext_vector_type(4)));
typedef short bf16x8 __attribute__((ext_vector_type(8)));
typedef GAS unsigned gu32;
typedef GAS unsigned long long gu64;
#define RLX_AGENT __ATOMIC_RELAXED, __HIP_MEMORY_SCOPE_AGENT
#define LDS_WAIT() asm volatile("s_waitcnt lgkmcnt(0)" ::: "memory")
#define VM_WAIT() asm volatile("s_waitcnt vmcnt(0)" ::: "memory")
__device__ __forceinline__ unsigned long long rt() { return __builtin_amdgcn_s_memrealtime(); }
__device__ __forceinline__ unsigned f2bf(float f) { unsigned u = __builtin_bit_cast(unsigned, f); return (u + 0x7fffu + ((u >> 16) & 1u)) >> 16; }
__device__ __forceinline__ unsigned pk2(float lo, float hi) { return f2bf(lo) | (f2bf(hi) << 16); }

#define XB_TMO      128
#define XB_XCNT(j)  (256  + 64 * (j))
#define XB_XSUB(j)  (1280 + 64 * (j))
#define XB_XGEN(j)  (2304 + 64 * (j))
#define XB_TOP      3328
#define XB_TOPGEN   3392
#define XCD_BAR_WORDS 3456
#define XB_SPIN_CAP (1u << 18)

__device__ __forceinline__ unsigned xb_ld(unsigned* p)              { return __hip_atomic_load(p, __ATOMIC_RELAXED, __HIP_MEMORY_SCOPE_AGENT); }
__device__ __forceinline__ unsigned xb_add(unsigned* p, unsigned v) { return __hip_atomic_fetch_add(p, v, __ATOMIC_RELAXED, __HIP_MEMORY_SCOPE_AGENT); }
__device__ __forceinline__ unsigned xb_xcc_id() { return (unsigned)__builtin_amdgcn_s_getreg((3 << 11) | 20) & 0xFu; }
#define XB_SPIN(cond, bar) do { unsigned _sp = 0; while (cond) { __builtin_amdgcn_s_sleep(1); \
    if ((++_sp & 255u) == 0u) { if (xb_ld(&(bar)[XB_TMO])) break; if (_sp > XB_SPIN_CAP) { atomicAdd(&(bar)[XB_TMO], 1u); break; } } } } while (0)

struct XcdBarrier {
    unsigned* bar; unsigned x;
    volatile LAS unsigned* st;
};

__device__ __forceinline__ XcdBarrier xcd_barrier_post(unsigned* bar, volatile LAS unsigned* st) {
    XcdBarrier b; b.bar = bar; b.x = xb_xcc_id(); b.st = st;
    if (threadIdx.x == 0) (void)xb_add(&bar[XB_XCNT(b.x)], 1u);
    return b;
}
__device__ __forceinline__ void xcd_barrier_complete(unsigned* bar, unsigned x, unsigned& nloc, unsigned& nx) {
    const unsigned G = gridDim.x * gridDim.y * gridDim.z;
    unsigned sum, cnt, mine, sp = 0u;
    for (;;) {
        sum = 0u; cnt = 0u; mine = 0u;
#pragma unroll
        for (unsigned j = 0; j < 16; ++j) { const unsigned c = xb_ld(&bar[XB_XCNT(j)]); sum += c; cnt += (c > 0u) ? 1u : 0u; mine = (j == x) ? c : mine; }
        if (sum == G) break;
        __builtin_amdgcn_s_sleep(1);
        if ((++sp & 255u) == 0u) { if (xb_ld(&bar[XB_TMO])) break; if (sp > XB_SPIN_CAP) { atomicAdd(&bar[XB_TMO], 1u); break; } }
    }
    nloc = mine > 0u ? mine : 1u; nx = cnt > 0u ? cnt : 1u;
}

__device__ __forceinline__ void xcd_barrier(const XcdBarrier& b) {
    asm volatile("s_waitcnt vmcnt(0)" ::: "memory");
    __syncthreads();
    if (threadIdx.x == 0) {
        unsigned* bar = b.bar; unsigned bx_ = b.x; asm volatile("" : "+s"(bar));
        __builtin_amdgcn_s_waitcnt(0);
        unsigned nloc = b.st[0], nx = b.st[1];
        if (nloc == 0u) { xcd_barrier_complete(bar, bx_, nloc, nx); b.st[0] = nloc; b.st[1] = nx; }
        const unsigned old = xb_add(&bar[XB_XSUB(bx_)], 1u);
        const unsigned gen = old / nloc;
        if (old + 1u == (gen + 1u) * nloc) {
            __builtin_amdgcn_fence(__ATOMIC_RELEASE, "agent");
            asm volatile("s_waitcnt vmcnt(0)" ::: "memory");
            const unsigned og = xb_add(&bar[XB_TOP], 1u);
            const unsigned tg = og / nx;
            if (og + 1u == (tg + 1u) * nx) xb_add(&bar[XB_TOPGEN], 1u);
            else XB_SPIN(xb_ld(&bar[XB_TOPGEN]) == tg, bar);
            __builtin_amdgcn_fence(__ATOMIC_ACQUIRE, "agent");
            xb_add(&bar[XB_XGEN(bx_)], 1u);
            asm volatile("s_waitcnt vmcnt(0)" ::: "memory");
        } else {
            XB_SPIN(xb_ld(&bar[XB_XGEN(bx_)]) == gen, bar);
            __builtin_amdgcn_fence(__ATOMIC_ACQUIRE, "agent");
            asm volatile("s_waitcnt vmcnt(0)" ::: "memory");
        }
    }
    __syncthreads();
}

constexpr int NLAT = 16384, NCTXR = 1024, MALL = 17408, DM = 1024, PIN = 2464, PINP = 2560, FF = 4096, KEYS = 4352;
constexpr float EPS = 1e-6f, LOG2E = 1.4426950408889634f;
constexpr float QSCALE = 0.10206207261596575f * 1.4426950408889634f;
constexpr float NA_C2 = 0.125f * 1.4426950408889634f;
constexpr int NWAVES = 8;
constexpr size_t MiB = 1u << 20;
constexpr size_t WS_CTL = 0, CTL_ZERO_BYTES = 64 * 1024;
constexpr size_t WS_MOD = 1 * MiB, WS_RSQ = 1 * MiB + 256 * 1024, WS_RSKV = 1 * MiB + 384 * 1024;
constexpr size_t WS_WIN = 2 * MiB, WS_WOUT = 7 * MiB, WS_W1 = 9 * MiB, WS_W2 = 17 * MiB, WS_WUQ = 25 * MiB, WS_WUKV = 25 * MiB + 256 * 1024, WS_WPW = 25 * MiB + 512 * 1024;
constexpr size_t WS_R0C = 26 * MiB, WS_R1 = 30 * MiB, WS_U = 98 * MiB, WS_Y = 183 * MiB, WS_QM = 217 * MiB, WS_A1 = 98 * MiB, WS_KM = 234 * MiB, WS_VTM = WS_KM + (size_t)16 * 4352 * 96 * 2;
constexpr size_t WS_NVT = WS_R1, WS_SCF = WS_R1 + 16 * MiB;
static_assert(WS_VTM + (size_t)16 * 64 * 4352 * 2 <= 256 * MiB, "ws map");
static_assert(WS_QM + (size_t)MALL * 384 * 2 <= WS_KM && WS_A1 + (size_t)MALL * FF * 2 <= WS_KM, "ws map");
constexpr int CW_BAR = 1024;
constexpr int RING_BYTES = 131072, MISC_OFF = RING_BYTES + 320, LDS_BYTES = 147456;

typedef unsigned v2u __attribute__((ext_vector_type(2)));
typedef float f32x16 __attribute__((ext_vector_type(16)));
__device__ __forceinline__ float bflo(unsigned w) { return __builtin_bit_cast(float, w << 16); }
__device__ __forceinline__ float bfhi(unsigned w) { return __builtin_bit_cast(float, w & 0xffff0000u); }
__device__ __forceinline__ float bf1(bf16 h) { return __builtin_bit_cast(float, (unsigned)h << 16); }
__device__ __forceinline__ float wave_sum(float v) {
#pragma unroll
    for (int o = 1; o < 64; o <<= 1) v += __shfl_xor(v, o);
    return v;
}
__device__ __forceinline__ float sigmoidf_(float x) { return 1.0f / (1.0f + __expf(-x)); }

struct Args { const float* in[25]; float* out; unsigned char* ws; int never; int pad; };

struct Frame {
    LAS unsigned char* lds;
    int tid, lane, wave, vcu, G;
    unsigned char* ws;
};
constexpr int PTAB_OFF = 131072 + 1024;
__device__ __forceinline__ const float* fin(const Frame& F, int i) {
    const volatile LAS unsigned* t = (const volatile LAS unsigned*)(F.lds + PTAB_OFF) + 2 * i;
    const unsigned lo = __builtin_amdgcn_readfirstlane(t[0]), hi = __builtin_amdgcn_readfirstlane(t[1]);
    return (const float*)(((unsigned long long)hi << 32) | lo);
}
__device__ __forceinline__ float* fout(const Frame& F) { return (float*)fin(F, 25); }
__device__ __forceinline__ unsigned char* wsl(const Frame& F) { return F.ws; }

struct AttnDesc { const bf16* q; int qpitch; bf16* o; const bf16* k0; const bf16* k1; const bf16* v0; const bf16* v1; int kpitch; int nseg0; int nt; int cq; int offr0; const LAS float* rpb; };
__device__ __forceinline__ int crow(int r, int hi) { return (r & 3) + 8 * (r >> 2) + 4 * hi; }

template <int DQK, int NGRP, int MODE>
__device__ __forceinline__ void attn_unit(LAS unsigned char* lds, const AttnDesc d) {
    constexpr int KP = DQK + 8, VP = 68, KBYTES = 64 * KP * 2, VBYTES = 64 * VP * 2, TG = 512 / NGRP, NKC = 64 * DQK / 8, NKI = (NKC + TG - 1) / TG, NVI = 512 / TG, CPR = DQK / 8, NKS = DQK / 16;
    int tid_ = threadIdx.x; asm volatile("" : "+v"(tid_));
    const int tid = tid_, lane = tid & 63, r32 = lane & 31, hi = lane >> 5;
    const int g = tid / TG, tg = tid % TG;
    LAS unsigned char* Ks = lds + g * (KBYTES + VBYTES); LAS unsigned char* Vs = Ks + KBYTES;
    bf16x8 qf[NKS];
#pragma unroll
    for (int ks = 0; ks < NKS; ++ks) qf[ks] = *(const bf16x8*)(d.q + (size_t)r32 * d.qpitch + ks * 16 + hi * 8);
    f32x16 o0, o1;
#pragma unroll
    for (int r = 0; r < 16; ++r) { o0[r] = 0.f; o1[r] = 0.f; }
    float mrun = -INFINITY, lrun = 0.f;
    v4u kreg[NKI], vreg[NVI];
#define ATT_LOAD(kt_) do { const int kt__ = (kt_); \
        const bf16* kb_ = kt__ < d.nseg0 ? d.k0 + (size_t)kt__ * 64 * d.kpitch : d.k1 + (size_t)(kt__ - d.nseg0) * 64 * d.kpitch; \
        const bf16* vb_ = kt__ < d.nseg0 ? d.v0 + kt__ * 64 : d.v1 + (kt__ - d.nseg0) * 64; \
        _Pragma("unroll") for (int i = 0; i < NKI; ++i) { const int c = tg + i * TG; if ((NKC % TG == 0) || c < NKC) { const int row = c / CPR, cc = c % CPR; kreg[i] = *(const v4u*)(kb_ + (size_t)row * d.kpitch + cc * 8); } } \
        _Pragma("unroll") for (int i = 0; i < NVI; ++i) { const int c = tg + i * TG; const int row = c >> 3, cc = c & 7; vreg[i] = *(const v4u*)(vb_ + (size_t)row * KEYS + cc * 8); } } while (0)
    ATT_LOAD(0);
    for (int kt = 0; kt < d.nt; ++kt) {
        __syncthreads();
#pragma unroll
        for (int i = 0; i < NKI; ++i) { const int c = tg + i * TG; if ((NKC % TG == 0) || c < NKC) { const int row = c / CPR, cc = c % CPR; *(LAS v4u*)(Ks + row * (KP * 2) + cc * 16) = kreg[i]; } }
#pragma unroll
        for (int i = 0; i < NVI; ++i) { const int c = tg + i * TG; const int row = c >> 3, cc = c & 7; LAS v2u* p = (LAS v2u*)(Vs + row * (VP * 2) + cc * 16); p[0] = (v2u){vreg[i].x, vreg[i].y}; p[1] = (v2u){vreg[i].z, vreg[i].w}; }
        __syncthreads();
        if (kt + 1 < d.nt) ATT_LOAD(kt + 1);
        f32x16 s0, s1;
#pragma unroll
        for (int r = 0; r < 16; ++r) { s0[r] = 0.f; s1[r] = 0.f; }
#pragma unroll
        for (int ks = 0; ks < NKS; ++ks) {
            const bf16x8 kf0 = *(const LAS bf16x8*)(Ks + r32 * (KP * 2) + ks * 32 + hi * 16);
            const bf16x8 kf1 = *(const LAS bf16x8*)(Ks + (32 + r32) * (KP * 2) + ks * 32 + hi * 16);
            s0 = __builtin_amdgcn_mfma_f32_32x32x16_bf16(kf0, qf[ks], s0, 0, 0, 0);
            s1 = __builtin_amdgcn_mfma_f32_32x32x16_bf16(kf1, qf[ks], s1, 0, 0, 0);
        }
        if (MODE == 1) {
#pragma unroll
            for (int r = 0; r < 16; ++r) { s0[r] *= NA_C2; s1[r] *= NA_C2; }
        }
        if (MODE == 2) {
            if (kt < 8) {
                const int cqa = d.cq + r32; const int cs = min(max(cqa - 8, 0), 48);
                const LAS float* rp = d.rpb + (d.offr0 + kt) * 31 + (15 - cqa);
#pragma unroll
                for (int r = 0; r < 16; ++r) {
                    const int ck0 = crow(r, hi), ck1 = 32 + ck0;
                    const bool ok0 = (ck0 >= cs) && (ck0 < cs + 16), ok1 = (ck1 >= cs) && (ck1 < cs + 16);
                    const float b0 = ok0 ? rp[ck0] : 0.f, b1 = ok1 ? rp[ck1] : 0.f;
                    s0[r] = ok0 ? s0[r] * NA_C2 + b0 : -INFINITY; s1[r] = ok1 ? s1[r] * NA_C2 + b1 : -INFINITY;
                }
            } else {
#pragma unroll
                for (int r = 0; r < 16; ++r) { s0[r] *= NA_C2; s1[r] *= NA_C2; }
            }
        }
        float mx = fmaxf(s0[0], s1[0]);
#pragma unroll
        for (int r = 1; r < 16; ++r) mx = fmaxf(mx, fmaxf(s0[r], s1[r]));
        mx = fmaxf(mx, __shfl_xor(mx, 32));
        const float mnew = fmaxf(mrun, mx);
        const float alpha = __builtin_amdgcn_exp2f(mrun - mnew);
        mrun = mnew;
        float ps = 0.f;
#pragma unroll
        for (int r = 0; r < 16; ++r) { s0[r] = __builtin_amdgcn_exp2f(s0[r] - mnew); s1[r] = __builtin_amdgcn_exp2f(s1[r] - mnew); ps += s0[r] + s1[r]; }
        lrun = lrun * alpha + ps;
#pragma unroll
        for (int r = 0; r < 16; ++r) { o0[r] *= alpha; o1[r] *= alpha; }
        bf16x8 pf[2][2];
#pragma unroll
        for (int sp = 0; sp < 2; ++sp) {
            v4u w0, w1;
            w0.x = pg8::cvt_pk_bf16(s0[8 * sp + 0], s0[8 * sp + 1]); w0.y = pg8::cvt_pk_bf16(s0[8 * sp + 2], s0[8 * sp + 3]); w0.z = pg8::cvt_pk_bf16(s0[8 * sp + 4], s0[8 * sp + 5]); w0.w = pg8::cvt_pk_bf16(s0[8 * sp + 6], s0[8 * sp + 7]);
            w1.x = pg8::cvt_pk_bf16(s1[8 * sp + 0], s1[8 * sp + 1]); w1.y = pg8::cvt_pk_bf16(s1[8 * sp + 2], s1[8 * sp + 3]); w1.z = pg8::cvt_pk_bf16(s1[8 * sp + 4], s1[8 * sp + 5]); w1.w = pg8::cvt_pk_bf16(s1[8 * sp + 6], s1[8 * sp + 7]);
            pf[0][sp] = __builtin_bit_cast(bf16x8, w0); pf[1][sp] = __builtin_bit_cast(bf16x8, w1);
        }
#pragma unroll
        for (int sub = 0; sub < 2; ++sub)
#pragma unroll
            for (int sp = 0; sp < 2; ++sp) {
                const int koff = (sub * 32 + 16 * sp + 4 * hi) * 2;
                const LAS v2u* pa = (const LAS v2u*)(Vs + r32 * (VP * 2) + koff);
                const LAS v2u* pb = (const LAS v2u*)(Vs + (32 + r32) * (VP * 2) + koff);
                const v2u a0 = pa[0], a1 = pa[2], b0 = pb[0], b1 = pb[2];
                const bf16x8 vf0 = __builtin_bit_cast(bf16x8, (v4u){a0.x, a0.y, a1.x, a1.y});
                const bf16x8 vf1 = __builtin_bit_cast(bf16x8, (v4u){b0.x, b0.y, b1.x, b1.y});
                o0 = __builtin_amdgcn_mfma_f32_32x32x16_bf16(vf0, pf[sub][sp], o0, 0, 0, 0);
                o1 = __builtin_amdgcn_mfma_f32_32x32x16_bf16(vf1, pf[sub][sp], o1, 0, 0, 0);
            }
    }
#undef ATT_LOAD
    const float ltot = lrun + __shfl_xor(lrun, 32);
    const float inv = 1.0f / ltot;
    bf16* orow = d.o + (size_t)r32 * 1024 + 4 * hi;
#pragma unroll
    for (int g4 = 0; g4 < 4; ++g4) {
        v2u w; w.x = pg8::cvt_pk_bf16(o0[4 * g4 + 0] * inv, o0[4 * g4 + 1] * inv); w.y = pg8::cvt_pk_bf16(o0[4 * g4 + 2] * inv, o0[4 * g4 + 3] * inv);
        *(v2u*)(orow + 8 * g4) = w;
        v2u x; x.x = pg8::cvt_pk_bf16(o1[4 * g4 + 0] * inv, o1[4 * g4 + 1] * inv); x.y = pg8::cvt_pk_bf16(o1[4 * g4 + 2] * inv, o1[4 * g4 + 3] * inv);
        *(v2u*)(orow + 32 + 8 * g4) = x;
    }
}

__device__ __forceinline__ void p0_transpose_item(const float* W, int K, int N, bf16* WT, int row_off, LAS float* scr, int item, int lane) {
    const int nblk = N / 32, kb = item / nblk, nb = item % nblk, k0 = 64 * kb, n0 = 32 * nb;
#pragma unroll 8
    for (int i = 0; i < 32; ++i) { const int kk = 2 * i + (lane >> 5); scr[kk * 33 + (lane & 31)] = W[(size_t)(k0 + kk) * N + n0 + (lane & 31)]; }
    LDS_WAIT(); asm volatile("" ::: "memory");
    const int c = lane & 7;
#pragma unroll
    for (int j = 0; j < 4; ++j) { const int n = (lane >> 3) + 8 * j; const LAS float* s = scr + (8 * c) * 33 + n;
        v4u o; o.x = pk2(s[0 * 33], s[1 * 33]); o.y = pk2(s[2 * 33], s[3 * 33]); o.z = pk2(s[4 * 33], s[5 * 33]); o.w = pk2(s[6 * 33], s[7 * 33]);
        *(v4u*)(WT + (size_t)(row_off + n0 + n) * K + k0 + 8 * c) = o; }
    LDS_WAIT(); asm volatile("" ::: "memory");
}
__device__ __forceinline__ void convert_weights(Frame& F, int L) {
    unsigned char* const ws_ = wsl(F);
    LAS float* scr = (LAS float*)(F.lds + F.wave * 16384);
    const int gw = F.vcu * NWAVES + F.wave, NGW = F.G * NWAVES;
    const float* w_in = fin(F, 7) + (size_t)L * DM * PIN; const float* w_out = fin(F, 19) + (size_t)L * DM * DM;
    const float* w1 = fin(F, 22) + (size_t)L * DM * FF; const float* w2 = fin(F, 23) + (size_t)L * FF * DM;
    bf16* WIN = (bf16*)(ws_ + WS_WIN); bf16* WOUT = (bf16*)(ws_ + WS_WOUT); bf16* W1 = (bf16*)(ws_ + WS_W1); bf16* W2 = (bf16*)(ws_ + WS_W2);
    constexpr int I_IN = (DM / 64) * (PIN / 32), I_O = (DM / 64) * (DM / 32), I_1 = (DM / 64) * (FF / 32), I_2 = (FF / 64) * (DM / 32);
    constexpr int NITEMS = I_IN + I_O + I_1 + I_2;
    for (int it = gw; it < NITEMS; it += NGW) {
        int r = it;
        if (r < I_IN) { p0_transpose_item(w_in, DM, PIN, WIN, 0, scr, r, F.lane); continue; } r -= I_IN;
        if (r < I_O) { p0_transpose_item(w_out, DM, DM, WOUT, 0, scr, r, F.lane); continue; } r -= I_O;
        if (r < I_1) { p0_transpose_item(w1, DM, FF, W1, 0, scr, r, F.lane); continue; } r -= I_1;
        p0_transpose_item(w2, FF, DM, W2, 0, scr, r, F.lane);
    }
    const float* w_uq = fin(F, 10) + (size_t)L * 256 * 384; const float* g_q = fin(F, 9) + L * 256;
    const float* w_ukv = fin(F, 12) + (size_t)L * 128 * 512; const float* g_kv = fin(F, 11) + L * 128;
    const float* w_pw = fin(F, 17) + (size_t)L * 256 * 256;
    bf16* WUQ = (bf16*)(ws_ + WS_WUQ); bf16* WUKV = (bf16*)(ws_ + WS_WUKV); bf16* WPW = (bf16*)(ws_ + WS_WPW);
    const int gt = F.vcu * 512 + F.tid, NGT = F.G * 512;
    constexpr int E_UQ = 512 * 256, E_UKV = 512 * 256, E_PW = 256 * 256, E_PAD = (PINP - PIN) * DM;
    for (int e = gt; e < E_UQ + E_UKV + E_PW + E_PAD; e += NGT) {
        int r = e;
        if (r < E_UQ) { const int n = r >> 8, k = r & 255; float v = 0.f;
            if (n < 384) { const int head = n / 96, d = n % 96; int od = d;
                if (d >= 64) { const int j = d - 64; od = 64 + (j < 16 ? (j & 1) * 8 + (j >> 1) : 16 + ((j - 16) & 1) * 8 + ((j - 16) >> 1)); }
                v = w_uq[(size_t)k * 384 + head * 96 + od] * g_q[k]; }
            WUQ[r] = (bf16)f2bf(v); continue; } r -= E_UQ;
        if (r < E_UKV) { const int n = r >> 8, k = r & 255; float v = 0.f; if (k < 128) v = w_ukv[(size_t)k * 512 + n] * g_kv[k]; WUKV[r] = (bf16)f2bf(v); continue; } r -= E_UKV;
        if (r < E_PW) { const int n = r >> 8, k = r & 255; WPW[r] = (bf16)f2bf(w_pw[(size_t)k * 256 + n]); continue; } r -= E_PW;
        WIN[(size_t)PIN * DM + r] = 0;
    }
}
__device__ __forceinline__ void mod_gemv(Frame& F) {
    unsigned char* const ws_ = wsl(F);
    LAS float* red = (LAS float*)F.lds;
    float* MOD = (float*)(ws_ + WS_MOD);
    const float* c = fin(F, 1); const float* cctx = fin(F, 3);
    for (int unit = F.vcu; unit < 192; unit += F.G) {
        const int L = unit / 96, n0 = (unit % 96) * 64;
        const float* W = fin(F, 4) + (size_t)L * DM * 6144; const float* bm = fin(F, 5) + L * 6144;
        const int cg = F.tid & 15, ks = F.tid >> 4;
        float acc[5][4];
#pragma unroll
        for (int v = 0; v < 5; ++v)
#pragma unroll
            for (int e = 0; e < 4; ++e) acc[v][e] = 0.f;
        for (int kk = 0; kk < 32; ++kk) { const int k = ks * 32 + kk;
            const f32x4 w = *(const f32x4*)(W + (size_t)k * 6144 + n0 + cg * 4);
#pragma unroll
            for (int v = 0; v < 5; ++v) { const float cv = v < 4 ? c[v * DM + k] : cctx[k]; const float s = cv * sigmoidf_(cv);
#pragma unroll
                for (int e = 0; e < 4; ++e) acc[v][e] += s * w[e]; } }
        __syncthreads();
#pragma unroll
        for (int v = 0; v < 5; ++v)
#pragma unroll
            for (int e = 0; e < 4; ++e) red[(ks * 5 + v) * 64 + cg * 4 + e] = acc[v][e];
        __syncthreads();
        if (F.tid < 320) { const int v = F.tid >> 6, col = F.tid & 63; float s = 0.f;
            for (int j = 0; j < 32; ++j) s += red[(j * 5 + v) * 64 + col];
            MOD[((size_t)L * 5 + v) * 6144 + n0 + col] = s + bm[n0 + col]; }
        __syncthreads();
    }
}

__device__ __forceinline__ const float* xrow_src(Frame& F, int L, int row) {
    if (L == 0) return row < NLAT ? fin(F, 0) + (size_t)row * DM : fin(F, 2) + (size_t)(row - NLAT) * DM;
    return row < NLAT ? fout(F) + (size_t)row * DM : (const float*)(F.ws + WS_R0C) + (size_t)(row - NLAT) * DM;
}
__device__ __forceinline__ float* r0row(Frame& F, int row) { return row < NLAT ? fout(F) + (size_t)row * DM : (float*)(F.ws + WS_R0C) + (size_t)(row - NLAT) * DM; }
__device__ __forceinline__ void load_row(const float* p, int lane, f32x4 (&v)[4]) {
#pragma unroll
    for (int j = 0; j < 4; ++j) v[j] = *(const f32x4*)(p + 4 * lane + 256 * j);
}
__device__ __forceinline__ float row_rstd(const f32x4 (&v)[4]) {
    float s = 0.f;
#pragma unroll
    for (int j = 0; j < 4; ++j) s += (v[j].x * v[j].x + v[j].y * v[j].y) + (v[j].z * v[j].z + v[j].w * v[j].w);
    return 1.0f / sqrtf(wave_sum(s) * (1.0f / DM) + EPS);
}
__device__ __forceinline__ void write_modnorm(const f32x4 (&x)[4], float rstd, const float* g, const float* sc, const float* sh, bf16* dst, int lane) {
#pragma unroll
    for (int j = 0; j < 4; ++j) { const int c = 4 * lane + 256 * j;
        const f32x4 gv = *(const f32x4*)(g + c), scv = *(const f32x4*)(sc + c), shv = *(const f32x4*)(sh + c);
        const f32x4 h = (x[j] * rstd * gv) * (scv + 1.0f) + shv;
        v2u w; w.x = pk2(h.x, h.y); w.y = pk2(h.z, h.w);
        *(v2u*)(dst + c) = w; }
}
__device__ __forceinline__ void pass_prep(Frame& F, int L) {
    unsigned char* const ws_ = wsl(F);
    const int gw = F.vcu * NWAVES + F.wave, NGW = F.G * NWAVES;
    const float* MOD = (const float*)(ws_ + WS_MOD) + (size_t)L * 5 * 6144;
    const float* g = fin(F, 6) + L * DM;
    for (int row = gw; row < MALL; row += NGW) {
        f32x4 x[4]; load_row(xrow_src(F, L, row), F.lane, x);
        const float rstd = row_rstd(x);
        const float* mv = MOD + (row < NLAT ? (row >> 12) : 4) * 6144;
        write_modnorm(x, rstd, g, mv + 1024, mv + 0, (bf16*)(ws_ + WS_R1 + (size_t)row * 4096), F.lane);
    }
}
__device__ __forceinline__ void pass_postwo(Frame& F, int L, int nrows) {
    unsigned char* const ws_ = wsl(F);
    const int gw = F.vcu * NWAVES + F.wave, NGW = F.G * NWAVES;
    const float* MOD = (const float*)(ws_ + WS_MOD) + (size_t)L * 5 * 6144;
    const float* gpost = fin(F, 20) + L * DM; const float* gpre = fin(F, 21) + L * DM;
    for (int row = gw; row < nrows; row += NGW) {
        float* yrow = (float*)(ws_ + WS_R1 + (size_t)row * 4096);
        f32x4 y[4], x[4]; load_row(yrow, F.lane, y); load_row(xrow_src(F, L, row), F.lane, x);
        const float ry = row_rstd(y);
        const float* mv = MOD + (row < NLAT ? (row >> 12) : 4) * 6144;
#pragma unroll
        for (int j = 0; j < 4; ++j) { const int c = 4 * F.lane + 256 * j;
            const f32x4 gv = *(const f32x4*)(gpost + c), ga = *(const f32x4*)(mv + 2048 + c);
            x[j] = x[j] + ga * (y[j] * ry * gv); }
        float* xo = r0row(F, row);
#pragma unroll
        for (int j = 0; j < 4; ++j) *(f32x4*)(xo + 4 * F.lane + 256 * j) = x[j];
        const float r1 = row_rstd(x);
        write_modnorm(x, r1, gpre, mv + 4096, mv + 3072, (bf16*)yrow, F.lane);
    }
}
__device__ __forceinline__ void pass_postmlp(Frame& F, int L, int nrows) {
    unsigned char* const ws_ = wsl(F);
    const int gw = F.vcu * NWAVES + F.wave, NGW = F.G * NWAVES;
    const float* MOD = (const float*)(ws_ + WS_MOD) + (size_t)L * 5 * 6144;
    const float* gpost = fin(F, 24) + L * DM;
    for (int row = gw; row < nrows; row += NGW) {
        float* mrow = (float*)(ws_ + WS_R1 + (size_t)row * 4096);
        float* xo = r0row(F, row);
        f32x4 y[4], x[4]; load_row(mrow, F.lane, y); load_row(xo, F.lane, x);
        const float ry = row_rstd(y);
        const float* mv = MOD + (row < NLAT ? (row >> 12) : 4) * 6144;
#pragma unroll
        for (int j = 0; j < 4; ++j) { const int c = 4 * F.lane + 256 * j;
            const f32x4 gv = *(const f32x4*)(gpost + c), ga = *(const f32x4*)(mv + 5120 + c);
            x[j] = x[j] + ga * (y[j] * ry * gv); }
#pragma unroll
        for (int j = 0; j < 4; ++j) *(f32x4*)(xo + 4 * F.lane + 256 * j) = x[j];
        if (L == 0) {
            const float* mv1 = mv + 5 * 6144;
            const float r1 = row_rstd(x);
            write_modnorm(x, r1, fin(F, 6) + DM, mv1 + 1024, mv1 + 0, (bf16*)mrow, F.lane);
        }
    }
}

__device__ __forceinline__ void row_bk(int row, int& b, int& kk) { if (row < NLAT) { b = row >> 12; kk = row & 4095; } else { const int r2 = row - NLAT; b = r2 >> 8; kk = 4096 + (r2 & 255); } }
__device__ __forceinline__ void pass_mix(Frame& F, int L) {
    unsigned char* const ws_ = wsl(F);
    const bf16* U = (const bf16*)(ws_ + WS_U); bf16* Y = (bf16*)(ws_ + WS_Y);
    {
        const float* wsc = fin(F, 8) + L * 3 * 256;
        const int gt = F.vcu * 512 + F.tid, NGT = F.G * 512;
        for (int idx = gt; idx < MALL * 32; idx += NGT) {
            const int row = idx >> 5, c8 = idx & 31;
            int t, len; if (row < NLAT) { t = row & 4095; len = 4096; } else { t = (row - NLAT) & 255; len = 256; }
            const bf16* ur = U + (size_t)row * PINP + c8 * 8;
            float acc[8];
#pragma unroll
            for (int e = 0; e < 8; ++e) acc[e] = 0.f;
#pragma unroll
            for (int k = 0; k < 3; ++k) { const int tt = t + k - 1; if (tt < 0 || tt >= len) continue;
                const bf16* up = ur + (ptrdiff_t)(k - 1) * PINP;
                const v4u xi = *(const v4u*)(up), cg = *(const v4u*)(up + 512);
                const f32x4 w0 = *(const f32x4*)(wsc + k * 256 + c8 * 8), w1 = *(const f32x4*)(wsc + k * 256 + c8 * 8 + 4);
                acc[0] += w0.x * (bflo(xi.x) * bflo(cg.x)); acc[1] += w0.y * (bfhi(xi.x) * bfhi(cg.x));
                acc[2] += w0.z * (bflo(xi.y) * bflo(cg.y)); acc[3] += w0.w * (bfhi(xi.y) * bfhi(cg.y));
                acc[4] += w1.x * (bflo(xi.z) * bflo(cg.z)); acc[5] += w1.y * (bfhi(xi.z) * bfhi(cg.z));
                acc[6] += w1.z * (bflo(xi.w) * bflo(cg.w)); acc[7] += w1.w * (bfhi(xi.w) * bfhi(cg.w)); }
            const v4u bg = *(const v4u*)(ur + 256);
            v4u o; o.x = pk2(acc[0] * bflo(bg.x), acc[1] * bfhi(bg.x)); o.y = pk2(acc[2] * bflo(bg.y), acc[3] * bfhi(bg.y));
            o.z = pk2(acc[4] * bflo(bg.z), acc[5] * bfhi(bg.z)); o.w = pk2(acc[6] * bflo(bg.w), acc[7] * bfhi(bg.w));
            *(v4u*)(Y + (size_t)row * DM + c8 * 8) = o;
        }
    }
    {
        const int gw = F.vcu * NWAVES + F.wave, NGW = F.G * NWAVES;
        float* RSQ = (float*)(ws_ + WS_RSQ); float* RSKV = (float*)(ws_ + WS_RSKV); bf16* KM = (bf16*)(ws_ + WS_KM);
        for (int row = gw; row < MALL; row += NGW) {
            const bf16* ur = U + (size_t)row * PINP;
            float sq = 0.f, skv = 0.f;
            if (F.lane < 48) { const v4u w = *(const v4u*)(ur + 768 + F.lane * 8);
                float s = bflo(w.x) * bflo(w.x) + bfhi(w.x) * bfhi(w.x) + bflo(w.y) * bflo(w.y) + bfhi(w.y) * bfhi(w.y) + bflo(w.z) * bflo(w.z) + bfhi(w.z) * bfhi(w.z) + bflo(w.w) * bflo(w.w) + bfhi(w.w) * bfhi(w.w);
                if (F.lane < 32) sq = s; else skv = s; }
            sq = wave_sum(sq); skv = wave_sum(skv);
            if (F.lane == 0) { RSQ[row] = 1.0f / sqrtf(sq * (1.0f / 256.0f) + EPS); RSKV[row] = 1.0f / sqrtf(skv * (1.0f / 128.0f) + EPS); }
            if (F.lane < 16) { const int part = F.lane >> 3, i = F.lane & 7;
                float x1 = bf1(ur[1152 + part * 16 + i]), x2 = bf1(ur[1152 + part * 16 + 8 + i]);
                int b, kk; row_bk(row, b, kk);
                if (row < NLAT) { const int t = row & 4095, pos = part ? (t & 63) : (t >> 6); const float c = ROPE_TAB[(pos * 8 + i) * 2], s = ROPE_TAB[(pos * 8 + i) * 2 + 1];
                    const float a = x1 * c - x2 * s, bb = x1 * s + x2 * c; x1 = a; x2 = bb; }
                const unsigned w = pk2(x1, x2);
#pragma unroll
                for (int h = 0; h < 4; ++h) *(unsigned*)(KM + ((size_t)((b * 4 + h) * KEYS + kk)) * 96 + 64 + part * 16 + 2 * i) = w; }
        }
    }
    {
        LAS float* Z = (LAS float*)F.lds;
        LAS float* YL = (LAS float*)(F.lds + 62 * 1024);
        bf16* SCF = (bf16*)(ws_ + WS_SCF);
        const float* wdw = fin(F, 13) + (size_t)L * 31 * 256; const float* bdw = fin(F, 14) + L * 256; const float* lng = fin(F, 15) + L * 256; const float* lnb = fin(F, 16) + L * 256;
        for (int tile = F.vcu; tile < MALL / 32; tile += F.G) {
            const int row0 = tile * 32;
            int t0, len, base; if (row0 < NLAT) { t0 = row0 & 4095; len = 4096; base = row0 - t0; } else { t0 = (row0 - NLAT) & 255; len = 256; base = row0 - t0; }
            __syncthreads();
            for (int idx = F.tid; idx < 62 * 32; idx += 512) { const int tt = idx >> 5, c8 = idx & 31; const int tp = t0 + tt - 15;
                float z[8];
                if (tp >= 0 && tp < len) { const bf16* ur = U + (size_t)(base + tp) * PINP + 1184 + c8 * 8;
                    const v4u a = *(const v4u*)ur, gg = *(const v4u*)(ur + 256);
                    z[0] = bflo(a.x) * sigmoidf_(bflo(gg.x)); z[1] = bfhi(a.x) * sigmoidf_(bfhi(gg.x)); z[2] = bflo(a.y) * sigmoidf_(bflo(gg.y)); z[3] = bfhi(a.y) * sigmoidf_(bfhi(gg.y));
                    z[4] = bflo(a.z) * sigmoidf_(bflo(gg.z)); z[5] = bfhi(a.z) * sigmoidf_(bfhi(gg.z)); z[6] = bflo(a.w) * sigmoidf_(bflo(gg.w)); z[7] = bfhi(a.w) * sigmoidf_(bfhi(gg.w));
                } else {
#pragma unroll
                    for (int e = 0; e < 8; ++e) z[e] = 0.f; }
                *(LAS f32x4*)(Z + tt * 256 + c8 * 8) = (f32x4){z[0], z[1], z[2], z[3]}; *(LAS f32x4*)(Z + tt * 256 + c8 * 8 + 4) = (f32x4){z[4], z[5], z[6], z[7]}; }
            __syncthreads();
            { const int c = F.tid & 255, half = F.tid >> 8; const float bias = bdw[c];
                float acc[16];
#pragma unroll
                for (int i = 0; i < 16; ++i) acc[i] = bias;
                for (int k = 0; k < 31; ++k) { const float w = wdw[k * 256 + c];
#pragma unroll
                    for (int i = 0; i < 16; ++i) acc[i] += w * Z[(half * 16 + i + k) * 256 + c]; }
#pragma unroll
                for (int i = 0; i < 16; ++i) YL[(half * 16 + i) * 256 + c] = acc[i]; }
            __syncthreads();
#pragma unroll
            for (int q = 0; q < 4; ++q) { const int tok = F.wave * 4 + q;
                const f32x4 v = *(const LAS f32x4*)(YL + tok * 256 + F.lane * 4);
                const float mean = wave_sum((v.x + v.y) + (v.z + v.w)) * (1.0f / 256.0f);
                const f32x4 dv = v - mean;
                const float var = wave_sum((dv.x * dv.x + dv.y * dv.y) + (dv.z * dv.z + dv.w * dv.w)) * (1.0f / 256.0f);
                const float rs = 1.0f / sqrtf(var + EPS);
                const f32x4 gv = *(const f32x4*)(lng + F.lane * 4), bv = *(const f32x4*)(lnb + F.lane * 4);
                f32x4 o = dv * rs * gv + bv;
                o.x = o.x * sigmoidf_(o.x); o.y = o.y * sigmoidf_(o.y); o.z = o.z * sigmoidf_(o.z); o.w = o.w * sigmoidf_(o.w);
                v2u w; w.x = pk2(o.x, o.y); w.y = pk2(o.z, o.w);
                *(v2u*)(SCF + (size_t)(row0 + tok) * 256 + F.lane * 4) = w; }
        }
        __syncthreads();
    }
    {
        const int gw = F.vcu * NWAVES + F.wave, NGW = F.G * NWAVES;
        bf16* NVT = (bf16*)(ws_ + WS_NVT);
        for (int task = gw; task < (MALL / 64) * 32; task += NGW) {
            const int kb = task >> 5, ch = task & 31, h = ch >> 3, dv0 = (ch & 7) * 8;
            const int row = kb * 64 + F.lane; int b, kk; row_bk(row, b, kk);
            const v4u w = *(const v4u*)(U + (size_t)row * PINP + 2208 + ch * 8);
            bf16* vp = NVT + ((size_t)((b * 4 + h) * 64 + dv0)) * KEYS + kk;
            vp[0 * KEYS] = (bf16)(w.x & 0xffffu); vp[1 * KEYS] = (bf16)(w.x >> 16); vp[2 * KEYS] = (bf16)(w.y & 0xffffu); vp[3 * KEYS] = (bf16)(w.y >> 16);
            vp[4 * KEYS] = (bf16)(w.z & 0xffffu); vp[5 * KEYS] = (bf16)(w.z >> 16); vp[6 * KEYS] = (bf16)(w.w & 0xffffu); vp[7 * KEYS] = (bf16)(w.w >> 16);
        }
    }
}

__device__ __forceinline__ void pass_attn(Frame& F, int L) {
    unsigned char* const ws_ = wsl(F);
    const bf16* U = (const bf16*)(ws_ + WS_U); bf16* Y = (bf16*)(ws_ + WS_Y);
    const bf16* QM = (const bf16*)(ws_ + WS_QM); const bf16* KM = (const bf16*)(ws_ + WS_KM); const bf16* VTM = (const bf16*)(ws_ + WS_VTM); const bf16* NVT = (const bf16*)(ws_ + WS_NVT);
    for (int u = F.vcu; u < 256; u += F.G) {
        const int b = u >> 6, h = (u >> 4) & 3, qb = u & 15; const int row = b * 4096 + qb * 256 + F.wave * 32;
        AttnDesc d; d.q = QM + (size_t)row * 384 + h * 96; d.qpitch = 384; d.o = Y + (size_t)row * DM + 256 + h * 64;
        d.k0 = KM + (size_t)((b * 4 + h) * KEYS) * 96; d.k1 = d.k0; d.kpitch = 96; d.nseg0 = 68; d.nt = 68;
        d.v0 = VTM + (size_t)((b * 4 + h) * 64) * KEYS; d.v1 = d.v0; d.cq = 0; d.offr0 = 0; d.rpb = nullptr;
        attn_unit<96, 1, 0>(F.lds, d);
    }
    {
        LAS float* RP = (LAS float*)(F.lds + 4 * (64 * 72 * 2 + 64 * 68 * 2));
        const float* rpb = fin(F, 18) + (size_t)L * 4 * 15 * 31;
        __syncthreads();
        for (int i = F.tid; i < 4 * 15 * 31; i += 512) RP[i] = rpb[i] * LOG2E;
        for (int u = F.vcu; u < 256; u += F.G) {
            const int b = u >> 6, r = u & 63, h = F.wave >> 1, half = F.wave & 1; const int row = b * 4096 + r * 64 + half * 32;
            const int rs = min(max(r - 4, 0), 56);
            AttnDesc d; d.q = U + (size_t)row * PINP + 1696 + h * 64; d.qpitch = PINP; d.o = Y + (size_t)row * DM + 768 + h * 64;
            d.k0 = U + (size_t)(b * 4096 + rs * 64) * PINP + 1952 + h * 64; d.k1 = U + (size_t)(NLAT + b * 256) * PINP + 1952 + h * 64; d.kpitch = PINP; d.nseg0 = 8; d.nt = 12;
            d.v0 = NVT + (size_t)((b * 4 + h) * 64) * KEYS + rs * 64; d.v1 = NVT + (size_t)((b * 4 + h) * 64) * KEYS + 4096;
            d.cq = half * 32; d.offr0 = rs - r + 7; d.rpb = RP + h * 465;
            attn_unit<64, 4, 2>(F.lds, d);
        }
    }
    if (L == 0) {
        for (int u = F.vcu; u < 32; u += F.G) {
            const int bh = u & 15, b = bh >> 2, h = bh & 3; const int row = NLAT + b * 256 + F.wave * 32;
            AttnDesc d; d.cq = 0; d.offr0 = 0; d.rpb = nullptr; d.nseg0 = 4; d.nt = 4;
            if (u < 16) {
                d.q = QM + (size_t)row * 384 + h * 96; d.qpitch = 384; d.o = Y + (size_t)row * DM + 256 + h * 64;
                d.k0 = KM + (size_t)((b * 4 + h) * KEYS + 4096) * 96; d.k1 = d.k0; d.kpitch = 96;
                d.v0 = VTM + (size_t)((b * 4 + h) * 64) * KEYS + 4096; d.v1 = d.v0;
                attn_unit<96, 1, 0>(F.lds, d);
            } else {
                d.q = U + (size_t)row * PINP + 1696 + h * 64; d.qpitch = PINP; d.o = Y + (size_t)row * DM + 768 + h * 64;
                d.k0 = U + (size_t)(NLAT + b * 256) * PINP + 1952 + h * 64; d.k1 = d.k0; d.kpitch = PINP;
                d.v0 = NVT + (size_t)((b * 4 + h) * 64) * KEYS + 4096; d.v1 = d.v0;
                attn_unit<64, 1, 1>(F.lds, d);
            }
        }
    }
    __syncthreads();
}

__global__ void __launch_bounds__(NWAVES * 64, 2) hybrid_fwd(Args args) {
    extern __shared__ __attribute__((aligned(16))) unsigned char lds[];
    Frame F0;
    F0.lds = (LAS unsigned char*)lds;
    F0.tid = 0; F0.lane = 0; F0.wave = __builtin_amdgcn_readfirstlane((int)threadIdx.x >> 6);
    F0.G = gridDim.x; { const int bx = blockIdx.x; F0.vcu = (F0.G % 8 == 0) ? (bx % 8) * (F0.G / 8) + bx / 8 : bx; }
    F0.ws = args.ws;
    if (args.never) cooperative_groups::this_grid().sync();
    volatile LAS unsigned* MISC = (volatile LAS unsigned*)(F0.lds + MISC_OFF);
    for (int u = threadIdx.x; u < (LDS_BYTES - RING_BYTES) / 4; u += NWAVES * 64) ((LAS unsigned*)(F0.lds + RING_BYTES))[u] = 0u;
    __syncthreads();
    if (threadIdx.x == 0) { LAS unsigned* t = (LAS unsigned*)(F0.lds + PTAB_OFF);
#pragma unroll
        for (int i = 0; i < 25; ++i) { const unsigned long long p = (unsigned long long)args.in[i]; t[2 * i] = (unsigned)p; t[2 * i + 1] = (unsigned)(p >> 32); }
        const unsigned long long po = (unsigned long long)args.out; t[50] = (unsigned)po; t[51] = (unsigned)(po >> 32); }
    __syncthreads();
    unsigned* ctl = (unsigned*)(F0.ws + WS_CTL);
    XcdBarrier bar = xcd_barrier_post(ctl + CW_BAR, MISC + 8);
#define GRID_BAR() xcd_barrier(bar)
    const int bx0 = (int)blockIdx.x;

#define MKFRAME() Frame F = F0; int bx = bx0; { int t_ = threadIdx.x; asm volatile("" : "+v"(t_)); F.tid = t_; F.lane = t_ & 63; } \
        asm volatile("" : "+s"(F.wave), "+s"(F.vcu), "+s"(F.G), "+s"(F.ws), "+s"(bx)); LAS unsigned char* ring = F.lds; (void)ring; (void)bx
    constexpr int NPH = 20;
#pragma nounroll
    for (int ph = 0; ph < NPH; ++ph) {
        const int kind = ph < 2 ? ph : 2 + (ph - 2) % 9, L = ph < 2 ? 0 : (ph - 2) / 9;
        const int MR = (L == 0) ? MALL : NLAT;
        if (kind == 0) { MKFRAME(); mod_gemv(F); convert_weights(F, 0); }
        if (kind == 1) { MKFRAME(); pass_prep(F, 0); }
        if (kind == 3) { MKFRAME(); pass_mix(F, L); }
        if (kind == 4) {
            MKFRAME(); unsigned char* const ws_ = wsl(F);
            { pg8::Gemm g{(const pg8::bf16_t*)(ws_ + WS_U) + 768, (const pg8::bf16_t*)(ws_ + WS_WUQ), MALL, 512, 256, PINP}; pg8::StaticOrder S; S.init(MALL, 512, F.G, bx);
              pg8::EpiUQ E{(pg8::bf16_t*)(ws_ + WS_QM), (const float*)(ws_ + WS_RSQ), ROPE_TAB, QSCALE};
              pg8::gemm_phase<pg8::EpiUQ, pg8::StaticOrder, true, true>(ring, g, S, E); }
            { pg8::Gemm g{(const pg8::bf16_t*)(ws_ + WS_U) + 1024, (const pg8::bf16_t*)(ws_ + WS_WUKV), MALL, 512, 256, PINP}; pg8::StaticOrder S; S.init(MALL, 512, F.G, (bx + 136) % F.G);
              pg8::EpiUKV E{(pg8::bf16_t*)(ws_ + WS_KM), (pg8::bf16_t*)(ws_ + WS_VTM), (const float*)(ws_ + WS_RSKV)};
              pg8::gemm_phase<pg8::EpiUKV, pg8::StaticOrder, true, true>(ring, g, S, E); }
        }
        if (kind == 2 || kind == 4 || kind == 8) {
            MKFRAME(); unsigned char* const ws_ = wsl(F);
            pg8::Gemm g; pg8::EpiBf16 E; int c = bx;
            if (kind == 2) { g = pg8::Gemm{(const pg8::bf16_t*)(ws_ + WS_R1), (const pg8::bf16_t*)(ws_ + WS_WIN), MALL, PINP, DM, 2048}; E = pg8::EpiBf16{(pg8::bf16_t*)(ws_ + WS_U), PINP, 0}; }
            else if (kind == 4) { g = pg8::Gemm{(const pg8::bf16_t*)(ws_ + WS_SCF), (const pg8::bf16_t*)(ws_ + WS_WPW), MALL, 256, 256, 256}; E = pg8::EpiBf16{(pg8::bf16_t*)(ws_ + WS_Y) + 512, DM, 0}; c = (bx + 16) % F.G; }
            else { g = pg8::Gemm{(const pg8::bf16_t*)(ws_ + WS_R1), (const pg8::bf16_t*)(ws_ + WS_W1), MR, FF, DM, 2048}; E = pg8::EpiBf16{(pg8::bf16_t*)(ws_ + WS_A1), FF, 2}; }
            pg8::StaticOrder S; S.init(g.M, g.N, F.G, c);
            pg8::gemm_phase<pg8::EpiBf16, pg8::StaticOrder, true, true>(ring, g, S, E);
        }
        if (kind == 5) { MKFRAME(); pass_attn(F, L); }
        if (kind == 6 || kind == 9) {
            MKFRAME(); unsigned char* const ws_ = wsl(F);
            pg8::Gemm g;
            if (kind == 6) g = pg8::Gemm{(const pg8::bf16_t*)(ws_ + WS_Y), (const pg8::bf16_t*)(ws_ + WS_WOUT), MR, DM, DM, DM};
            else g = pg8::Gemm{(const pg8::bf16_t*)(ws_ + WS_A1), (const pg8::bf16_t*)(ws_ + WS_W2), MR, DM, FF, FF};
            pg8::StaticOrder S; S.init(g.M, g.N, F.G, bx);
            pg8::EpiF32 E{(float*)(ws_ + WS_R1), DM};
            pg8::gemm_phase<pg8::EpiF32, pg8::StaticOrder, true, true>(ring, g, S, E);
        }
        if (kind == 7) { MKFRAME(); pass_postwo(F, L, MR); }
        if (kind == 10) { MKFRAME(); pass_postmlp(F, L, MR); if (L == 0) convert_weights(F, 1); }
        if (ph + 1 < NPH) GRID_BAR();
    }
#undef GRID_BAR
}

extern "C" void kernel_launch(void* const* d_in, const int* in_sizes, int n_in, void* d_out, int out_size, void* d_ws, size_t ws_size, hipStream_t stream) {
    static int grid = 0;
    if (grid == 0) {
        if (n_in != 25 || out_size != NLAT * DM || ws_size < 256 * MiB) { fprintf(stderr, "kernel_launch: unexpected shapes (n_in %d out %d ws %zu)\n", n_in, out_size, ws_size); grid = -1; return; }
        int dev = 0, cus = 0;
        if (hipGetDevice(&dev) != hipSuccess || hipDeviceGetAttribute(&cus, hipDeviceAttributeMultiprocessorCount, dev) != hipSuccess) { grid = -1; return; }
        if (hipFuncSetAttribute((const void*)hybrid_fwd, hipFuncAttributeMaxDynamicSharedMemorySize, LDS_BYTES) != hipSuccess) { fprintf(stderr, "kernel_launch: hipFuncSetAttribute failed\n"); grid = -1; return; }
        (void)hipGetLastError();
        grid = cus;
    }
    if (grid < 0) return;
    if (hipMemsetAsync((char*)d_ws + WS_CTL, 0, CTL_ZERO_BYTES, stream) != hipSuccess) { fprintf(stderr, "kernel_launch: memset failed\n"); return; }
    Args a{};
    for (int i = 0; i < 25; ++i) a.in[i] = (const float*)d_in[i];
    a.out = (float*)d_out; a.ws = (unsigned char*)d_ws; a.never = 0; a.pad = 0;
    void* kargs[] = {&a};
    hipError_t e = hipLaunchCooperativeKernel((const void*)hybrid_fwd, dim3(grid), dim3(NWAVES * 64), kargs, LDS_BYTES, stream);
    if (e != hipSuccess) fprintf(stderr, "kernel_launch: cooperative launch failed: %s (grid %d)\n", hipGetErrorString(e), grid);
}
```

```cpp
#include <hip/hip_runtime.h>
#include <cstdio>
#include <cstdint>
#include <hip/hip_cooperative_groups.h>
namespace pg8 {
#define PG8_LAS __attribute__((address_space(3)))
typedef unsigned short bf16_t;
typedef short bf16x8 __attribute__((ext_vector_type(8)));
typedef float f32x4 __attribute__((ext_vector_type(4)));
typedef unsigned u32x4 __attribute__((ext_vector_type(4)));
constexpr int BM = 256, BK = 64, HALF = 128, HTB = HALF * BK * 2  , STAGE_BYTES = 8 * HTB, NXCD = 8, WGM = 8;

__host__ __device__ __forceinline__ int lds_byte(int r, int c) { const int st = (r >> 4) * 2 + (c >> 5), rr = r & 15, cc = c & 31, ob = rr * 64 + cc * 2; return st * 1024 + (ob ^ (((ob >> 9) & 1) << 5)); }
__host__ __device__ __forceinline__ void stage_rc(int b, int& R, int& C) { const int st = b / 1024, sb = b % 1024, swz = sb ^ (((sb >> 9) & 1) << 5); R = (st >> 1) * 16 + swz / 64; C = (st & 1) * 32 + (swz % 64) / 2; }
__host__ __device__ __forceinline__ int perm32(int rho) { const int n = rho >> 4, i = rho & 15; return 8 * (i >> 2) + 4 * n + (i & 3); }

struct Unit { int pm, pn; };
struct Gemm { const bf16_t* A; const bf16_t* Bt; int M, N, K, lda, ldb; };

struct StaticOrder {
    int nM, nN, nwg, G, c;
    __host__ __device__ void init(int M, int N, int G_, int c_) { nM = M / BM; nN = N / BM; nwg = nM * nN; G = G_; c = c_; }
    __host__ __device__ bool next(int i, Unit& u) const {
        const long L = (long)i * G + c; if (L >= nwg) return false;
        int wgid = (int)L; { const int q = nwg / NXCD, r = nwg % NXCD, xcd = wgid % NXCD, off = wgid / NXCD; wgid = (xcd < r ? xcd * (q + 1) : r * (q + 1) + (xcd - r) * q) + off; }
        const int nig = WGM * nN, gid = wgid / nig, fm = gid * WGM, gsz = (nM - fm) < WGM ? (nM - fm) : WGM;
        u.pm = fm + ((wgid % nig) % gsz); u.pn = (wgid % nig) / gsz; return true;
    }
    __device__ __forceinline__ void a_ready(const Unit&) const {}
    __device__ __forceinline__ void done(const Unit&) const {}
};

__device__ __forceinline__ unsigned cvt_pk_bf16(float lo, float hi) { unsigned r; asm volatile("v_cvt_pk_bf16_f32 %0, %1, %2" : "=v"(r) : "v"(lo), "v"(hi)); return r; }
typedef float f32x2 __attribute__((ext_vector_type(2)));
struct EpiF32 {
    static constexpr bool PERM = false, AFTER_DRAIN = false;
    float* C; int ldc;
    __device__ __forceinline__ void operator()(const f32x4 (&acc)[2][2][4][2], const Unit& u, int wr, int wc, int fr, int fq) const {
        const int row0 = u.pm * BM + wr * 64 + fr, col0 = u.pn * BM + wc * 32 + 4 * fq;
#pragma unroll
        for (int ai = 0; ai < 2; ++ai)
#pragma unroll
            for (int m = 0; m < 4; ++m) { float* rowp = C + (size_t)(row0 + ai * HALF + m * 16) * ldc + col0;
#pragma unroll
                for (int bj = 0; bj < 2; ++bj)
#pragma unroll
                    for (int n = 0; n < 2; ++n) *(f32x4*)(rowp + bj * HALF + n * 16) = acc[ai][bj][m][n]; }
    }
};
struct OneUnit {
    int pm, pn, on;
    __device__ __forceinline__ bool next(int i, Unit& u) const { if (i != 0 || !on) return false; u.pm = pm; u.pn = pn; return true; }
    __device__ __forceinline__ void a_ready(const Unit&) const {}
    __device__ __forceinline__ void done(const Unit&) const {}
};
struct EpiBf16 {
    static constexpr bool PERM = true, AFTER_DRAIN = false;
    bf16_t* O; int ldc; int ACT;
    __device__ __forceinline__ void operator()(const f32x4 (&acc)[2][2][4][2], const Unit& u, int wr, int wc, int fr, int fq) const {
        const int row0 = u.pm * BM + wr * 64 + fr, col0 = u.pn * BM + wc * 32 + 8 * fq;
#pragma unroll
        for (int ai = 0; ai < 2; ++ai)
#pragma unroll
            for (int m = 0; m < 4; ++m) { bf16_t* rowp = O + (size_t)(row0 + ai * HALF + m * 16) * ldc + col0;
#pragma unroll
                for (int bj = 0; bj < 2; ++bj) { f32x4 v0 = acc[ai][bj][m][0], v1 = acc[ai][bj][m][1];
                    if (ACT == 2) {
#pragma unroll
                        for (int e = 0; e < 4; ++e) { const float a = fmaxf(v0[e], 0.f), b = fmaxf(v1[e], 0.f); v0[e] = a * a; v1[e] = b * b; } }
                    u32x4 w; w.x = cvt_pk_bf16(v0[0], v0[1]); w.y = cvt_pk_bf16(v0[2], v0[3]); w.z = cvt_pk_bf16(v1[0], v1[1]); w.w = cvt_pk_bf16(v1[2], v1[3]);
                    *(u32x4*)(rowp + bj * HALF) = w; } }
    }
};
struct EpiUQ {
    static constexpr bool PERM = true, AFTER_DRAIN = false;
    bf16_t* Q; const float* rstd; const float* tab; float qscale;
    __device__ __forceinline__ void operator()(const f32x4 (&acc)[2][2][4][2], const Unit& u, int wr, int wc, int fr, int fq) const {
        const int row0 = u.pm * BM + wr * 64 + fr, col0 = u.pn * BM + wc * 32 + 8 * fq;
#pragma unroll
        for (int ai = 0; ai < 2; ++ai)
#pragma unroll
            for (int m = 0; m < 4; ++m) { const int row = row0 + ai * HALF + m * 16; const float rs = rstd[row] * qscale;
                const bool latent = row < 16384; const int t = row & 4095, prow = t >> 6, pcol = t & 63;
#pragma unroll
                for (int bj = 0; bj < 2; ++bj) { const int col = col0 + bj * HALF; if (col >= 384) continue;
                    f32x4 v0 = acc[ai][bj][m][0] * rs, v1 = acc[ai][bj][m][1] * rs;
                    const int d0 = col % 96;
                    if (d0 >= 64 && latent) { const int j0 = d0 - 64, part = j0 >> 4, i0 = (j0 & 15) >> 1; const int pos = part ? pcol : prow;
                        const float* cs = tab + (pos * 8 + i0) * 2;
                        float x1, x2, c, s;
                        x1 = v0[0]; x2 = v0[1]; c = cs[0]; s = cs[1]; v0[0] = x1 * c - x2 * s; v0[1] = x1 * s + x2 * c;
                        x1 = v0[2]; x2 = v0[3]; c = cs[2]; s = cs[3]; v0[2] = x1 * c - x2 * s; v0[3] = x1 * s + x2 * c;
                        x1 = v1[0]; x2 = v1[1]; c = cs[4]; s = cs[5]; v1[0] = x1 * c - x2 * s; v1[1] = x1 * s + x2 * c;
                        x1 = v1[2]; x2 = v1[3]; c = cs[6]; s = cs[7]; v1[2] = x1 * c - x2 * s; v1[3] = x1 * s + x2 * c; }
                    u32x4 w; w.x = cvt_pk_bf16(v0[0], v0[1]); w.y = cvt_pk_bf16(v0[2], v0[3]); w.z = cvt_pk_bf16(v1[0], v1[1]); w.w = cvt_pk_bf16(v1[2], v1[3]);
                    *(u32x4*)(Q + (size_t)row * 384 + col) = w; } }
    }
};
struct EpiUKV {
    static constexpr bool PERM = true, AFTER_DRAIN = false;
    bf16_t* KM; bf16_t* VT; const float* rstd;
    __device__ __forceinline__ void operator()(const f32x4 (&acc)[2][2][4][2], const Unit& u, int wr, int wc, int fr, int fq) const {
        const int row0 = u.pm * BM + wr * 64 + fr, col0 = u.pn * BM + wc * 32 + 8 * fq;
#pragma unroll
        for (int ai = 0; ai < 2; ++ai)
#pragma unroll
            for (int m = 0; m < 4; ++m) { const int row = row0 + ai * HALF + m * 16; const float rs = rstd[row];
                int b, kk; if (row < 16384) { b = row >> 12; kk = row & 4095; } else { const int r2 = row - 16384; b = r2 >> 8; kk = 4096 + (r2 & 255); }
#pragma unroll
                for (int bj = 0; bj < 2; ++bj) { const int col = col0 + bj * HALF; const int head = col >> 7, d = col & 127;
                    const f32x4 v0 = acc[ai][bj][m][0] * rs, v1 = acc[ai][bj][m][1] * rs;
                    u32x4 w; w.x = cvt_pk_bf16(v0[0], v0[1]); w.y = cvt_pk_bf16(v0[2], v0[3]); w.z = cvt_pk_bf16(v1[0], v1[1]); w.w = cvt_pk_bf16(v1[2], v1[3]);
                    if (d < 64) { *(u32x4*)(KM + ((size_t)((b * 4 + head) * 4352 + kk)) * 96 + d) = w; }
                    else { bf16_t* vp = VT + ((size_t)((b * 4 + head) * 64 + (d - 64))) * 4352 + kk;
                        vp[0 * 4352] = (bf16_t)(w.x & 0xffffu); vp[1 * 4352] = (bf16_t)(w.x >> 16); vp[2 * 4352] = (bf16_t)(w.y & 0xffffu); vp[3 * 4352] = (bf16_t)(w.y >> 16);
                        vp[4 * 4352] = (bf16_t)(w.z & 0xffffu); vp[5 * 4352] = (bf16_t)(w.z >> 16); vp[6 * 4352] = (bf16_t)(w.w & 0xffffu); vp[7 * 4352] = (bf16_t)(w.w >> 16); } } }
    }
};
template <class Epi, class Sched, bool ALIGN_EPI = false, bool SP2 = false>
__device__ __forceinline__ void gemm_phase(PG8_LAS unsigned char* lds, const Gemm g, const Sched& S, const Epi& E) {
    int tid_ = threadIdx.x; asm volatile("" : "+v"(tid_));
    const int tid = tid_, wid = __builtin_amdgcn_readfirstlane(tid >> 6), lane = tid & 63, wr = wid >> 2, wc = wid & 3, fr = lane & 15, fq = lane >> 4;
    const int K = g.K, nt = K / BK;
    unsigned voffA, voffB;
    { int R, C; stage_rc(tid * 16, R, C); const int Rb = Epi::PERM ? ((R & ~31) + perm32(R & 31)) : R;
        voffA = (unsigned)(R * g.lda + C) * 2u; voffB = (unsigned)(Rb * g.ldb + C) * 2u; }
    const size_t pstepA = (size_t)64 * g.lda * 2, pstepB = (size_t)64 * g.ldb * 2;
    const size_t kstep = (size_t)(BK * 2);
    const size_t hstep = (size_t)HALF * g.ldb * 2;
    const size_t tstep = 2 * hstep; const size_t hstepA = (size_t)HALF * g.lda * 2, tstepA = 2 * hstepA;
    const unsigned ldsw = (unsigned)wid * 1024u;
    const int aoff = lds_byte(wr * 64 + fr, fq * 8), boff = lds_byte(wc * 32 + fr, fq * 8);
#define PG8_SA(b, h) (((b) * 2 + (h)) * HTB)
#define PG8_SB(b, h) ((4 + (b) * 2 + (h)) * HTB)
#define PG8_STAGE(bufoff, gbase, voff) do { _Pragma("unroll") for (int _i = 0; _i < 2; ++_i) \
        __builtin_amdgcn_global_load_lds((const unsigned*)((const char*)(gbase) + (size_t)_i * PG8_PSTEP_##voff + (voff)), (PG8_LAS unsigned*)(lds + (bufoff) + ldsw + _i * 8192), 16, 0, 0); } while (0)
#define PG8_PSTEP_voffA pstepA
#define PG8_PSTEP_voffB pstepB
#define PG8_LDA(dst, b, h) do { _Pragma("unroll") for (int m = 0; m < 4; ++m) _Pragma("unroll") for (int k = 0; k < 2; ++k) dst[m][k] = *(const PG8_LAS bf16x8*)(lds + PG8_SA(b, h) + aoff + m * 2048 + k * 1024); } while (0)
#define PG8_LDB(dst, b, h) do { _Pragma("unroll") for (int n = 0; n < 2; ++n) _Pragma("unroll") for (int k = 0; k < 2; ++k) dst[n][k] = *(const PG8_LAS bf16x8*)(lds + PG8_SB(b, h) + boff + n * 2048 + k * 1024); } while (0)
#define PG8_MMA(ai, bj, At, Bt) do { __builtin_amdgcn_s_setprio(1); _Pragma("unroll") for (int m = 0; m < 4; ++m) _Pragma("unroll") for (int n = 0; n < 2; ++n) _Pragma("unroll") for (int k = 0; k < 2; ++k) \
        acc[ai][bj][m][n] = __builtin_amdgcn_mfma_f32_16x16x32_bf16(Bt[n][k], At[m][k], acc[ai][bj][m][n], 0, 0, 0); __builtin_amdgcn_s_setprio(0); } while (0)
#define PG8_WAIT_V(n) asm volatile("s_waitcnt vmcnt(" #n ")" ::: "memory")
#define PG8_WAIT_L(n) asm volatile("s_waitcnt lgkmcnt(" #n ")" ::: "memory")
#define PG8_BAR __builtin_amdgcn_s_barrier()
#define PG8_SCHED __builtin_amdgcn_sched_barrier(0)
    Unit cur, nxt; int ui = 0;
    if (!S.next(0, cur)) return;
    f32x4 acc[2][2][4][2];
#pragma unroll
    for (int a = 0; a < 2; ++a)
#pragma unroll
        for (int b = 0; b < 2; ++b)
#pragma unroll
            for (int m = 0; m < 4; ++m)
#pragma unroll
                for (int n = 0; n < 2; ++n) acc[a][b][m][n] = (f32x4){0.f, 0.f, 0.f, 0.f};
    bf16x8 At[4][2], B0[2][2], B1[2][2];
    const char* cA = (const char*)g.A + (size_t)cur.pm * tstepA; const char* cB = (const char*)g.Bt + (size_t)cur.pn * tstep;
    S.a_ready(cur);
    if constexpr (SP2) {
        PG8_STAGE(PG8_SB(0, 0), cB, voffB); PG8_STAGE(PG8_SB(0, 1), cB + hstep, voffB); PG8_STAGE(PG8_SA(0, 0), cA, voffA); PG8_STAGE(PG8_SA(0, 1), cA + hstepA, voffA);
        if (wr == 1) PG8_BAR;
        PG8_WAIT_V(2); PG8_BAR;
        PG8_STAGE(PG8_SB(1, 0), cB + kstep, voffB); PG8_STAGE(PG8_SA(1, 0), cA + kstep, voffA); PG8_STAGE(PG8_SB(1, 1), cB + hstep + kstep, voffB);
        PG8_WAIT_V(6); PG8_BAR;
    } else {
        PG8_STAGE(PG8_SB(0, 0), cB, voffB); PG8_STAGE(PG8_SA(0, 0), cA, voffA); PG8_STAGE(PG8_SB(0, 1), cB + hstep, voffB); PG8_STAGE(PG8_SA(0, 1), cA + hstepA, voffA);
        if (wr == 1) PG8_BAR;
        PG8_WAIT_V(4); PG8_BAR;
        PG8_STAGE(PG8_SB(1, 0), cB + kstep, voffB); PG8_STAGE(PG8_SA(1, 0), cA + kstep, voffA); PG8_STAGE(PG8_SB(1, 1), cB + hstep + kstep, voffB);
        PG8_WAIT_V(6); PG8_BAR;
    }
    for (;;) {
        const bool has_next = S.next(ui + 1, nxt);
        const char* nA = has_next ? (const char*)g.A + (size_t)nxt.pm * tstepA : cA; const char* nB = has_next ? (const char*)g.Bt + (size_t)nxt.pn * tstep : cB;
        for (int t = 0; t < nt; t += 2) {
            const bool last = (t == nt - 2);
            const char* a1 = cA + (size_t)(t + 1) * kstep;
            const char* a2 = last ? nA : cA + (size_t)(t + 2) * kstep; const char* b2 = last ? nB : cB + (size_t)(t + 2) * kstep;
            const char* a3 = a2 + kstep; const char* b3 = b2 + kstep;
            if (last && has_next) S.a_ready(nxt);
            if constexpr (SP2) {
            PG8_LDB(B0, 0, 0); PG8_LDB(B1, 0, 1); PG8_SCHED; PG8_LDA(At, 0, 0); PG8_STAGE(PG8_SA(1, 1), a1 + hstepA, voffA);
            PG8_WAIT_V(8); PG8_WAIT_L(0); PG8_BAR; PG8_MMA(0, 0, At, B0); PG8_MMA(0, 1, At, B1); PG8_BAR; PG8_SCHED;
            PG8_LDA(At, 0, 1); PG8_STAGE(PG8_SB(0, 0), b2, voffB); PG8_STAGE(PG8_SB(0, 1), b2 + hstep, voffB); PG8_STAGE(PG8_SA(0, 0), a2, voffA);
            PG8_WAIT_V(8); PG8_WAIT_L(0); PG8_BAR; PG8_MMA(1, 0, At, B0); PG8_MMA(1, 1, At, B1); PG8_BAR; PG8_SCHED;
            PG8_LDB(B0, 1, 0); PG8_LDB(B1, 1, 1); PG8_SCHED; PG8_LDA(At, 1, 0); PG8_STAGE(PG8_SA(0, 1), a2 + hstepA, voffA);
            PG8_WAIT_V(8); PG8_WAIT_L(0); PG8_BAR; PG8_MMA(0, 0, At, B0); PG8_MMA(0, 1, At, B1); PG8_BAR; PG8_SCHED;
            PG8_LDA(At, 1, 1); PG8_STAGE(PG8_SB(1, 0), b3, voffB); PG8_STAGE(PG8_SB(1, 1), b3 + hstep, voffB); PG8_STAGE(PG8_SA(1, 0), a3, voffA);
            PG8_WAIT_V(8); PG8_WAIT_L(0); PG8_BAR; PG8_MMA(1, 0, At, B0); PG8_MMA(1, 1, At, B1); PG8_BAR; PG8_SCHED;
            } else {
            PG8_LDB(B0, 0, 0); PG8_SCHED; PG8_LDA(At, 0, 0); PG8_STAGE(PG8_SA(1, 1), a1 + hstepA, voffA);
            PG8_WAIT_L(8); PG8_BAR; PG8_WAIT_L(0); PG8_MMA(0, 0, At, B0); PG8_BAR; PG8_SCHED;
            PG8_LDB(B1, 0, 1); PG8_STAGE(PG8_SB(0, 0), b2, voffB);
            PG8_BAR; PG8_WAIT_L(0); PG8_MMA(0, 1, At, B1); PG8_BAR;
            PG8_LDA(At, 0, 1); PG8_STAGE(PG8_SA(0, 0), a2, voffA);
            PG8_BAR; PG8_WAIT_L(0); PG8_MMA(1, 0, At, B0); PG8_BAR; PG8_SCHED;
            PG8_STAGE(PG8_SB(0, 1), b2 + hstep, voffB);
            PG8_WAIT_V(6); PG8_BAR; PG8_MMA(1, 1, At, B1); PG8_BAR;
            PG8_LDB(B0, 1, 0); PG8_SCHED; PG8_LDA(At, 1, 0); PG8_STAGE(PG8_SA(0, 1), a2 + hstepA, voffA);
            PG8_WAIT_L(8); PG8_BAR; PG8_WAIT_L(0); PG8_MMA(0, 0, At, B0); PG8_BAR; PG8_SCHED;
            PG8_LDB(B1, 1, 1); PG8_STAGE(PG8_SB(1, 0), b3, voffB);
            PG8_BAR; PG8_WAIT_L(0); PG8_MMA(0, 1, At, B1); PG8_BAR;
            PG8_LDA(At, 1, 1); PG8_STAGE(PG8_SA(1, 0), a3, voffA);
            PG8_BAR; PG8_WAIT_L(0); PG8_MMA(1, 0, At, B0); PG8_BAR; PG8_SCHED;
            PG8_STAGE(PG8_SB(1, 1), b3 + hstep, voffB);
            PG8_WAIT_V(6); PG8_BAR; PG8_MMA(1, 1, At, B1); PG8_BAR;
            }
        }
        if constexpr (ALIGN_EPI) { if (wr == 0) PG8_BAR; }
        if constexpr (!Epi::AFTER_DRAIN) { E(acc, cur, wr, wc, fr, fq); S.done(cur); }
        if (!has_next) break;
#pragma unroll
        for (int a = 0; a < 2; ++a)
#pragma unroll
            for (int b = 0; b < 2; ++b)
#pragma unroll
                for (int m = 0; m < 4; ++m)
#pragma unroll
                    for (int n = 0; n < 2; ++n) acc[a][b][m][n] = (f32x4){0.f, 0.f, 0.f, 0.f};
        cur = nxt; cA = nA; cB = nB; ++ui;
        if constexpr (ALIGN_EPI) { if (wr == 1) PG8_BAR; }
    }
    PG8_WAIT_V(0);
    if constexpr (!ALIGN_EPI) { if (wr == 0) PG8_BAR; }
    PG8_BAR;
    if constexpr (Epi::AFTER_DRAIN) { E.fused(acc, cur, wr, wc, fr, fq, lds, wid, lane); S.done(cur); }
#undef PG8_SA
#undef PG8_SB
#undef PG8_STAGE
#undef PG8_LDA
#undef PG8_LDB
#undef PG8_MMA
#undef PG8_WAIT_V
#undef PG8_WAIT_L
#undef PG8_BAR
#undef PG8_SCHED
}
}

__device__ const float ROPE_TAB[1024] = {
1.000000000e+00f,0.000000000e+00f,1.000000000e+00f,0.000000000e+00f,1.000000000e+00f,0.000000000e+00f,1.000000000e+00f,0.000000000e+00f,
1.000000000e+00f,0.000000000e+00f,1.000000000e+00f,0.000000000e+00f,1.000000000e+00f,0.000000000e+00f,1.000000000e+00f,0.000000000e+00f,
5.403022766e-01f,8.414709568e-01f,9.504152536e-01f,3.109835982e-01f,9.950041771e-01f,9.983342141e-02f,9.995000362e-01f,3.161750361e-02f,
9.999499917e-01f,9.999833070e-03f,9.999949932e-01f,3.162272274e-03f,9.999995232e-01f,9.999999311e-04f,9.999999404e-01f,3.162277571e-04f,
-4.161468446e-01f,9.092974067e-01f,8.065783978e-01f,5.911270976e-01f,9.800665975e-01f,1.986693293e-01f,9.980006814e-01f,6.320339441e-02f,
9.998000264e-01f,1.999866590e-02f,9.999799728e-01f,6.324512884e-03f,9.999979734e-01f,1.999998698e-03f,9.999998212e-01f,6.324554561e-04f,
-9.899924994e-01f,1.411200017e-01f,5.827536583e-01f,8.126488924e-01f,9.553365111e-01f,2.955202162e-01f,9.955033660e-01f,9.472608566e-02f,
9.995500445e-01f,2.999549918e-02f,9.999549985e-01f,9.486690164e-03f,9.999955297e-01f,2.999995602e-03f,9.999995232e-01f,9.486831259e-04f,
-6.536436081e-01f,-7.568024993e-01f,3.011374772e-01f,9.535807371e-01f,9.210609794e-01f,3.894183338e-01f,9.920106530e-01f,1.261540651e-01f,
9.992001057e-01f,3.998933360e-02f,9.999200106e-01f,1.264877338e-02f,9.999920130e-01f,3.999989480e-03f,9.999992251e-01f,1.264910679e-03f,
2.836622000e-01f,-9.589242935e-01f,-1.034233812e-02f,9.999465346e-01f,8.775825500e-01f,4.794255495e-01f,9.875259995e-01f,1.574558765e-01f,
9.987502694e-01f,4.997916520e-02f,9.998750091e-01f,1.581072807e-02f,9.999874830e-01f,4.999979399e-03f,9.999987483e-01f,1.581138116e-03f,
9.601702690e-01f,-2.794154882e-01f,-3.207964003e-01f,9.471482038e-01f,8.253356218e-01f,5.646424890e-01f,9.820539355e-01f,1.886002719e-01f,
9.982005358e-01f,5.996400490e-02f,9.998199940e-01f,1.897252724e-02f,9.999819994e-01f,5.999964196e-03f,9.999982119e-01f,1.897365320e-03f,
7.539022565e-01f,6.569865942e-01f,-5.994374752e-01f,8.004215956e-01f,7.648422122e-01f,6.442176700e-01f,9.755998850e-01f,2.195560932e-01f,
9.975510240e-01f,6.994284689e-02f,9.997550249e-01f,2.213413455e-02f,9.999755025e-01f,6.999942940e-03f,9.999975562e-01f,2.213592408e-03f,
-1.455000341e-01f,9.893582463e-01f,-8.186324239e-01f,5.743177533e-01f,6.967067122e-01f,7.173560858e-01f,9.681702852e-01f,2.502923310e-01f,
9.968017340e-01f,7.991468906e-02f,9.996800423e-01f,2.529552206e-02f,9.999679923e-01f,7.999914698e-03f,9.999967813e-01f,2.529819263e-03f,
-9.111302495e-01f,4.121184945e-01f,-9.566441774e-01f,2.912592292e-01f,6.216099262e-01f,7.833269238e-01f,9.597726464e-01f,2.807783186e-01f,
9.959527254e-01f,8.987854421e-02f,9.995950460e-01f,2.845665626e-02f,9.999595284e-01f,8.999879472e-03f,9.999959469e-01f,2.846045885e-03f,
-8.390715122e-01f,-5.440211296e-01f,-9.997860789e-01f,-2.068356983e-02f,5.403022766e-01f,8.414709568e-01f,9.504153132e-01f,3.109835684e-01f,
9.950041771e-01f,9.983341396e-02f,9.995000362e-01f,3.161750361e-02f,9.999499917e-01f,9.999834001e-03f,9.999949932e-01f,3.162272274e-03f,
4.425697960e-03f,-9.999902248e-01f,-9.437797666e-01f,-3.305749595e-01f,4.535960853e-01f,8.912073970e-01f,9.401075840e-01f,3.408778608e-01f,
9.939560890e-01f,1.097782999e-01f,9.993950725e-01f,3.477803990e-02f,9.999395013e-01f,1.099977922e-02f,9.999939203e-01f,3.478498431e-03f,
8.438539505e-01f,-5.365729332e-01f,-7.941793799e-01f,-6.076834202e-01f,3.623577058e-01f,9.320390821e-01f,9.288598895e-01f,3.704313040e-01f,
9.928086400e-01f,1.197122037e-01f,9.992800951e-01f,3.793822229e-02f,9.999279976e-01f,1.199971233e-02f,9.999927878e-01f,3.794723889e-03f,
9.074468017e-01f,4.201670289e-01f,-5.658205152e-01f,-8.245284557e-01f,2.674987614e-01f,9.635581970e-01f,9.166833758e-01f,3.996143043e-01f,
9.915618896e-01f,1.296341419e-01f,9.991551042e-01f,4.109803215e-02f,9.999154806e-01f,1.299963426e-02f,9.999915361e-01f,4.110949114e-03f,
1.367372125e-01f,9.906073809e-01f,-2.813494802e-01f,-9.596053958e-01f,1.699671596e-01f,9.854497313e-01f,9.035902619e-01f,4.283977747e-01f,
9.902160168e-01f,1.395431161e-01f,9.990201592e-01f,4.425742477e-02f,9.999020100e-01f,1.399954315e-02f,9.999902248e-01f,4.427174106e-03f,
-7.596879005e-01f,6.502878666e-01f,3.102235124e-02f,-9.995186925e-01f,7.073719800e-02f,9.974949956e-01f,8.895936012e-01f,4.567528665e-01f,
9.887710810e-01f,1.494381279e-01f,9.988752007e-01f,4.741638154e-02f,9.998875260e-01f,1.499943808e-02f,9.999887347e-01f,4.743398633e-03f,
-9.576594830e-01f,-2.879033089e-01f,3.403181732e-01f,-9.403103590e-01f,-2.919954620e-02f,9.995735884e-01f,8.747074604e-01f,4.846512377e-01f,
9.872272611e-01f,1.593182087e-01f,9.987202883e-01f,5.057485774e-02f,9.998720288e-01f,1.599931903e-02f,9.999871850e-01f,5.059622694e-03f,
-2.751633525e-01f,-9.613974690e-01f,6.158648133e-01f,-7.878518701e-01f,-1.288445443e-01f,9.916648269e-01f,8.589466810e-01f,5.120649934e-01f,
9.855847955e-01f,1.691823453e-01f,9.985553622e-01f,5.373282731e-02f,9.998555183e-01f,1.699918136e-02f,9.999855757e-01f,5.375845823e-03f,
6.603167057e-01f,-7.509872317e-01f,8.303361535e-01f,-5.572628975e-01f,-2.272021621e-01f,9.738476276e-01f,8.423270583e-01f,5.389667153e-01f,
9.838436842e-01f,1.790295690e-01f,9.983804226e-01f,5.689026415e-02f,9.998379946e-01f,1.799902879e-02f,9.999837875e-01f,5.692068953e-03f,
9.887046218e-01f,1.498772055e-01f,9.624637961e-01f,-2.714101076e-01f,-3.232895434e-01f,9.463000894e-01f,8.248651624e-01f,5.653295517e-01f,
9.820042253e-01f,1.888588965e-01f,9.981955290e-01f,6.004713103e-02f,9.998195171e-01f,1.899885759e-02f,9.999819398e-01f,6.008291151e-03f,
4.080820680e-01f,9.129452705e-01f,9.991443753e-01f,4.135828838e-02f,-4.161468446e-01f,9.092974067e-01f,8.065784574e-01f,5.911270380e-01f,
9.800665975e-01f,1.986693144e-01f,9.980006814e-01f,6.320339441e-02f,9.998000264e-01f,1.999866776e-02f,9.999799728e-01f,6.324512884e-03f,
-5.477292538e-01f,8.366556168e-01f,9.367404580e-01f,3.500247598e-01f,-5.048462152e-01f,8.632093072e-01f,7.874851823e-01f,6.163335443e-01f,
9.780309200e-01f,2.084598988e-01f,9.977958202e-01f,6.635902822e-02f,9.997795224e-01f,2.099845745e-02f,9.999779463e-01f,6.640734151e-03f,
-9.999608397e-01f,-8.851309307e-03f,7.814403772e-01f,6.239799261e-01f,-5.885011554e-01f,8.084963560e-01f,7.676045895e-01f,6.409237385e-01f,
9.758974314e-01f,2.182296216e-01f,9.975810051e-01f,6.951400638e-02f,9.997580051e-01f,2.199822664e-02f,9.999758005e-01f,6.956954487e-03f,
-5.328330398e-01f,-8.462204337e-01f,5.486452579e-01f,8.360552788e-01f,-6.662759781e-01f,7.457052469e-01f,7.469564080e-01f,6.648730636e-01f,
9.736663699e-01f,2.279775143e-01f,9.973561764e-01f,7.266827673e-02f,9.997355342e-01f,2.299797349e-02f,9.999735355e-01f,7.273174357e-03f,
4.241790175e-01f,-9.055783749e-01f,2.614416778e-01f,9.652192593e-01f,-7.373937964e-01f,6.754631400e-01f,7.255613208e-01f,6.881574988e-01f,
9.713379741e-01f,2.377026230e-01f,9.971213937e-01f,7.582182437e-02f,9.997119904e-01f,2.399769612e-02f,9.999712110e-01f,7.589393295e-03f,
9.912028313e-01f,-1.323517561e-01f,-5.168933049e-02f,9.986631870e-01f,-8.011435866e-01f,5.984721184e-01f,7.034407258e-01f,7.107539177e-01f,
9.689124227e-01f,2.474039644e-01f,9.968766570e-01f,7.897461206e-02f,9.996874928e-01f,2.499739639e-02f,9.999687672e-01f,7.905611768e-03f,
6.469193101e-01f,7.625584602e-01f,-3.596943319e-01f,9.330701828e-01f,-8.568888307e-01f,5.155012608e-01f,6.806167960e-01f,7.326396108e-01f,
9.663899541e-01f,2.570805550e-01f,9.966219068e-01f,8.212661743e-02f,9.996620417e-01f,2.599707060e-02f,9.999662042e-01f,8.221829310e-03f,
-2.921388149e-01f,9.563759565e-01f,-6.320286393e-01f,7.749450207e-01f,-9.040721655e-01f,4.273798466e-01f,6.571123004e-01f,7.537927032e-01f,
9.637709260e-01f,2.667314112e-01f,9.963572025e-01f,8.527779579e-02f,9.996355176e-01f,2.699672058e-02f,9.999635220e-01f,8.538045920e-03f,
-9.626058936e-01f,2.709057927e-01f,-8.416849375e-01f,5.399689674e-01f,-9.422222972e-01f,3.349882066e-01f,6.329506636e-01f,7.741920948e-01f,
9.610554576e-01f,2.763556540e-01f,9.960825443e-01f,8.842811733e-02f,9.996080399e-01f,2.799634263e-02f,9.999607801e-01f,8.854261599e-03f,
-7.480575442e-01f,-6.636338830e-01f,-9.678714871e-01f,2.514453232e-01f,-9.709581733e-01f,2.392492294e-01f,6.081562042e-01f,7.938174009e-01f,
9.582439065e-01f,2.859522104e-01f,9.957979321e-01f,9.157756716e-02f,9.995795488e-01f,2.899593674e-02f,9.999579787e-01f,9.170476347e-03f,
1.542514563e-01f,-9.880316257e-01f,-9.980752468e-01f,-6.201484054e-02f,-9.899924994e-01f,1.411200017e-01f,5.827536583e-01f,8.126488924e-01f,
9.553365111e-01f,2.955201864e-01f,9.955033660e-01f,9.472609311e-02f,9.995500445e-01f,2.999550104e-02f,9.999549985e-01f,9.486690164e-03f,
9.147423506e-01f,-4.040376544e-01f,-9.293003082e-01f,-3.693250120e-01f,-9.991351366e-01f,4.158052057e-02f,5.567683578e-01f,8.306677938e-01f,
9.523335695e-01f,3.050586283e-01f,9.951988459e-01f,9.787366539e-02f,9.995195270e-01f,3.099503554e-02f,9.999519587e-01f,9.802903049e-03f,
8.342233896e-01f,5.514267087e-01f,-7.683671117e-01f,-6.400094032e-01f,-9.982947707e-01f,-5.837419257e-02f,5.302263498e-01f,8.478561044e-01f,
9.492354393e-01f,3.145665526e-01f,9.948843718e-01f,1.010202691e-01f,9.994880557e-01f,3.199454024e-02f,9.999487996e-01f,1.011911593e-02f,
-1.327674743e-02f,9.999118447e-01f,-5.312352777e-01f,-8.472243547e-01f,-9.874798059e-01f,-1.577456445e-01f,5.031541586e-01f,8.641966581e-01f,
9.460423589e-01f,3.240430057e-01f,9.945599437e-01f,1.041658595e-01f,9.994555712e-01f,3.299400955e-02f,9.999455214e-01f,1.043532696e-02f,
-8.485702872e-01f,5.290827155e-01f,-2.414211184e-01f,-9.704204202e-01f,-9.667981863e-01f,-2.555412054e-01f,4.755789042e-01f,8.796730638e-01f,
9.427546859e-01f,3.334870934e-01f,9.942255616e-01f,1.073104069e-01f,9.994220734e-01f,3.399345279e-02f,9.999421835e-01f,1.075153705e-02f,
-9.036921859e-01f,-4.281826615e-01f,7.233466953e-02f,-9.973804355e-01f,-9.364566803e-01f,-3.507832289e-01f,4.475280643e-01f,8.942698836e-01f,
9.393727183e-01f,3.428978026e-01f,9.938812256e-01f,1.104538813e-01f,9.993875623e-01f,3.499285504e-02f,9.999387264e-01f,1.106774528e-02f,
-1.279636919e-01f,-9.917788506e-01f,3.789161742e-01f,-9.254310131e-01f,-8.967583776e-01f,-4.425205588e-01f,4.190297425e-01f,9.079725146e-01f,
9.358968139e-01f,3.522742093e-01f,9.935269952e-01f,1.135962531e-01f,9.993520975e-01f,3.599222749e-02f,9.999352098e-01f,1.138395350e-02f,
7.654140592e-01f,-6.435381174e-01f,6.479216814e-01f,-7.617069483e-01f,-8.481000066e-01f,-5.298361778e-01f,3.901124299e-01f,9.207672477e-01f,
9.323273301e-01f,3.616154492e-01f,9.931628108e-01f,1.167374924e-01f,9.993155599e-01f,3.699155897e-02f,9.999315739e-01f,1.170015987e-02f,
9.550736547e-01f,2.963685691e-01f,8.526731133e-01f,-5.224447846e-01f,-7.909677625e-01f,-6.118578315e-01f,3.608050346e-01f,9.326412678e-01f,
9.286646247e-01f,3.709204793e-01f,9.927886724e-01f,1.198775545e-01f,9.992780685e-01f,3.799085692e-02f,9.999278188e-01f,1.201636530e-02f,
2.666429281e-01f,9.637953639e-01f,9.728653431e-01f,-2.313720137e-01f,-7.259322405e-01f,-6.877662539e-01f,3.311368525e-01f,9.435827136e-01f,
9.249090552e-01f,3.801884055e-01f,9.924046397e-01f,1.230164245e-01f,9.992396235e-01f,3.899011388e-02f,9.999239445e-01f,1.233256981e-02f,
-6.669380665e-01f,7.451131344e-01f,9.965789914e-01f,8.264580369e-02f,-6.536436081e-01f,-7.568024993e-01f,3.011375964e-01f,9.535806775e-01f,
9.210609794e-01f,3.894183338e-01f,9.920106530e-01f,1.261540651e-01f,9.992001057e-01f,3.998933733e-02f,9.999200106e-01f,1.264877338e-02f,
-9.873392582e-01f,-1.586226672e-01f,9.214623570e-01f,3.884676993e-01f,-5.748240352e-01f,-8.182770610e-01f,2.708370686e-01f,9.626252055e-01f,
9.171208143e-01f,3.986093104e-01f,9.916067719e-01f,1.292904317e-01f,9.991596341e-01f,4.098851606e-02f,9.999159575e-01f,1.296497509e-02f,
-3.999853134e-01f,-9.165215492e-01f,7.549653649e-01f,6.557646990e-01f,-4.902605712e-01f,-8.715758920e-01f,2.402658761e-01f,9.707071185e-01f,
9.130889177e-01f,4.077604413e-01f,9.911929369e-01f,1.324255317e-01f,9.991181493e-01f,4.198765755e-02f,9.999117851e-01f,1.328117587e-02f,
5.551133156e-01f,-8.317747712e-01f,5.135984421e-01f,8.580306768e-01f,-4.007990062e-01f,-9.161660075e-01f,2.094544172e-01f,9.778184295e-01f,
9.089657664e-01f,4.168707728e-01f,9.907692075e-01f,1.355592906e-01f,9.990756512e-01f,4.298675060e-02f,9.999075532e-01f,1.359737478e-02f,
9.998432994e-01f,1.770192571e-02f,2.212981731e-01f,9.752061963e-01f,-3.073327839e-01f,-9.516021013e-01f,1.784335226e-01f,9.839519858e-01f,
9.047516584e-01f,4.259394705e-01f,9.903355837e-01f,1.386916935e-01f,9.990321398e-01f,4.398580641e-02f,9.999032021e-01f,1.391357277e-02f,
5.253219604e-01f,8.509035110e-01f,-9.294810891e-02f,9.956709743e-01f,-2.107958049e-01f,-9.775301218e-01f,1.472342163e-01f,9.891016483e-01f,
9.004471302e-01f,4.349655211e-01f,9.898920655e-01f,1.418227106e-01f,9.989876747e-01f,4.498481750e-02f,9.998987317e-01f,1.422976889e-02f,
-4.321779311e-01f,9.017883539e-01f,-3.979767561e-01f,9.173954725e-01f,-1.121526212e-01f,-9.936909676e-01f,1.158876941e-01f,9.932623506e-01f,
8.960524797e-01f,4.439480901e-01f,9.894386530e-01f,1.449523121e-01f,9.989421964e-01f,4.598378390e-02f,9.998942018e-01f,1.454596408e-02f,
-9.923354983e-01f,1.235731244e-01f,-6.635382771e-01f,7.481423616e-01f,-1.238837745e-02f,-9.999232888e-01f,8.442528546e-02f,9.964298010e-01f,
8.915683031e-01f,4.528862834e-01f,9.889753461e-01f,1.480804533e-01f,9.988957047e-01f,4.698270187e-02f,9.998895526e-01f,1.486215740e-02f,
-6.401443481e-01f,-7.682546377e-01f,-8.632965088e-01f,5.046970844e-01f,8.749917150e-02f,-9.961646199e-01f,5.287845805e-02f,9.986009598e-01f,
8.869948983e-01f,4.617791772e-01f,9.885020852e-01f,1.512071192e-01f,9.988481998e-01f,4.798157141e-02f,9.998847842e-01f,1.517834887e-02f,
3.005925417e-01f,-9.537526369e-01f,-9.774427414e-01f,2.112006545e-01f,1.865124702e-01f,-9.824525714e-01f,2.127875760e-02f,9.997735620e-01f,
8.823328614e-01f,4.706258774e-01f,9.880189896e-01f,1.543322802e-01f,9.987997413e-01f,4.898039624e-02f,9.998799562e-01f,1.549453940e-02f,
9.649659991e-01f,-2.623748481e-01f,-9.946564436e-01f,-1.032404602e-01f,2.836622000e-01f,-9.589242935e-01f,-1.034221891e-02f,9.999465346e-01f,
8.775825500e-01f,4.794255495e-01f,9.875259995e-01f,1.574558914e-01f,9.987502694e-01f,4.997916892e-02f,9.998750091e-01f,1.581072807e-02f,
7.421541810e-01f,6.702291965e-01f,-9.132301211e-01f,-4.074441493e-01f,3.779776692e-01f,-9.258147478e-01f,-4.195285589e-02f,9.991195798e-01f,
8.727445006e-01f,4.881772399e-01f,9.870231748e-01f,1.605779380e-01f,9.986997843e-01f,5.097789690e-02f,9.998699427e-01f,1.612691768e-02f,
-1.629907787e-01f,9.866275787e-01f,-7.412399650e-01f,-6.712401509e-01f,4.685169160e-01f,-8.834545016e-01f,-7.352153957e-02f,9.972936511e-01f,
8.678191900e-01f,4.968801141e-01f,9.865104556e-01f,1.636983752e-01f,9.986482859e-01f,5.197656900e-02f,9.998648167e-01f,1.644310169e-02f,
-9.182828069e-01f,3.959251642e-01f,-4.957418144e-01f,-8.684699535e-01f,5.543745160e-01f,-8.322673440e-01f,-1.050167084e-01f,9.944704771e-01f,
8.628070951e-01f,5.055333376e-01f,9.859878421e-01f,1.668171734e-01f,9.985958338e-01f,5.297519267e-02f,9.998595715e-01f,1.675928757e-02f,
-8.293098211e-01f,-5.587890744e-01f,-2.010796219e-01f,-9.795749187e-01f,6.346929669e-01f,-7.727644444e-01f,-1.364068687e-01f,9.906529188e-01f,
8.577086926e-01f,5.141359568e-01f,9.854553938e-01f,1.699342877e-01f,9.985423684e-01f,5.397376046e-02f,9.998542070e-01f,1.707546785e-02f,
2.212675661e-02f,-9.997551441e-01f,1.135217771e-01f,-9.935355186e-01f,7.086697817e-01f,-7.055402994e-01f,-1.676606387e-01f,9.858447909e-01f,
8.525245190e-01f,5.226872563e-01f,9.849131107e-01f,1.730497181e-01f,9.984878898e-01f,5.497227982e-02f,9.998487830e-01f,1.739165001e-02f,
8.532201052e-01f,-5.215510130e-01f,4.168670774e-01f,-9.089674354e-01f,7.755658031e-01f,-6.312667131e-01f,-1.987468749e-01f,9.800508618e-01f,
8.472551107e-01f,5.311862230e-01f,9.843609333e-01f,1.761634201e-01f,9.984323978e-01f,5.597073585e-02f,9.998431802e-01f,1.770782843e-02f,
8.998668194e-01f,4.361647666e-01f,6.788702011e-01f,-7.342582941e-01f,8.347129226e-01f,-5.506852865e-01f,-2.296342701e-01f,9.732769728e-01f,
8.419010043e-01f,5.396320224e-01f,9.837989211e-01f,1.792753637e-01f,9.983759522e-01f,5.696914345e-02f,9.998375773e-01f,1.802400686e-02f,
1.191801354e-01f,9.928726554e-01f,8.735505342e-01f,-4.867334962e-01f,8.855196238e-01f,-4.646020234e-01f,-2.602920532e-01f,9.655299187e-01f,
8.364626765e-01f,5.480239391e-01f,9.832270741e-01f,1.823855042e-01f,9.983184934e-01f,5.796748772e-02f,9.998317957e-01f,1.834018156e-02f,
-7.710801959e-01f,6.367380023e-01f,9.816020727e-01f,-1.909380108e-01f,9.274784923e-01f,-3.738765717e-01f,-2.906895578e-01f,9.568174481e-01f,
8.309407234e-01f,5.563610196e-01f,9.826454520e-01f,1.854938269e-01f,9.982600212e-01f,5.896577984e-02f,9.998259544e-01f,1.865635626e-02f,
-9.524129629e-01f,-3.048106134e-01f,9.923083186e-01f,1.237909496e-01f,9.601702690e-01f,-2.794154882e-01f,-3.207964003e-01f,9.471482038e-01f,
8.253356218e-01f,5.646424294e-01f,9.820539355e-01f,1.886002868e-01f,9.982005358e-01f,5.996400863e-02f,9.998199940e-01f,1.897252724e-02f,
-2.581016421e-01f,-9.661177993e-01f,9.046075940e-01f,4.262454212e-01f,9.832684398e-01f,-1.821625978e-01f,-3.505824506e-01f,9.365318418e-01f,
8.196480274e-01f,5.728674531e-01f,9.814526439e-01f,1.917048544e-01f,9.981400967e-01f,6.096218154e-02f,9.998139739e-01f,1.928869821e-02f,
6.735071540e-01f,-7.391806841e-01f,7.271980643e-01f,6.864276528e-01f,9.965420961e-01f,-8.308912069e-02f,-3.800179660e-01f,9.249790907e-01f,
8.138784766e-01f,5.810351372e-01f,9.808415174e-01f,1.948075294e-01f,9.980786443e-01f,6.196028739e-02f,9.998078346e-01f,1.960486546e-02f,
9.858965874e-01f,1.673557013e-01f,4.776714444e-01f,8.785385489e-01f,9.998586178e-01f,1.681409031e-02f,-4.090735018e-01f,9.125014544e-01f,
8.080275059e-01f,5.891447663e-01f,9.802205563e-01f,1.979082376e-01f,9.980161786e-01f,6.295833737e-02f,9.998015761e-01f,1.992103085e-02f,
};

#define GAS __attribute__((address_space(1)))
#define LAS __attribute__((address_space(3)))
typedef unsigned short bf16;
typedef unsigned v4u __attribute__((ext_vector_type(4)));
typedef float f32x4 __attribute__((ext_vector_type(4)));
typedef short bf16x8 __attribute__((ext_vector_type(8)));
typedef GAS unsigned gu32;
typedef GAS unsigned long long gu64;
#define RLX_AGENT __ATOMIC_RELAXED, __HIP_MEMORY_SCOPE_AGENT
#define LDS_WAIT() asm volatile("s_waitcnt lgkmcnt(0)" ::: "memory")
#define VM_WAIT() asm volatile("s_waitcnt vmcnt(0)" ::: "memory")
__device__ __forceinline__ unsigned long long rt() { return __builtin_amdgcn_s_memrealtime(); }
__device__ __forceinline__ unsigned f2bf(float f) { unsigned u = __builtin_bit_cast(unsigned, f); return (u + 0x7fffu + ((u >> 16) & 1u)) >> 16; }
__device__ __forceinline__ unsigned pk2(float lo, float hi) { return f2bf(lo) | (f2bf(hi) << 16); }

#define XB_TMO      128
#define XB_XCNT(j)  (256  + 64 * (j))
#define XB_XSUB(j)  (1280 + 64 * (j))
#define XB_XGEN(j)  (2304 + 64 * (j))
#define XB_TOP      3328
#define XB_TOPGEN   3392
#define XCD_BAR_WORDS 3456
#define XB_SPIN_CAP (1u << 18)

__device__ __forceinline__ unsigned xb_ld(unsigned* p)              { return __hip_atomic_load(p, __ATOMIC_RELAXED, __HIP_MEMORY_SCOPE_AGENT); }
__device__ __forceinline__ unsigned xb_add(unsigned* p, unsigned v) { return __hip_atomic_fetch_add(p, v, __ATOMIC_RELAXED, __HIP_MEMORY_SCOPE_AGENT); }
__device__ __forceinline__ unsigned xb_xcc_id() { return (unsigned)__builtin_amdgcn_s_getreg((3 << 11) | 20) & 0xFu; }
#define XB_SPIN(cond, bar) do { unsigned _sp = 0; while (cond) { __builtin_amdgcn_s_sleep(1); \
    if ((++_sp & 255u) == 0u) { if (xb_ld(&(bar)[XB_TMO])) break; if (_sp > XB_SPIN_CAP) { atomicAdd(&(bar)[XB_TMO], 1u); break; } } } } while (0)

struct XcdBarrier {
    unsigned* bar; unsigned x;
    volatile LAS unsigned* st;
};

__device__ __forceinline__ XcdBarrier xcd_barrier_post(unsigned* bar, volatile LAS unsigned* st) {
    XcdBarrier b; b.bar = bar; b.x = xb_xcc_id(); b.st = st;
    if (threadIdx.x == 0) (void)xb_add(&bar[XB_XCNT(b.x)], 1u);
    return b;
}
__device__ __forceinline__ void xcd_barrier_complete(unsigned* bar, unsigned x, unsigned& nloc, unsigned& nx) {
    const unsigned G = gridDim.x * gridDim.y * gridDim.z;
    unsigned sum, cnt, mine, sp = 0u;
    for (;;) {
        sum = 0u; cnt = 0u; mine = 0u;
#pragma unroll
        for (unsigned j = 0; j < 16; ++j) { const unsigned c = xb_ld(&bar[XB_XCNT(j)]); sum += c; cnt += (c > 0u) ? 1u : 0u; mine = (j == x) ? c : mine; }
        if (sum == G) break;
        __builtin_amdgcn_s_sleep(1);
        if ((++sp & 255u) == 0u) { if (xb_ld(&bar[XB_TMO])) break; if (sp > XB_SPIN_CAP) { atomicAdd(&bar[XB_TMO], 1u); break; } }
    }
    nloc = mine > 0u ? mine : 1u; nx = cnt > 0u ? cnt : 1u;
}

__device__ __forceinline__ void xcd_barrier(const XcdBarrier& b) {
    asm volatile("s_waitcnt vmcnt(0)" ::: "memory");
    __syncthreads();
    if (threadIdx.x == 0) {
        unsigned* bar = b.bar; unsigned bx_ = b.x; asm volatile("" : "+s"(bar));
        __builtin_amdgcn_s_waitcnt(0);
        unsigned nloc = b.st[0], nx = b.st[1];
        if (nloc == 0u) { xcd_barrier_complete(bar, bx_, nloc, nx); b.st[0] = nloc; b.st[1] = nx; }
        const unsigned old = xb_add(&bar[XB_XSUB(bx_)], 1u);
        const unsigned gen = old / nloc;
        if (old + 1u == (gen + 1u) * nloc) {
            __builtin_amdgcn_fence(__ATOMIC_RELEASE, "agent");
            asm volatile("s_waitcnt vmcnt(0)" ::: "memory");
            const unsigned og = xb_add(&bar[XB_TOP], 1u);
            const unsigned tg = og / nx;
            if (og + 1u == (tg + 1u) * nx) xb_add(&bar[XB_TOPGEN], 1u);
            else XB_SPIN(xb_ld(&bar[XB_TOPGEN]) == tg, bar);
            __builtin_amdgcn_fence(__ATOMIC_ACQUIRE, "agent");
            xb_add(&bar[XB_XGEN(bx_)], 1u);
            asm volatile("s_waitcnt vmcnt(0)" ::: "memory");
        } else {
            XB_SPIN(xb_ld(&bar[XB_XGEN(bx_)]) == gen, bar);
            __builtin_amdgcn_fence(__ATOMIC_ACQUIRE, "agent");
            asm volatile("s_waitcnt vmcnt(0)" ::: "memory");
        }
    }
    __syncthreads();
}

constexpr int NLAT = 16384, NCTXR = 1024, MALL = 17408, DM = 1024, PIN = 2464, PINP = 2560, FF = 4096, KEYS = 4352;
constexpr float EPS = 1e-6f, LOG2E = 1.4426950408889634f;
constexpr float QSCALE = 0.10206207261596575f * 1.4426950408889634f;
constexpr float NA_C2 = 0.125f * 1.4426950408889634f;
constexpr int NWAVES = 8;
constexpr size_t MiB = 1u << 20;
constexpr size_t WS_CTL = 0, CTL_ZERO_BYTES = 64 * 1024;
constexpr size_t WS_MOD = 1 * MiB, WS_RSQ = 1 * MiB + 256 * 1024, WS_RSKV = 1 * MiB + 384 * 1024;
constexpr size_t WS_WIN = 2 * MiB, WS_WOUT = 7 * MiB, WS_W1 = 9 * MiB, WS_W2 = 17 * MiB, WS_WUQ = 25 * MiB, WS_WUKV = 25 * MiB + 256 * 1024, WS_WPW = 25 * MiB + 512 * 1024;
constexpr size_t WS_R0C = 26 * MiB, WS_R1 = 30 * MiB, WS_U = 98 * MiB, WS_Y = 183 * MiB, WS_QM = 217 * MiB, WS_A1 = 98 * MiB, WS_KM = 234 * MiB, WS_VTM = WS_KM + (size_t)16 * 4352 * 96 * 2;
constexpr size_t WS_NVT = WS_R1, WS_SCF = WS_R1 + 16 * MiB;
static_assert(WS_VTM + (size_t)16 * 64 * 4352 * 2 <= 256 * MiB, "ws map");
static_assert(WS_QM + (size_t)MALL * 384 * 2 <= WS_KM && WS_A1 + (size_t)MALL * FF * 2 <= WS_KM, "ws map");
constexpr int CW_BAR = 1024;
constexpr int RING_BYTES = 131072, MISC_OFF = RING_BYTES + 320, LDS_BYTES = 147456;

typedef unsigned v2u __attribute__((ext_vector_type(2)));
typedef float f32x16 __attribute__((ext_vector_type(16)));
__device__ __forceinline__ float bflo(unsigned w) { return __builtin_bit_cast(float, w << 16); }
__device__ __forceinline__ float bfhi(unsigned w) { return __builtin_bit_cast(float, w & 0xffff0000u); }
__device__ __forceinline__ float bf1(bf16 h) { return __builtin_bit_cast(float, (unsigned)h << 16); }
__device__ __forceinline__ float wave_sum(float v) {
#pragma unroll
    for (int o = 1; o < 64; o <<= 1) v += __shfl_xor(v, o);
    return v;
}
__device__ __forceinline__ float sigmoidf_(float x) { return 1.0f / (1.0f + __expf(-x)); }

struct Args { const float* in[25]; float* out; unsigned char* ws; int never; int pad; };

struct Frame {
    LAS unsigned char* lds;
    int tid, lane, wave, vcu, G;
    unsigned char* ws;
};
constexpr int PTAB_OFF = 131072 + 1024;
__device__ __forceinline__ const float* fin(const Frame& F, int i) {
    const volatile LAS unsigned* t = (const volatile LAS unsigned*)(F.lds + PTAB_OFF) + 2 * i;
    const unsigned lo = __builtin_amdgcn_readfirstlane(t[0]), hi = __builtin_amdgcn_readfirstlane(t[1]);
    return (const float*)(((unsigned long long)hi << 32) | lo);
}
__device__ __forceinline__ float* fout(const Frame& F) { return (float*)fin(F, 25); }
__device__ __forceinline__ unsigned char* wsl(const Frame& F) { return F.ws; }

struct AttnDesc { const bf16* q; int qpitch; bf16* o; const bf16* k0; const bf16* k1; const bf16* v0; const bf16* v1; int kpitch; int nseg0; int nt; int cq; int offr0; const LAS float* rpb; };
__device__ __forceinline__ int crow(int r, int hi) { return (r & 3) + 8 * (r >> 2) + 4 * hi; }

template <int DQK, int NGRP, int MODE>
__device__ __forceinline__ void attn_unit(LAS unsigned char* lds, const AttnDesc d) {
    constexpr int KP = DQK + 8, VP = 68, KBYTES = 64 * KP * 2, VBYTES = 64 * VP * 2, TG = 512 / NGRP, NKC = 64 * DQK / 8, NKI = (NKC + TG - 1) / TG, NVI = 512 / TG, CPR = DQK / 8, NKS = DQK / 16;
    int tid_ = threadIdx.x; asm volatile("" : "+v"(tid_));
    const int tid = tid_, lane = tid & 63, r32 = lane & 31, hi = lane >> 5;
    const int g = tid / TG, tg = tid % TG;
    LAS unsigned char* Ks = lds + g * (KBYTES + VBYTES); LAS unsigned char* Vs = Ks + KBYTES;
    bf16x8 qf[NKS];
#pragma unroll
    for (int ks = 0; ks < NKS; ++ks) qf[ks] = *(const bf16x8*)(d.q + (size_t)r32 * d.qpitch + ks * 16 + hi * 8);
    f32x16 o0, o1;
#pragma unroll
    for (int r = 0; r < 16; ++r) { o0[r] = 0.f; o1[r] = 0.f; }
    float mrun = -INFINITY, lrun = 0.f;
    v4u kreg[NKI], vreg[NVI];
#define ATT_LOAD(kt_) do { const int kt__ = (kt_); \
        const bf16* kb_ = kt__ < d.nseg0 ? d.k0 + (size_t)kt__ * 64 * d.kpitch : d.k1 + (size_t)(kt__ - d.nseg0) * 64 * d.kpitch; \
        const bf16* vb_ = kt__ < d.nseg0 ? d.v0 + kt__ * 64 : d.v1 + (kt__ - d.nseg0) * 64; \
        _Pragma("unroll") for (int i = 0; i < NKI; ++i) { const int c = tg + i * TG; if ((NKC % TG == 0) || c < NKC) { const int row = c / CPR, cc = c % CPR; kreg[i] = *(const v4u*)(kb_ + (size_t)row * d.kpitch + cc * 8); } } \
        _Pragma("unroll") for (int i = 0; i < NVI; ++i) { const int c = tg + i * TG; const int row = c >> 3, cc = c & 7; vreg[i] = *(const v4u*)(vb_ + (size_t)row * KEYS + cc * 8); } } while (0)
    ATT_LOAD(0);
    for (int kt = 0; kt < d.nt; ++kt) {
        __syncthreads();
#pragma unroll
        for (int i = 0; i < NKI; ++i) { const int c = tg + i * TG; if ((NKC % TG == 0) || c < NKC) { const int row = c / CPR, cc = c % CPR; *(LAS v4u*)(Ks + row * (KP * 2) + cc * 16) = kreg[i]; } }
#pragma unroll
        for (int i = 0; i < NVI; ++i) { const int c = tg + i * TG; const int row = c >> 3, cc = c & 7; LAS v2u* p = (LAS v2u*)(Vs + row * (VP * 2) + cc * 16); p[0] = (v2u){vreg[i].x, vreg[i].y}; p[1] = (v2u){vreg[i].z, vreg[i].w}; }
        __syncthreads();
        if (kt + 1 < d.nt) ATT_LOAD(kt + 1);
        f32x16 s0, s1;
#pragma unroll
        for (int r = 0; r < 16; ++r) { s0[r] = 0.f; s1[r] = 0.f; }
#pragma unroll
        for (int ks = 0; ks < NKS; ++ks) {
            const bf16x8 kf0 = *(const LAS bf16x8*)(Ks + r32 * (KP * 2) + ks * 32 + hi * 16);
            const bf16x8 kf1 = *(const LAS bf16x8*)(Ks + (32 + r32) * (KP * 2) + ks * 32 + hi * 16);
            s0 = __builtin_amdgcn_mfma_f32_32x32x16_bf16(kf0, qf[ks], s0, 0, 0, 0);
            s1 = __builtin_amdgcn_mfma_f32_32x32x16_bf16(kf1, qf[ks], s1, 0, 0, 0);
        }
        if (MODE == 1) {
#pragma unroll
            for (int r = 0; r < 16; ++r) { s0[r] *= NA_C2; s1[r] *= NA_C2; }
        }
        if (MODE == 2) {
            if (kt < 8) {
                const int cqa = d.cq + r32; const int cs = min(max(cqa - 8, 0), 48);
                const LAS float* rp = d.rpb + (d.offr0 + kt) * 31 + (15 - cqa);
#pragma unroll
                for (int r = 0; r < 16; ++r) {
                    const int ck0 = crow(r, hi), ck1 = 32 + ck0;
                    const bool ok0 = (ck0 >= cs) && (ck0 < cs + 16), ok1 = (ck1 >= cs) && (ck1 < cs + 16);
                    const float b0 = ok0 ? rp[ck0] : 0.f, b1 = ok1 ? rp[ck1] : 0.f;
                    s0[r] = ok0 ? s0[r] * NA_C2 + b0 : -INFINITY; s1[r] = ok1 ? s1[r] * NA_C2 + b1 : -INFINITY;
                }
            } else {
#pragma unroll
                for (int r = 0; r < 16; ++r) { s0[r] *= NA_C2; s1[r] *= NA_C2; }
            }
        }
        float mx = fmaxf(s0[0], s1[0]);
#pragma unroll
        for (int r = 1; r < 16; ++r) mx = fmaxf(mx, fmaxf(s0[r], s1[r]));
        mx = fmaxf(mx, __shfl_xor(mx, 32));
        const float mnew = fmaxf(mrun, mx);
        const float alpha = __builtin_amdgcn_exp2f(mrun - mnew);
        mrun = mnew;
        float ps = 0.f;
#pragma unroll
        for (int r = 0; r < 16; ++r) { s0[r] = __builtin_amdgcn_exp2f(s0[r] - mnew); s1[r] = __builtin_amdgcn_exp2f(s1[r] - mnew); ps += s0[r] + s1[r]; }
        lrun = lrun * alpha + ps;
#pragma unroll
        for (int r = 0; r < 16; ++r) { o0[r] *= alpha; o1[r] *= alpha; }
        bf16x8 pf[2][2];
#pragma unroll
        for (int sp = 0; sp < 2; ++sp) {
            v4u w0, w1;
            w0.x = pg8::cvt_pk_bf16(s0[8 * sp + 0], s0[8 * sp + 1]); w0.y = pg8::cvt_pk_bf16(s0[8 * sp + 2], s0[8 * sp + 3]); w0.z = pg8::cvt_pk_bf16(s0[8 * sp + 4], s0[8 * sp + 5]); w0.w = pg8::cvt_pk_bf16(s0[8 * sp + 6], s0[8 * sp + 7]);
            w1.x = pg8::cvt_pk_bf16(s1[8 * sp + 0], s1[8 * sp + 1]); w1.y = pg8::cvt_pk_bf16(s1[8 * sp + 2], s1[8 * sp + 3]); w1.z = pg8::cvt_pk_bf16(s1[8 * sp + 4], s1[8 * sp + 5]); w1.w = pg8::cvt_pk_bf16(s1[8 * sp + 6], s1[8 * sp + 7]);
            pf[0][sp] = __builtin_bit_cast(bf16x8, w0); pf[1][sp] = __builtin_bit_cast(bf16x8, w1);
        }
#pragma unroll
        for (int sub = 0; sub < 2; ++sub)
#pragma unroll
            for (int sp = 0; sp < 2; ++sp) {
                const int koff = (sub * 32 + 16 * sp + 4 * hi) * 2;
                const LAS v2u* pa = (const LAS v2u*)(Vs + r32 * (VP * 2) + koff);
                const LAS v2u* pb = (const LAS v2u*)(Vs + (32 + r32) * (VP * 2) + koff);
                const v2u a0 = pa[0], a1 = pa[2], b0 = pb[0], b1 = pb[2];
                const bf16x8 vf0 = __builtin_bit_cast(bf16x8, (v4u){a0.x, a0.y, a1.x, a1.y});
                const bf16x8 vf1 = __builtin_bit_cast(bf16x8, (v4u){b0.x, b0.y, b1.x, b1.y});
                o0 = __builtin_amdgcn_mfma_f32_32x32x16_bf16(vf0, pf[sub][sp], o0, 0, 0, 0);
                o1 = __builtin_amdgcn_mfma_f32_32x32x16_bf16(vf1, pf[sub][sp], o1, 0, 0, 0);
            }
    }
#undef ATT_LOAD
    const float ltot = lrun + __shfl_xor(lrun, 32);
    const float inv = 1.0f / ltot;
    bf16* orow = d.o + (size_t)r32 * 1024 + 4 * hi;
#pragma unroll
    for (int g4 = 0; g4 < 4; ++g4) {
        v2u w; w.x = pg8::cvt_pk_bf16(o0[4 * g4 + 0] * inv, o0[4 * g4 + 1] * inv); w.y = pg8::cvt_pk_bf16(o0[4 * g4 + 2] * inv, o0[4 * g4 + 3] * inv);
        *(v2u*)(orow + 8 * g4) = w;
        v2u x; x.x = pg8::cvt_pk_bf16(o1[4 * g4 + 0] * inv, o1[4 * g4 + 1] * inv); x.y = pg8::cvt_pk_bf16(o1[4 * g4 + 2] * inv, o1[4 * g4 + 3] * inv);
        *(v2u*)(orow + 32 + 8 * g4) = x;
    }
}

__device__ __forceinline__ void p0_transpose_item(const float* W, int K, int N, bf16* WT, int row_off, LAS float* scr, int item, int lane) {
    const int nblk = N / 32, kb = item / nblk, nb = item % nblk, k0 = 64 * kb, n0 = 32 * nb;
#pragma unroll 8
    for (int i = 0; i < 32; ++i) { const int kk = 2 * i + (lane >> 5); scr[kk * 33 + (lane & 31)] = W[(size_t)(k0 + kk) * N + n0 + (lane & 31)]; }
    LDS_WAIT(); asm volatile("" ::: "memory");
    const int c = lane & 7;
#pragma unroll
    for (int j = 0; j < 4; ++j) { const int n = (lane >> 3) + 8 * j; const LAS float* s = scr + (8 * c) * 33 + n;
        v4u o; o.x = pk2(s[0 * 33], s[1 * 33]); o.y = pk2(s[2 * 33], s[3 * 33]); o.z = pk2(s[4 * 33], s[5 * 33]); o.w = pk2(s[6 * 33], s[7 * 33]);
        *(v4u*)(WT + (size_t)(row_off + n0 + n) * K + k0 + 8 * c) = o; }
    LDS_WAIT(); asm volatile("" ::: "memory");
}
__device__ __forceinline__ void convert_weights(Frame& F, int L) {
    unsigned char* const ws_ = wsl(F);
    LAS float* scr = (LAS float*)(F.lds + F.wave * 16384);
    const int gw = F.vcu * NWAVES + F.wave, NGW = F.G * NWAVES;
    const float* w_in = fin(F, 7) + (size_t)L * DM * PIN; const float* w_out = fin(F, 19) + (size_t)L * DM * DM;
    const float* w1 = fin(F, 22) + (size_t)L * DM * FF; const float* w2 = fin(F, 23) + (size_t)L * FF * DM;
    bf16* WIN = (bf16*)(ws_ + WS_WIN); bf16* WOUT = (bf16*)(ws_ + WS_WOUT); bf16* W1 = (bf16*)(ws_ + WS_W1); bf16* W2 = (bf16*)(ws_ + WS_W2);
    constexpr int I_IN = (DM / 64) * (PIN / 32), I_O = (DM / 64) * (DM / 32), I_1 = (DM / 64) * (FF / 32), I_2 = (FF / 64) * (DM / 32);
    constexpr int NITEMS = I_IN + I_O + I_1 + I_2;
    for (int it = gw; it < NITEMS; it += NGW) {
        int r = it;
        if (r < I_IN) { p0_transpose_item(w_in, DM, PIN, WIN, 0, scr, r, F.lane); continue; } r -= I_IN;
        if (r < I_O) { p0_transpose_item(w_out, DM, DM, WOUT, 0, scr, r, F.lane); continue; } r -= I_O;
        if (r < I_1) { p0_transpose_item(w1, DM, FF, W1, 0, scr, r, F.lane); continue; } r -= I_1;
        p0_transpose_item(w2, FF, DM, W2, 0, scr, r, F.lane);
    }
    const float* w_uq = fin(F, 10) + (size_t)L * 256 * 384; const float* g_q = fin(F, 9) + L * 256;
    const float* w_ukv = fin(F, 12) + (size_t)L * 128 * 512; const float* g_kv = fin(F, 11) + L * 128;
    const float* w_pw = fin(F, 17) + (size_t)L * 256 * 256;
    bf16* WUQ = (bf16*)(ws_ + WS_WUQ); bf16* WUKV = (bf16*)(ws_ + WS_WUKV); bf16* WPW = (bf16*)(ws_ + WS_WPW);
    const int gt = F.vcu * 512 + F.tid, NGT = F.G * 512;
    constexpr int E_UQ = 512 * 256, E_UKV = 512 * 256, E_PW = 256 * 256, E_PAD = (PINP - PIN) * DM;
    for (int e = gt; e < E_UQ + E_UKV + E_PW + E_PAD; e += NGT) {
        int r = e;
        if (r < E_UQ) { const int n = r >> 8, k = r & 255; float v = 0.f;
            if (n < 384) { const int head = n / 96, d = n % 96; int od = d;
                if (d >= 64) { const int j = d - 64; od = 64 + (j < 16 ? (j & 1) * 8 + (j >> 1) : 16 + ((j - 16) & 1) * 8 + ((j - 16) >> 1)); }
                v = w_uq[(size_t)k * 384 + head * 96 + od] * g_q[k]; }
            WUQ[r] = (bf16)f2bf(v); continue; } r -= E_UQ;
        if (r < E_UKV) { const int n = r >> 8, k = r & 255; float v = 0.f; if (k < 128) v = w_ukv[(size_t)k * 512 + n] * g_kv[k]; WUKV[r] = (bf16)f2bf(v); continue; } r -= E_UKV;
        if (r < E_PW) { const int n = r >> 8, k = r & 255; WPW[r] = (bf16)f2bf(w_pw[(size_t)k * 256 + n]); continue; } r -= E_PW;
        WIN[(size_t)PIN * DM + r] = 0;
    }
}
__device__ __forceinline__ void mod_gemv(Frame& F) {
    unsigned char* const ws_ = wsl(F);
    LAS float* red = (LAS float*)F.lds;
    float* MOD = (float*)(ws_ + WS_MOD);
    const float* c = fin(F, 1); const float* cctx = fin(F, 3);
    for (int unit = F.vcu; unit < 192; unit += F.G) {
        const int L = unit / 96, n0 = (unit % 96) * 64;
        const float* W = fin(F, 4) + (size_t)L * DM * 6144; const float* bm = fin(F, 5) + L * 6144;
        const int cg = F.tid & 15, ks = F.tid >> 4;
        float acc[5][4];
#pragma unroll
        for (int v = 0; v < 5; ++v)
#pragma unroll
            for (int e = 0; e < 4; ++e) acc[v][e] = 0.f;
        for (int kk = 0; kk < 32; ++kk) { const int k = ks * 32 + kk;
            const f32x4 w = *(const f32x4*)(W + (size_t)k * 6144 + n0 + cg * 4);
#pragma unroll
            for (int v = 0; v < 5; ++v) { const float cv = v < 4 ? c[v * DM + k] : cctx[k]; const float s = cv * sigmoidf_(cv);
#pragma unroll
                for (int e = 0; e < 4; ++e) acc[v][e] += s * w[e]; } }
        __syncthreads();
#pragma unroll
        for (int v = 0; v < 5; ++v)
#pragma unroll
            for (int e = 0; e < 4; ++e) red[(ks * 5 + v) * 64 + cg * 4 + e] = acc[v][e];
        __syncthreads();
        if (F.tid < 320) { const int v = F.tid >> 6, col = F.tid & 63; float s = 0.f;
            for (int j = 0; j < 32; ++j) s += red[(j * 5 + v) * 64 + col];
            MOD[((size_t)L * 5 + v) * 6144 + n0 + col] = s + bm[n0 + col]; }
        __syncthreads();
    }
}

__device__ __forceinline__ const float* xrow_src(Frame& F, int L, int row) {
    if (L == 0) return row < NLAT ? fin(F, 0) + (size_t)row * DM : fin(F, 2) + (size_t)(row - NLAT) * DM;
    return row < NLAT ? fout(F) + (size_t)row * DM : (const float*)(F.ws + WS_R0C) + (size_t)(row - NLAT) * DM;
}
__device__ __forceinline__ float* r0row(Frame& F, int row) { return row < NLAT ? fout(F) + (size_t)row * DM : (float*)(F.ws + WS_R0C) + (size_t)(row - NLAT) * DM; }
__device__ __forceinline__ void load_row(const float* p, int lane, f32x4 (&v)[4]) {
#pragma unroll
    for (int j = 0; j < 4; ++j) v[j] = *(const f32x4*)(p + 4 * lane + 256 * j);
}
__device__ __forceinline__ float row_rstd(const f32x4 (&v)[4]) {
    float s = 0.f;
#pragma unroll
    for (int j = 0; j < 4; ++j) s += (v[j].x * v[j].x + v[j].y * v[j].y) + (v[j].z * v[j].z + v[j].w * v[j].w);
    return 1.0f / sqrtf(wave_sum(s) * (1.0f / DM) + EPS);
}
__device__ __forceinline__ void write_modnorm(const f32x4 (&x)[4], float rstd, const float* g, const float* sc, const float* sh, bf16* dst, int lane) {
#pragma unroll
    for (int j = 0; j < 4; ++j) { const int c = 4 * lane + 256 * j;
        const f32x4 gv = *(const f32x4*)(g + c), scv = *(const f32x4*)(sc + c), shv = *(const f32x4*)(sh + c);
        const f32x4 h = (x[j] * rstd * gv) * (scv + 1.0f) + shv;
        v2u w; w.x = pk2(h.x, h.y); w.y = pk2(h.z, h.w);
        *(v2u*)(dst + c) = w; }
}
__device__ __forceinline__ void pass_prep(Frame& F, int L) {
    unsigned char* const ws_ = wsl(F);
    const int gw = F.vcu * NWAVES + F.wave, NGW = F.G * NWAVES;
    const float* MOD = (const float*)(ws_ + WS_MOD) + (size_t)L * 5 * 6144;
    const float* g = fin(F, 6) + L * DM;
    for (int row = gw; row < MALL; row += NGW) {
        f32x4 x[4]; load_row(xrow_src(F, L, row), F.lane, x);
        const float rstd = row_rstd(x);
        const float* mv = MOD + (row < NLAT ? (row >> 12) : 4) * 6144;
        write_modnorm(x, rstd, g, mv + 1024, mv + 0, (bf16*)(ws_ + WS_R1 + (size_t)row * 4096), F.lane);
    }
}
__device__ __forceinline__ void pass_postwo(Frame& F, int L, int nrows) {
    unsigned char* const ws_ = wsl(F);
    const int gw = F.vcu * NWAVES + F.wave, NGW = F.G * NWAVES;
    const float* MOD = (const float*)(ws_ + WS_MOD) + (size_t)L * 5 * 6144;
    const float* gpost = fin(F, 20) + L * DM; const float* gpre = fin(F, 21) + L * DM;
    for (int row = gw; row < nrows; row += NGW) {
        float* yrow = (float*)(ws_ + WS_R1 + (size_t)row * 4096);
        f32x4 y[4], x[4];
        if (L == 0 && row >= NLAT) { const float* sl = (const float*)(ws_ + WS_U) + (size_t)(row - NLAT) * DM; f32x4 t[4]; load_row(sl, F.lane, y);
#pragma unroll
            for (int q = 1; q < 4; ++q) { load_row(sl + (size_t)q * NCTXR * DM, F.lane, t);
#pragma unroll
                for (int j = 0; j < 4; ++j) y[j] = y[j] + t[j]; } }
        else load_row(yrow, F.lane, y);
        load_row(xrow_src(F, L, row), F.lane, x);
        const float ry = row_rstd(y);
        const float* mv = MOD + (row < NLAT ? (row >> 12) : 4) * 6144;
#pragma unroll
        for (int j = 0; j < 4; ++j) { const int c = 4 * F.lane + 256 * j;
            const f32x4 gv = *(const f32x4*)(gpost + c), ga = *(const f32x4*)(mv + 2048 + c);
            x[j] = x[j] + ga * (y[j] * ry * gv); }
        float* xo = r0row(F, row);
#pragma unroll
        for (int j = 0; j < 4; ++j) *(f32x4*)(xo + 4 * F.lane + 256 * j) = x[j];
        const float r1 = row_rstd(x);
        write_modnorm(x, r1, gpre, mv + 4096, mv + 3072, (bf16*)yrow, F.lane);
    }
}
__device__ __forceinline__ void pass_postmlp(Frame& F, int L, int nrows) {
    unsigned char* const ws_ = wsl(F);
    const int gw = F.vcu * NWAVES + F.wave, NGW = F.G * NWAVES;
    const float* MOD = (const float*)(ws_ + WS_MOD) + (size_t)L * 5 * 6144;
    const float* gpost = fin(F, 24) + L * DM;
    for (int row = gw; row < nrows; row += NGW) {
        float* mrow = (float*)(ws_ + WS_R1 + (size_t)row * 4096);
        float* xo = r0row(F, row);
        f32x4 y[4], x[4];
        if (L == 0 && row >= NLAT) { const float* sl = (const float*)(ws_ + WS_KM) + (size_t)(row - NLAT) * DM; f32x4 t[4]; load_row(sl, F.lane, y);
#pragma unroll
            for (int q = 1; q < 4; ++q) { load_row(sl + (size_t)q * NCTXR * DM, F.lane, t);
#pragma unroll
                for (int j = 0; j < 4; ++j) y[j] = y[j] + t[j]; } }
        else load_row(mrow, F.lane, y);
        load_row(xo, F.lane, x);
        const float ry = row_rstd(y);
        const float* mv = MOD + (row < NLAT ? (row >> 12) : 4) * 6144;
#pragma unroll
        for (int j = 0; j < 4; ++j) { const int c = 4 * F.lane + 256 * j;
            const f32x4 gv = *(const f32x4*)(gpost + c), ga = *(const f32x4*)(mv + 5120 + c);
            x[j] = x[j] + ga * (y[j] * ry * gv); }
#pragma unroll
        for (int j = 0; j < 4; ++j) *(f32x4*)(xo + 4 * F.lane + 256 * j) = x[j];
        if (L == 0) {
            const float* mv1 = mv + 5 * 6144;
            const float r1 = row_rstd(x);
            write_modnorm(x, r1, fin(F, 6) + DM, mv1 + 1024, mv1 + 0, (bf16*)mrow, F.lane);
        }
    }
}

__device__ __forceinline__ void row_bk(int row, int& b, int& kk) { if (row < NLAT) { b = row >> 12; kk = row & 4095; } else { const int r2 = row - NLAT; b = r2 >> 8; kk = 4096 + (r2 & 255); } }
__device__ __forceinline__ void pass_mix(Frame& F, int L) {
    unsigned char* const ws_ = wsl(F);
    const bf16* U = (const bf16*)(ws_ + WS_U); bf16* Y = (bf16*)(ws_ + WS_Y);
    {
        const float* wsc = fin(F, 8) + L * 3 * 256;
        const int gt = F.vcu * 512 + F.tid, NGT = F.G * 512;
        for (int idx = gt; idx < MALL * 32; idx += NGT) {
            const int row = idx >> 5, c8 = idx & 31;
            int t, len; if (row < NLAT) { t = row & 4095; len = 4096; } else { t = (row - NLAT) & 255; len = 256; }
            const bf16* ur = U + (size_t)row * PINP + c8 * 8;
            float acc[8];
#pragma unroll
            for (int e = 0; e < 8; ++e) acc[e] = 0.f;
#pragma unroll
            for (int k = 0; k < 3; ++k) { const int tt = t + k - 1; if (tt < 0 || tt >= len) continue;
                const bf16* up = ur + (ptrdiff_t)(k - 1) * PINP;
                const v4u xi = *(const v4u*)(up), cg = *(const v4u*)(up + 512);
                const f32x4 w0 = *(const f32x4*)(wsc + k * 256 + c8 * 8), w1 = *(const f32x4*)(wsc + k * 256 + c8 * 8 + 4);
                acc[0] += w0.x * (bflo(xi.x) * bflo(cg.x)); acc[1] += w0.y * (bfhi(xi.x) * bfhi(cg.x));
                acc[2] += w0.z * (bflo(xi.y) * bflo(cg.y)); acc[3] += w0.w * (bfhi(xi.y) * bfhi(cg.y));
                acc[4] += w1.x * (bflo(xi.z) * bflo(cg.z)); acc[5] += w1.y * (bfhi(xi.z) * bfhi(cg.z));
                acc[6] += w1.z * (bflo(xi.w) * bflo(cg.w)); acc[7] += w1.w * (bfhi(xi.w) * bfhi(cg.w)); }
            const v4u bg = *(const v4u*)(ur + 256);
            v4u o; o.x = pk2(acc[0] * bflo(bg.x), acc[1] * bfhi(bg.x)); o.y = pk2(acc[2] * bflo(bg.y), acc[3] * bfhi(bg.y));
            o.z = pk2(acc[4] * bflo(bg.z), acc[5] * bfhi(bg.z)); o.w = pk2(acc[6] * bflo(bg.w), acc[7] * bfhi(bg.w));
            *(v4u*)(Y + (size_t)row * DM + c8 * 8) = o;
        }
    }
    {
        const int gw = F.vcu * NWAVES + F.wave, NGW = F.G * NWAVES;
        float* RSQ = (float*)(ws_ + WS_RSQ); float* RSKV = (float*)(ws_ + WS_RSKV); bf16* KM = (bf16*)(ws_ + WS_KM);
        for (int row = gw; row < MALL; row += NGW) {
            const bf16* ur = U + (size_t)row * PINP;
            float sq = 0.f, skv = 0.f;
            if (F.lane < 48) { const v4u w = *(const v4u*)(ur + 768 + F.lane * 8);
                float s = bflo(w.x) * bflo(w.x) + bfhi(w.x) * bfhi(w.x) + bflo(w.y) * bflo(w.y) + bfhi(w.y) * bfhi(w.y) + bflo(w.z) * bflo(w.z) + bfhi(w.z) * bfhi(w.z) + bflo(w.w) * bflo(w.w) + bfhi(w.w) * bfhi(w.w);
                if (F.lane < 32) sq = s; else skv = s; }
            sq = wave_sum(sq); skv = wave_sum(skv);
            if (F.lane == 0) { RSQ[row] = 1.0f / sqrtf(sq * (1.0f / 256.0f) + EPS); RSKV[row] = 1.0f / sqrtf(skv * (1.0f / 128.0f) + EPS); }
            if (F.lane < 16) { const int part = F.lane >> 3, i = F.lane & 7;
                float x1 = bf1(ur[1152 + part * 16 + i]), x2 = bf1(ur[1152 + part * 16 + 8 + i]);
                int b, kk; row_bk(row, b, kk);
                if (row < NLAT) { const int t = row & 4095, pos = part ? (t & 63) : (t >> 6); const float c = ROPE_TAB[(pos * 8 + i) * 2], s = ROPE_TAB[(pos * 8 + i) * 2 + 1];
                    const float a = x1 * c - x2 * s, bb = x1 * s + x2 * c; x1 = a; x2 = bb; }
                const unsigned w = pk2(x1, x2);
#pragma unroll
                for (int h = 0; h < 4; ++h) *(unsigned*)(KM + ((size_t)((b * 4 + h) * KEYS + kk)) * 96 + 64 + part * 16 + 2 * i) = w; }
        }
    }
    {
        LAS float* Z = (LAS float*)F.lds;
        LAS float* YL = (LAS float*)(F.lds + 62 * 1024);
        bf16* SCF = (bf16*)(ws_ + WS_SCF);
        const float* wdw = fin(F, 13) + (size_t)L * 31 * 256; const float* bdw = fin(F, 14) + L * 256; const float* lng = fin(F, 15) + L * 256; const float* lnb = fin(F, 16) + L * 256;
        for (int tile = F.vcu; tile < MALL / 32; tile += F.G) {
            const int row0 = tile * 32;
            int t0, len, base; if (row0 < NLAT) { t0 = row0 & 4095; len = 4096; base = row0 - t0; } else { t0 = (row0 - NLAT) & 255; len = 256; base = row0 - t0; }
            __syncthreads();
            for (int idx = F.tid; idx < 62 * 32; idx += 512) { const int tt = idx >> 5, c8 = idx & 31; const int tp = t0 + tt - 15;
                float z[8];
                if (tp >= 0 && tp < len) { const bf16* ur = U + (size_t)(base + tp) * PINP + 1184 + c8 * 8;
                    const v4u a = *(const v4u*)ur, gg = *(const v4u*)(ur + 256);
                    z[0] = bflo(a.x) * sigmoidf_(bflo(gg.x)); z[1] = bfhi(a.x) * sigmoidf_(bfhi(gg.x)); z[2] = bflo(a.y) * sigmoidf_(bflo(gg.y)); z[3] = bfhi(a.y) * sigmoidf_(bfhi(gg.y));
                    z[4] = bflo(a.z) * sigmoidf_(bflo(gg.z)); z[5] = bfhi(a.z) * sigmoidf_(bfhi(gg.z)); z[6] = bflo(a.w) * sigmoidf_(bflo(gg.w)); z[7] = bfhi(a.w) * sigmoidf_(bfhi(gg.w));
                } else {
#pragma unroll
                    for (int e = 0; e < 8; ++e) z[e] = 0.f; }
                *(LAS f32x4*)(Z + tt * 256 + c8 * 8) = (f32x4){z[0], z[1], z[2], z[3]}; *(LAS f32x4*)(Z + tt * 256 + c8 * 8 + 4) = (f32x4){z[4], z[5], z[6], z[7]}; }
            __syncthreads();
            { const int c = F.tid & 255, half = F.tid >> 8; const float bias = bdw[c];
                float acc[16];
#pragma unroll
                for (int i = 0; i < 16; ++i) acc[i] = bias;
                for (int k = 0; k < 31; ++k) { const float w = wdw[k * 256 + c];
#pragma unroll
                    for (int i = 0; i < 16; ++i) acc[i] += w * Z[(half * 16 + i + k) * 256 + c]; }
#pragma unroll
                for (int i = 0; i < 16; ++i) YL[(half * 16 + i) * 256 + c] = acc[i]; }
            __syncthreads();
#pragma unroll
            for (int q = 0; q < 4; ++q) { const int tok = F.wave * 4 + q;
                const f32x4 v = *(const LAS f32x4*)(YL + tok * 256 + F.lane * 4);
                const float mean = wave_sum((v.x + v.y) + (v.z + v.w)) * (1.0f / 256.0f);
                const f32x4 dv = v - mean;
                const float var = wave_sum((dv.x * dv.x + dv.y * dv.y) + (dv.z * dv.z + dv.w * dv.w)) * (1.0f / 256.0f);
                const float rs = 1.0f / sqrtf(var + EPS);
                const f32x4 gv = *(const f32x4*)(lng + F.lane * 4), bv = *(const f32x4*)(lnb + F.lane * 4);
                f32x4 o = dv * rs * gv + bv;
                o.x = o.x * sigmoidf_(o.x); o.y = o.y * sigmoidf_(o.y); o.z = o.z * sigmoidf_(o.z); o.w = o.w * sigmoidf_(o.w);
                v2u w; w.x = pk2(o.x, o.y); w.y = pk2(o.z, o.w);
                *(v2u*)(SCF + (size_t)(row0 + tok) * 256 + F.lane * 4) = w; }
        }
        __syncthreads();
    }
    {
        const int gw = F.vcu * NWAVES + F.wave, NGW = F.G * NWAVES;
        bf16* NVT = (bf16*)(ws_ + WS_NVT);
        for (int task = gw; task < (MALL / 64) * 32; task += NGW) {
            const int kb = task >> 5, ch = task & 31, h = ch >> 3, dv0 = (ch & 7) * 8;
            const int row = kb * 64 + F.lane; int b, kk; row_bk(row, b, kk);
            const v4u w = *(const v4u*)(U + (size_t)row * PINP + 2208 + ch * 8);
            bf16* vp = NVT + ((size_t)((b * 4 + h) * 64 + dv0)) * KEYS + kk;
            vp[0 * KEYS] = (bf16)(w.x & 0xffffu); vp[1 * KEYS] = (bf16)(w.x >> 16); vp[2 * KEYS] = (bf16)(w.y & 0xffffu); vp[3 * KEYS] = (bf16)(w.y >> 16);
            vp[4 * KEYS] = (bf16)(w.z & 0xffffu); vp[5 * KEYS] = (bf16)(w.z >> 16); vp[6 * KEYS] = (bf16)(w.w & 0xffffu); vp[7 * KEYS] = (bf16)(w.w >> 16);
        }
    }
}

__device__ __forceinline__ void pass_attn(Frame& F, int L) {
    unsigned char* const ws_ = wsl(F);
    const bf16* U = (const bf16*)(ws_ + WS_U); bf16* Y = (bf16*)(ws_ + WS_Y);
    const bf16* QM = (const bf16*)(ws_ + WS_QM); const bf16* KM = (const bf16*)(ws_ + WS_KM); const bf16* VTM = (const bf16*)(ws_ + WS_VTM); const bf16* NVT = (const bf16*)(ws_ + WS_NVT);
    for (int u = F.vcu; u < 256; u += F.G) {
        const int b = u >> 6, h = (u >> 4) & 3, qb = u & 15; const int row = b * 4096 + qb * 256 + F.wave * 32;
        AttnDesc d; d.q = QM + (size_t)row * 384 + h * 96; d.qpitch = 384; d.o = Y + (size_t)row * DM + 256 + h * 64;
        d.k0 = KM + (size_t)((b * 4 + h) * KEYS) * 96; d.k1 = d.k0; d.kpitch = 96; d.nseg0 = 68; d.nt = 68;
        d.v0 = VTM + (size_t)((b * 4 + h) * 64) * KEYS; d.v1 = d.v0; d.cq = 0; d.offr0 = 0; d.rpb = nullptr;
        attn_unit<96, 1, 0>(F.lds, d);
    }
    {
        LAS float* RP = (LAS float*)(F.lds + 4 * (64 * 72 * 2 + 64 * 68 * 2));
        const float* rpb = fin(F, 18) + (size_t)L * 4 * 15 * 31;
        __syncthreads();
        for (int i = F.tid; i < 4 * 15 * 31; i += 512) RP[i] = rpb[i] * LOG2E;
        for (int u = F.vcu; u < 256; u += F.G) {
            const int b = u >> 6, r = u & 63, h = F.wave >> 1, half = F.wave & 1; const int row = b * 4096 + r * 64 + half * 32;
            const int rs = min(max(r - 4, 0), 56);
            AttnDesc d; d.q = U + (size_t)row * PINP + 1696 + h * 64; d.qpitch = PINP; d.o = Y + (size_t)row * DM + 768 + h * 64;
            d.k0 = U + (size_t)(b * 4096 + rs * 64) * PINP + 1952 + h * 64; d.k1 = U + (size_t)(NLAT + b * 256) * PINP + 1952 + h * 64; d.kpitch = PINP; d.nseg0 = 8; d.nt = 12;
            d.v0 = NVT + (size_t)((b * 4 + h) * 64) * KEYS + rs * 64; d.v1 = NVT + (size_t)((b * 4 + h) * 64) * KEYS + 4096;
            d.cq = half * 32; d.offr0 = rs - r + 7; d.rpb = RP + h * 465;
            attn_unit<64, 4, 2>(F.lds, d);
        }
    }
    if (L == 0) {
        for (int u = F.vcu; u < 32; u += F.G) {
            const int bh = u & 15, b = bh >> 2, h = bh & 3; const int row = NLAT + b * 256 + F.wave * 32;
            AttnDesc d; d.cq = 0; d.offr0 = 0; d.rpb = nullptr; d.nseg0 = 4; d.nt = 4;
            if (u < 16) {
                d.q = QM + (size_t)row * 384 + h * 96; d.qpitch = 384; d.o = Y + (size_t)row * DM + 256 + h * 64;
                d.k0 = KM + (size_t)((b * 4 + h) * KEYS + 4096) * 96; d.k1 = d.k0; d.kpitch = 96;
                d.v0 = VTM + (size_t)((b * 4 + h) * 64) * KEYS + 4096; d.v1 = d.v0;
                attn_unit<96, 1, 0>(F.lds, d);
            } else {
                d.q = U + (size_t)row * PINP + 1696 + h * 64; d.qpitch = PINP; d.o = Y + (size_t)row * DM + 768 + h * 64;
                d.k0 = U + (size_t)(NLAT + b * 256) * PINP + 1952 + h * 64; d.k1 = d.k0; d.kpitch = PINP;
                d.v0 = NVT + (size_t)((b * 4 + h) * 64) * KEYS + 4096; d.v1 = d.v0;
                attn_unit<64, 1, 1>(F.lds, d);
            }
        }
    }
    __syncthreads();
}

__global__ void __launch_bounds__(NWAVES * 64, 2) hybrid_fwd(Args args) {
    extern __shared__ __attribute__((aligned(16))) unsigned char lds[];
    Frame F0;
    F0.lds = (LAS unsigned char*)lds;
    F0.tid = 0; F0.lane = 0; F0.wave = __builtin_amdgcn_readfirstlane((int)threadIdx.x >> 6);
    F0.G = gridDim.x; { const int bx = blockIdx.x; F0.vcu = (F0.G % 8 == 0) ? (bx % 8) * (F0.G / 8) + bx / 8 : bx; }
    F0.ws = args.ws;
    if (args.never) cooperative_groups::this_grid().sync();
    volatile LAS unsigned* MISC = (volatile LAS unsigned*)(F0.lds + MISC_OFF);
    for (int u = threadIdx.x; u < (LDS_BYTES - RING_BYTES) / 4; u += NWAVES * 64) ((LAS unsigned*)(F0.lds + RING_BYTES))[u] = 0u;
    __syncthreads();
    if (threadIdx.x == 0) { LAS unsigned* t = (LAS unsigned*)(F0.lds + PTAB_OFF);
#pragma unroll
        for (int i = 0; i < 25; ++i) { const unsigned long long p = (unsigned long long)args.in[i]; t[2 * i] = (unsigned)p; t[2 * i + 1] = (unsigned)(p >> 32); }
        const unsigned long long po = (unsigned long long)args.out; t[50] = (unsigned)po; t[51] = (unsigned)(po >> 32); }
    __syncthreads();
    unsigned* ctl = (unsigned*)(F0.ws + WS_CTL);
    XcdBarrier bar = xcd_barrier_post(ctl + CW_BAR, MISC + 8);
#define GRID_BAR() xcd_barrier(bar)
    const int bx0 = (int)blockIdx.x;

#define MKFRAME() Frame F = F0; int bx = bx0; { int t_ = threadIdx.x; asm volatile("" : "+v"(t_)); F.tid = t_; F.lane = t_ & 63; } \
        asm volatile("" : "+s"(F.wave), "+s"(F.vcu), "+s"(F.G), "+s"(F.ws), "+s"(bx)); LAS unsigned char* ring = F.lds; (void)ring; (void)bx
    constexpr int NPH = 20;
#pragma nounroll
    for (int ph = 0; ph < NPH; ++ph) {
        const int kind = ph < 2 ? ph : 2 + (ph - 2) % 9, L = ph < 2 ? 0 : (ph - 2) / 9;
        const int MR = (L == 0) ? MALL : NLAT;
        if (kind == 0) { MKFRAME(); mod_gemv(F); convert_weights(F, 0); }
        if (kind == 1) { MKFRAME(); pass_prep(F, 0); }
        if (kind == 3) { MKFRAME(); pass_mix(F, L); }
        if (kind == 4) {
            MKFRAME(); unsigned char* const ws_ = wsl(F);
            { pg8::Gemm g{(const pg8::bf16_t*)(ws_ + WS_U) + 768, (const pg8::bf16_t*)(ws_ + WS_WUQ), MALL, 512, 256, PINP, 256}; pg8::StaticOrder S; S.init(MALL, 512, F.G, bx);
              pg8::EpiUQ E{(pg8::bf16_t*)(ws_ + WS_QM), (const float*)(ws_ + WS_RSQ), ROPE_TAB, QSCALE};
              pg8::gemm_phase<pg8::EpiUQ, pg8::StaticOrder, true, true>(ring, g, S, E); }
            { pg8::Gemm g{(const pg8::bf16_t*)(ws_ + WS_U) + 1024, (const pg8::bf16_t*)(ws_ + WS_WUKV), MALL, 512, 256, PINP, 256}; pg8::StaticOrder S; S.init(MALL, 512, F.G, (bx + 136) % F.G);
              pg8::EpiUKV E{(pg8::bf16_t*)(ws_ + WS_KM), (pg8::bf16_t*)(ws_ + WS_VTM), (const float*)(ws_ + WS_RSKV)};
              pg8::gemm_phase<pg8::EpiUKV, pg8::StaticOrder, true, true>(ring, g, S, E); }
        }
        if (kind == 2 || kind == 4 || kind == 8) {
            MKFRAME(); unsigned char* const ws_ = wsl(F);
            pg8::Gemm g; pg8::EpiBf16 E; int c = bx;
            if (kind == 2) { g = pg8::Gemm{(const pg8::bf16_t*)(ws_ + WS_R1), (const pg8::bf16_t*)(ws_ + WS_WIN), MALL, PINP, DM, 2048, DM}; E = pg8::EpiBf16{(pg8::bf16_t*)(ws_ + WS_U), PINP, 0}; }
            else if (kind == 4) { g = pg8::Gemm{(const pg8::bf16_t*)(ws_ + WS_SCF), (const pg8::bf16_t*)(ws_ + WS_WPW), MALL, 256, 256, 256, 256}; E = pg8::EpiBf16{(pg8::bf16_t*)(ws_ + WS_Y) + 512, DM, 0}; c = (bx + 16) % F.G; }
            else { g = pg8::Gemm{(const pg8::bf16_t*)(ws_ + WS_R1), (const pg8::bf16_t*)(ws_ + WS_W1), MR, FF, DM, 2048, DM}; E = pg8::EpiBf16{(pg8::bf16_t*)(ws_ + WS_A1), FF, 2}; }
            pg8::StaticOrder S; S.init(g.M, g.N, F.G, c);
            pg8::gemm_phase<pg8::EpiBf16, pg8::StaticOrder, true, true>(ring, g, S, E);
        }
        if (kind == 5) { MKFRAME(); pass_attn(F, L); }
        if (kind == 6 || kind == 9) {
            MKFRAME(); unsigned char* const ws_ = wsl(F);
            pg8::Gemm g;
            if (kind == 6) g = pg8::Gemm{(const pg8::bf16_t*)(ws_ + WS_Y), (const pg8::bf16_t*)(ws_ + WS_WOUT), MR, DM, DM, DM, DM};
            else g = pg8::Gemm{(const pg8::bf16_t*)(ws_ + WS_A1), (const pg8::bf16_t*)(ws_ + WS_W2), MR, DM, FF, FF, FF};
            g.M = NLAT;
            pg8::StaticOrder S; S.init(g.M, g.N, F.G, bx);
            pg8::EpiF32 E{(float*)(ws_ + WS_R1), DM};
            pg8::gemm_phase<pg8::EpiF32, pg8::StaticOrder, true, true>(ring, g, S, E);
        }
        if ((kind == 6 || kind == 9) && L == 0) {
            MKFRAME(); unsigned char* const ws_ = wsl(F);
            const int K = (kind == 6) ? DM : FF;
            const int u = bx >> 2, slice = bx & 3, ks = K >> 2;
            pg8::OneUnit S1{64 + (u >> 2), u & 3, u < 16 ? 1 : 0};
            pg8::Gemm g2;
            if (kind == 6) g2 = pg8::Gemm{(const pg8::bf16_t*)(ws_ + WS_Y) + slice * ks, (const pg8::bf16_t*)(ws_ + WS_WOUT) + slice * ks, MALL, DM, ks, DM, DM};
            else g2 = pg8::Gemm{(const pg8::bf16_t*)(ws_ + WS_A1) + slice * ks, (const pg8::bf16_t*)(ws_ + WS_W2) + slice * ks, MALL, DM, ks, FF, FF};
            float* Cc = (float*)(ws_ + (kind == 6 ? WS_U : WS_KM)) + (size_t)slice * NCTXR * DM;
            pg8::EpiF32 E2{Cc - (size_t)NLAT * DM, DM};
            pg8::gemm_phase<pg8::EpiF32, pg8::OneUnit, true, true>(ring, g2, S1, E2);
        }
        if (kind == 7) { MKFRAME(); pass_postwo(F, L, MR); }
        if (kind == 10) { MKFRAME(); pass_postmlp(F, L, MR); if (L == 0) convert_weights(F, 1); }
        if (ph + 1 < NPH) GRID_BAR();
    }
#undef GRID_BAR
}

extern "C" void kernel_launch(void* const* d_in, const int* in_sizes, int n_in, void* d_out, int out_size, void* d_ws, size_t ws_size, hipStream_t stream) {
    static int grid = 0;
    if (grid == 0) {
        if (n_in != 25 || out_size != NLAT * DM || ws_size < 256 * MiB) { fprintf(stderr, "kernel_launch: unexpected shapes (n_in %d out %d ws %zu)\n", n_in, out_size, ws_size); grid = -1; return; }
        int dev = 0, cus = 0;
        if (hipGetDevice(&dev) != hipSuccess || hipDeviceGetAttribute(&cus, hipDeviceAttributeMultiprocessorCount, dev) != hipSuccess) { grid = -1; return; }
        if (hipFuncSetAttribute((const void*)hybrid_fwd, hipFuncAttributeMaxDynamicSharedMemorySize, LDS_BYTES) != hipSuccess) { fprintf(stderr, "kernel_launch: hipFuncSetAttribute failed\n"); grid = -1; return; }
        (void)hipGetLastError();
        grid = cus;
    }
    if (grid < 0) return;
    if (hipMemsetAsync((char*)d_ws + WS_CTL, 0, CTL_ZERO_BYTES, stream) != hipSuccess) { fprintf(stderr, "kernel_launch: memset failed\n"); return; }
    Args a{};
    for (int i = 0; i < 25; ++i) a.in[i] = (const float*)d_in[i];
    a.out = (float*)d_out; a.ws = (unsigned char*)d_ws; a.never = 0; a.pad = 0;
    void* kargs[] = {&a};
    hipError_t e = hipLaunchCooperativeKernel((const void*)hybrid_fwd, dim3(grid), dim3(NWAVES * 64), kargs, LDS_BYTES, stream);
    if (e != hipSuccess) fprintf(stderr, "kernel_launch: cooperative launch failed: %s (grid %d)\n", hipGetErrorString(e), grid);
}
```

```cpp
#include <hip/hip_runtime.h>
#include <cstdio>
#include <cstdint>
#include <hip/hip_cooperative_groups.h>
namespace pg8 {
#define PG8_LAS __attribute__((address_space(3)))
typedef unsigned short bf16_t;
typedef short bf16x8 __attribute__((ext_vector_type(8)));
typedef float f32x4 __attribute__((ext_vector_type(4)));
typedef unsigned u32x4 __attribute__((ext_vector_type(4)));
constexpr int BM = 256, BK = 64, HALF = 128, HTB = HALF * BK * 2  , STAGE_BYTES = 8 * HTB, NXCD = 8, WGM = 8;

__host__ __device__ __forceinline__ int lds_byte(int r, int c) { const int st = (r >> 4) * 2 + (c >> 5), rr = r & 15, cc = c & 31, ob = rr * 64 + cc * 2; return st * 1024 + (ob ^ (((ob >> 9) & 1) << 5)); }
__host__ __device__ __forceinline__ void stage_rc(int b, int& R, int& C) { const int st = b / 1024, sb = b % 1024, swz = sb ^ (((sb >> 9) & 1) << 5); R = (st >> 1) * 16 + swz / 64; C = (st & 1) * 32 + (swz % 64) / 2; }
__host__ __device__ __forceinline__ int perm32(int rho) { const int n = rho >> 4, i = rho & 15; return 8 * (i >> 2) + 4 * n + (i & 3); }

struct Unit { int pm, pn; };
struct Gemm { const bf16_t* A; const bf16_t* Bt; int M, N, K, lda, ldb; };

struct StaticOrder {
    int nM, nN, nwg, G, c;
    __host__ __device__ void init(int M, int N, int G_, int c_) { nM = M / BM; nN = N / BM; nwg = nM * nN; G = G_; c = c_; }
    __host__ __device__ bool next(int i, Unit& u) const {
        const long L = (long)i * G + c; if (L >= nwg) return false;
        int wgid = (int)L; { const int q = nwg / NXCD, r = nwg % NXCD, xcd = wgid % NXCD, off = wgid / NXCD; wgid = (xcd < r ? xcd * (q + 1) : r * (q + 1) + (xcd - r) * q) + off; }
        const int nig = WGM * nN, gid = wgid / nig, fm = gid * WGM, gsz = (nM - fm) < WGM ? (nM - fm) : WGM;
        u.pm = fm + ((wgid % nig) % gsz); u.pn = (wgid % nig) / gsz; return true;
    }
    __device__ __forceinline__ void a_ready(const Unit&) const {}
    __device__ __forceinline__ void done(const Unit&) const {}
};

__device__ __forceinline__ unsigned cvt_pk_bf16(float lo, float hi) { unsigned r; asm volatile("v_cvt_pk_bf16_f32 %0, %1, %2" : "=v"(r) : "v"(lo), "v"(hi)); return r; }
typedef float f32x2 __attribute__((ext_vector_type(2)));
struct EpiF32 {
    static constexpr bool PERM = false, AFTER_DRAIN = false;
    float* C; int ldc;
    __device__ __forceinline__ void operator()(const f32x4 (&acc)[2][2][4][2], const Unit& u, int wr, int wc, int fr, int fq) const {
        const int row0 = u.pm * BM + wr * 64 + fr, col0 = u.pn * BM + wc * 32 + 4 * fq;
#pragma unroll
        for (int ai = 0; ai < 2; ++ai)
#pragma unroll
            for (int m = 0; m < 4; ++m) { float* rowp = C + (size_t)(row0 + ai * HALF + m * 16) * ldc + col0;
#pragma unroll
                for (int bj = 0; bj < 2; ++bj)
#pragma unroll
                    for (int n = 0; n < 2; ++n) *(__attribute__((address_space(1))) f32x4*)(rowp + bj * HALF + n * 16) = acc[ai][bj][m][n]; }
    }
};
struct OneUnit {
    int pm, pn, on;
    __device__ __forceinline__ bool next(int i, Unit& u) const { if (i != 0 || !on) return false; u.pm = pm; u.pn = pn; return true; }
    __device__ __forceinline__ void a_ready(const Unit&) const {}
    __device__ __forceinline__ void done(const Unit&) const {}
};
struct EpiBf16 {
    static constexpr bool PERM = true, AFTER_DRAIN = false;
    bf16_t* O; int ldc; int ACT;
    __device__ __forceinline__ void operator()(const f32x4 (&acc)[2][2][4][2], const Unit& u, int wr, int wc, int fr, int fq) const {
        const int row0 = u.pm * BM + wr * 64 + fr, col0 = u.pn * BM + wc * 32 + 8 * fq;
#pragma unroll
        for (int ai = 0; ai < 2; ++ai)
#pragma unroll
            for (int m = 0; m < 4; ++m) { bf16_t* rowp = O + (size_t)(row0 + ai * HALF + m * 16) * ldc + col0;
#pragma unroll
                for (int bj = 0; bj < 2; ++bj) { f32x4 v0 = acc[ai][bj][m][0], v1 = acc[ai][bj][m][1];
                    if (ACT == 2) {
#pragma unroll
                        for (int e = 0; e < 4; ++e) { const float a = fmaxf(v0[e], 0.f), b = fmaxf(v1[e], 0.f); v0[e] = a * a; v1[e] = b * b; } }
                    u32x4 w; w.x = cvt_pk_bf16(v0[0], v0[1]); w.y = cvt_pk_bf16(v0[2], v0[3]); w.z = cvt_pk_bf16(v1[0], v1[1]); w.w = cvt_pk_bf16(v1[2], v1[3]);
                    *(__attribute__((address_space(1))) u32x4*)(rowp + bj * HALF) = w; } }
    }
};
struct EpiUQ {
    static constexpr bool PERM = true, AFTER_DRAIN = false;
    bf16_t* Q; const float* rstd; const float* tab; float qscale;
    __device__ __forceinline__ void operator()(const f32x4 (&acc)[2][2][4][2], const Unit& u, int wr, int wc, int fr, int fq) const {
        const int row0 = u.pm * BM + wr * 64 + fr, col0 = u.pn * BM + wc * 32 + 8 * fq;
#pragma unroll
        for (int ai = 0; ai < 2; ++ai)
#pragma unroll
            for (int m = 0; m < 4; ++m) { const int row = row0 + ai * HALF + m * 16; const float rs = rstd[row] * qscale;
                const bool latent = row < 16384; const int t = row & 4095, prow = t >> 6, pcol = t & 63;
#pragma unroll
                for (int bj = 0; bj < 2; ++bj) { const int col = col0 + bj * HALF; if (col >= 384) continue;
                    f32x4 v0 = acc[ai][bj][m][0] * rs, v1 = acc[ai][bj][m][1] * rs;
                    const int d0 = col % 96;
                    if (d0 >= 64 && latent) { const int j0 = d0 - 64, part = j0 >> 4, i0 = (j0 & 15) >> 1; const int pos = part ? pcol : prow;
                        const float* cs = tab + (pos * 8 + i0) * 2;
                        float x1, x2, c, s;
                        x1 = v0[0]; x2 = v0[1]; c = cs[0]; s = cs[1]; v0[0] = x1 * c - x2 * s; v0[1] = x1 * s + x2 * c;
                        x1 = v0[2]; x2 = v0[3]; c = cs[2]; s = cs[3]; v0[2] = x1 * c - x2 * s; v0[3] = x1 * s + x2 * c;
                        x1 = v1[0]; x2 = v1[1]; c = cs[4]; s = cs[5]; v1[0] = x1 * c - x2 * s; v1[1] = x1 * s + x2 * c;
                        x1 = v1[2]; x2 = v1[3]; c = cs[6]; s = cs[7]; v1[2] = x1 * c - x2 * s; v1[3] = x1 * s + x2 * c; }
                    u32x4 w; w.x = cvt_pk_bf16(v0[0], v0[1]); w.y = cvt_pk_bf16(v0[2], v0[3]); w.z = cvt_pk_bf16(v1[0], v1[1]); w.w = cvt_pk_bf16(v1[2], v1[3]);
                    *(__attribute__((address_space(1))) u32x4*)(Q + (size_t)row * 384 + col) = w; } }
    }
};
struct EpiUKV {
    static constexpr bool PERM = true, AFTER_DRAIN = false;
    bf16_t* KM; bf16_t* VT; const float* rstd;
    __device__ __forceinline__ void operator()(const f32x4 (&acc)[2][2][4][2], const Unit& u, int wr, int wc, int fr, int fq) const {
        const int row0 = u.pm * BM + wr * 64 + fr, col0 = u.pn * BM + wc * 32 + 8 * fq;
#pragma unroll
        for (int ai = 0; ai < 2; ++ai)
#pragma unroll
            for (int m = 0; m < 4; ++m) { const int row = row0 + ai * HALF + m * 16; const float rs = rstd[row];
                int b, kk; if (row < 16384) { b = row >> 12; kk = row & 4095; } else { const int r2 = row - 16384; b = r2 >> 8; kk = 4096 + (r2 & 255); }
#pragma unroll
                for (int bj = 0; bj < 2; ++bj) { const int col = col0 + bj * HALF; const int head = col >> 7, d = col & 127;
                    const f32x4 v0 = acc[ai][bj][m][0] * rs, v1 = acc[ai][bj][m][1] * rs;
                    u32x4 w; w.x = cvt_pk_bf16(v0[0], v0[1]); w.y = cvt_pk_bf16(v0[2], v0[3]); w.z = cvt_pk_bf16(v1[0], v1[1]); w.w = cvt_pk_bf16(v1[2], v1[3]);
                    if (d < 64) { *(__attribute__((address_space(1))) u32x4*)(KM + ((size_t)((b * 4 + head) * 4352 + kk)) * 96 + d) = w; }
                    else { __attribute__((address_space(1))) bf16_t* vp = (__attribute__((address_space(1))) bf16_t*)(VT + ((size_t)((b * 4 + head) * 64 + (d - 64))) * 4352 + kk);
                        vp[0 * 4352] = (bf16_t)(w.x & 0xffffu); vp[1 * 4352] = (bf16_t)(w.x >> 16); vp[2 * 4352] = (bf16_t)(w.y & 0xffffu); vp[3 * 4352] = (bf16_t)(w.y >> 16);
                        vp[4 * 4352] = (bf16_t)(w.z & 0xffffu); vp[5 * 4352] = (bf16_t)(w.z >> 16); vp[6 * 4352] = (bf16_t)(w.w & 0xffffu); vp[7 * 4352] = (bf16_t)(w.w >> 16); } } }
    }
};
template <class Epi, class Sched, bool ALIGN_EPI = false, bool SP2 = false>
__device__ __forceinline__ void gemm_phase(PG8_LAS unsigned char* lds, const Gemm g, const Sched& S, const Epi& E) {
    int tid_ = threadIdx.x; asm volatile("" : "+v"(tid_));
    const int tid = tid_, wid = __builtin_amdgcn_readfirstlane(tid >> 6), lane = tid & 63, wr = wid >> 2, wc = wid & 3, fr = lane & 15, fq = lane >> 4;
    const int K = g.K, nt = K / BK;
    unsigned voffA, voffB;
    { int R, C; stage_rc(tid * 16, R, C); const int Rb = Epi::PERM ? ((R & ~31) + perm32(R & 31)) : R;
        voffA = (unsigned)(R * g.lda + C) * 2u; voffB = (unsigned)(Rb * g.ldb + C) * 2u; }
    const size_t pstepA = (size_t)64 * g.lda * 2, pstepB = (size_t)64 * g.ldb * 2;
    const size_t kstep = (size_t)(BK * 2);
    const size_t hstep = (size_t)HALF * g.ldb * 2;
    const size_t tstep = 2 * hstep; const size_t hstepA = (size_t)HALF * g.lda * 2, tstepA = 2 * hstepA;
    const unsigned ldsw = (unsigned)wid * 1024u;
    const int aoff = lds_byte(wr * 64 + fr, fq * 8), boff = lds_byte(wc * 32 + fr, fq * 8);
#define PG8_SA(b, h) (((b) * 2 + (h)) * HTB)
#define PG8_SB(b, h) ((4 + (b) * 2 + (h)) * HTB)
#define PG8_STAGE(bufoff, gbase, voff) do { _Pragma("unroll") for (int _i = 0; _i < 2; ++_i) \
        __builtin_amdgcn_global_load_lds((const unsigned*)((const char*)(gbase) + (size_t)_i * PG8_PSTEP_##voff + (voff)), (PG8_LAS unsigned*)(lds + (bufoff) + ldsw + _i * 8192), 16, 0, 0); } while (0)
#define PG8_PSTEP_voffA pstepA
#define PG8_PSTEP_voffB pstepB
#define PG8_LDA(dst, b, h) do { _Pragma("unroll") for (int m = 0; m < 4; ++m) _Pragma("unroll") for (int k = 0; k < 2; ++k) dst[m][k] = *(const PG8_LAS bf16x8*)(lds + PG8_SA(b, h) + aoff + m * 2048 + k * 1024); } while (0)
#define PG8_LDB(dst, b, h) do { _Pragma("unroll") for (int n = 0; n < 2; ++n) _Pragma("unroll") for (int k = 0; k < 2; ++k) dst[n][k] = *(const PG8_LAS bf16x8*)(lds + PG8_SB(b, h) + boff + n * 2048 + k * 1024); } while (0)
#define PG8_MMA(ai, bj, At, Bt) do { __builtin_amdgcn_s_setprio(1); _Pragma("unroll") for (int m = 0; m < 4; ++m) _Pragma("unroll") for (int n = 0; n < 2; ++n) _Pragma("unroll") for (int k = 0; k < 2; ++k) \
        acc[ai][bj][m][n] = __builtin_amdgcn_mfma_f32_16x16x32_bf16(Bt[n][k], At[m][k], acc[ai][bj][m][n], 0, 0, 0); __builtin_amdgcn_s_setprio(0); } while (0)
#define PG8_WAIT_V(n) asm volatile("s_waitcnt vmcnt(" #n ")" ::: "memory")
#define PG8_WAIT_L(n) asm volatile("s_waitcnt lgkmcnt(" #n ")" ::: "memory")
#define PG8_BAR __builtin_amdgcn_s_barrier()
#define PG8_SCHED __builtin_amdgcn_sched_barrier(0)
    Unit cur, nxt; int ui = 0;
    if (!S.next(0, cur)) return;
    f32x4 acc[2][2][4][2];
#pragma unroll
    for (int a = 0; a < 2; ++a)
#pragma unroll
        for (int b = 0; b < 2; ++b)
#pragma unroll
            for (int m = 0; m < 4; ++m)
#pragma unroll
                for (int n = 0; n < 2; ++n) acc[a][b][m][n] = (f32x4){0.f, 0.f, 0.f, 0.f};
    bf16x8 At[4][2], B0[2][2], B1[2][2];
    const char* cA = (const char*)g.A + (size_t)cur.pm * tstepA; const char* cB = (const char*)g.Bt + (size_t)cur.pn * tstep;
    S.a_ready(cur);
    if constexpr (SP2) {
        PG8_STAGE(PG8_SB(0, 0), cB, voffB); PG8_STAGE(PG8_SB(0, 1), cB + hstep, voffB); PG8_STAGE(PG8_SA(0, 0), cA, voffA); PG8_STAGE(PG8_SA(0, 1), cA + hstepA, voffA);
        if (wr == 1) PG8_BAR;
        PG8_WAIT_V(2); PG8_BAR;
        PG8_STAGE(PG8_SB(1, 0), cB + kstep, voffB); PG8_STAGE(PG8_SA(1, 0), cA + kstep, voffA); PG8_STAGE(PG8_SB(1, 1), cB + hstep + kstep, voffB);
        PG8_WAIT_V(6); PG8_BAR;
    } else {
        PG8_STAGE(PG8_SB(0, 0), cB, voffB); PG8_STAGE(PG8_SA(0, 0), cA, voffA); PG8_STAGE(PG8_SB(0, 1), cB + hstep, voffB); PG8_STAGE(PG8_SA(0, 1), cA + hstepA, voffA);
        if (wr == 1) PG8_BAR;
        PG8_WAIT_V(4); PG8_BAR;
        PG8_STAGE(PG8_SB(1, 0), cB + kstep, voffB); PG8_STAGE(PG8_SA(1, 0), cA + kstep, voffA); PG8_STAGE(PG8_SB(1, 1), cB + hstep + kstep, voffB);
        PG8_WAIT_V(6); PG8_BAR;
    }
    for (;;) {
        const bool has_next = S.next(ui + 1, nxt);
        const char* nA = has_next ? (const char*)g.A + (size_t)nxt.pm * tstepA : cA; const char* nB = has_next ? (const char*)g.Bt + (size_t)nxt.pn * tstep : cB;
        for (int t = 0; t < nt; t += 2) {
            const bool last = (t == nt - 2);
            const char* a1 = cA + (size_t)(t + 1) * kstep;
            const char* a2 = last ? nA : cA + (size_t)(t + 2) * kstep; const char* b2 = last ? nB : cB + (size_t)(t + 2) * kstep;
            const char* a3 = a2 + kstep; const char* b3 = b2 + kstep;
            if (last && has_next) S.a_ready(nxt);
            if constexpr (SP2) {
            PG8_LDB(B0, 0, 0); PG8_LDB(B1, 0, 1); PG8_SCHED; PG8_LDA(At, 0, 0); PG8_STAGE(PG8_SA(1, 1), a1 + hstepA, voffA);
            PG8_WAIT_V(8); PG8_WAIT_L(0); PG8_BAR; PG8_MMA(0, 0, At, B0); PG8_MMA(0, 1, At, B1); PG8_BAR; PG8_SCHED;
            PG8_LDA(At, 0, 1); PG8_STAGE(PG8_SB(0, 0), b2, voffB); PG8_STAGE(PG8_SB(0, 1), b2 + hstep, voffB); PG8_STAGE(PG8_SA(0, 0), a2, voffA);
            PG8_WAIT_V(8); PG8_WAIT_L(0); PG8_BAR; PG8_MMA(1, 0, At, B0); PG8_MMA(1, 1, At, B1); PG8_BAR; PG8_SCHED;
            PG8_LDB(B0, 1, 0); PG8_LDB(B1, 1, 1); PG8_SCHED; PG8_LDA(At, 1, 0); PG8_STAGE(PG8_SA(0, 1), a2 + hstepA, voffA);
            PG8_WAIT_V(8); PG8_WAIT_L(0); PG8_BAR; PG8_MMA(0, 0, At, B0); PG8_MMA(0, 1, At, B1); PG8_BAR; PG8_SCHED;
            PG8_LDA(At, 1, 1); PG8_STAGE(PG8_SB(1, 0), b3, voffB); PG8_STAGE(PG8_SB(1, 1), b3 + hstep, voffB); PG8_STAGE(PG8_SA(1, 0), a3, voffA);
            PG8_WAIT_V(8); PG8_WAIT_L(0); PG8_BAR; PG8_MMA(1, 0, At, B0); PG8_MMA(1, 1, At, B1); PG8_BAR; PG8_SCHED;
            } else {
            PG8_LDB(B0, 0, 0); PG8_SCHED; PG8_LDA(At, 0, 0); PG8_STAGE(PG8_SA(1, 1), a1 + hstepA, voffA);
            PG8_WAIT_L(8); PG8_BAR; PG8_WAIT_L(0); PG8_MMA(0, 0, At, B0); PG8_BAR; PG8_SCHED;
            PG8_LDB(B1, 0, 1); PG8_STAGE(PG8_SB(0, 0), b2, voffB);
            PG8_BAR; PG8_WAIT_L(0); PG8_MMA(0, 1, At, B1); PG8_BAR;
            PG8_LDA(At, 0, 1); PG8_STAGE(PG8_SA(0, 0), a2, voffA);
            PG8_BAR; PG8_WAIT_L(0); PG8_MMA(1, 0, At, B0); PG8_BAR; PG8_SCHED;
            PG8_STAGE(PG8_SB(0, 1), b2 + hstep, voffB);
            PG8_WAIT_V(6); PG8_BAR; PG8_MMA(1, 1, At, B1); PG8_BAR;
            PG8_LDB(B0, 1, 0); PG8_SCHED; PG8_LDA(At, 1, 0); PG8_STAGE(PG8_SA(0, 1), a2 + hstepA, voffA);
            PG8_WAIT_L(8); PG8_BAR; PG8_WAIT_L(0); PG8_MMA(0, 0, At, B0); PG8_BAR; PG8_SCHED;
            PG8_LDB(B1, 1, 1); PG8_STAGE(PG8_SB(1, 0), b3, voffB);
            PG8_BAR; PG8_WAIT_L(0); PG8_MMA(0, 1, At, B1); PG8_BAR;
            PG8_LDA(At, 1, 1); PG8_STAGE(PG8_SA(1, 0), a3, voffA);
            PG8_BAR; PG8_WAIT_L(0); PG8_MMA(1, 0, At, B0); PG8_BAR; PG8_SCHED;
            PG8_STAGE(PG8_SB(1, 1), b3 + hstep, voffB);
            PG8_WAIT_V(6); PG8_BAR; PG8_MMA(1, 1, At, B1); PG8_BAR;
            }
        }
        if constexpr (ALIGN_EPI) { if (wr == 0) PG8_BAR; }
        if constexpr (!Epi::AFTER_DRAIN) { E(acc, cur, wr, wc, fr, fq); S.done(cur); }
        if (!has_next) break;
#pragma unroll
        for (int a = 0; a < 2; ++a)
#pragma unroll
            for (int b = 0; b < 2; ++b)
#pragma unroll
                for (int m = 0; m < 4; ++m)
#pragma unroll
                    for (int n = 0; n < 2; ++n) acc[a][b][m][n] = (f32x4){0.f, 0.f, 0.f, 0.f};
        cur = nxt; cA = nA; cB = nB; ++ui;
        if constexpr (ALIGN_EPI) { if (wr == 1) PG8_BAR; }
    }
    PG8_WAIT_V(0);
    if constexpr (!ALIGN_EPI) { if (wr == 0) PG8_BAR; }
    PG8_BAR;
    if constexpr (Epi::AFTER_DRAIN) { E.fused(acc, cur, wr, wc, fr, fq, lds, wid, lane); S.done(cur); }
#undef PG8_SA
#undef PG8_SB
#undef PG8_STAGE
#undef PG8_LDA
#undef PG8_LDB
#undef PG8_MMA
#undef PG8_WAIT_V
#undef PG8_WAIT_L
#undef PG8_BAR
#undef PG8_SCHED
}
}

__device__ const float ROPE_TAB[1024] = {
1.000000000e+00f,0.000000000e+00f,1.000000000e+00f,0.000000000e+00f,1.000000000e+00f,0.000000000e+00f,1.000000000e+00f,0.000000000e+00f,
1.000000000e+00f,0.000000000e+00f,1.000000000e+00f,0.000000000e+00f,1.000000000e+00f,0.000000000e+00f,1.000000000e+00f,0.000000000e+00f,
5.403022766e-01f,8.414709568e-01f,9.504152536e-01f,3.109835982e-01f,9.950041771e-01f,9.983342141e-02f,9.995000362e-01f,3.161750361e-02f,
9.999499917e-01f,9.999833070e-03f,9.999949932e-01f,3.162272274e-03f,9.999995232e-01f,9.999999311e-04f,9.999999404e-01f,3.162277571e-04f,
-4.161468446e-01f,9.092974067e-01f,8.065783978e-01f,5.911270976e-01f,9.800665975e-01f,1.986693293e-01f,9.980006814e-01f,6.320339441e-02f,
9.998000264e-01f,1.999866590e-02f,9.999799728e-01f,6.324512884e-03f,9.999979734e-01f,1.999998698e-03f,9.999998212e-01f,6.324554561e-04f,
-9.899924994e-01f,1.411200017e-01f,5.827536583e-01f,8.126488924e-01f,9.553365111e-01f,2.955202162e-01f,9.955033660e-01f,9.472608566e-02f,
9.995500445e-01f,2.999549918e-02f,9.999549985e-01f,9.486690164e-03f,9.999955297e-01f,2.999995602e-03f,9.999995232e-01f,9.486831259e-04f,
-6.536436081e-01f,-7.568024993e-01f,3.011374772e-01f,9.535807371e-01f,9.210609794e-01f,3.894183338e-01f,9.920106530e-01f,1.261540651e-01f,
9.992001057e-01f,3.998933360e-02f,9.999200106e-01f,1.264877338e-02f,9.999920130e-01f,3.999989480e-03f,9.999992251e-01f,1.264910679e-03f,
2.836622000e-01f,-9.589242935e-01f,-1.034233812e-02f,9.999465346e-01f,8.775825500e-01f,4.794255495e-01f,9.875259995e-01f,1.574558765e-01f,
9.987502694e-01f,4.997916520e-02f,9.998750091e-01f,1.581072807e-02f,9.999874830e-01f,4.999979399e-03f,9.999987483e-01f,1.581138116e-03f,
9.601702690e-01f,-2.794154882e-01f,-3.207964003e-01f,9.471482038e-01f,8.253356218e-01f,5.646424890e-01f,9.820539355e-01f,1.886002719e-01f,
9.982005358e-01f,5.996400490e-02f,9.998199940e-01f,1.897252724e-02f,9.999819994e-01f,5.999964196e-03f,9.999982119e-01f,1.897365320e-03f,
7.539022565e-01f,6.569865942e-01f,-5.994374752e-01f,8.004215956e-01f,7.648422122e-01f,6.442176700e-01f,9.755998850e-01f,2.195560932e-01f,
9.975510240e-01f,6.994284689e-02f,9.997550249e-01f,2.213413455e-02f,9.999755025e-01f,6.999942940e-03f,9.999975562e-01f,2.213592408e-03f,
-1.455000341e-01f,9.893582463e-01f,-8.186324239e-01f,5.743177533e-01f,6.967067122e-01f,7.173560858e-01f,9.681702852e-01f,2.502923310e-01f,
9.968017340e-01f,7.991468906e-02f,9.996800423e-01f,2.529552206e-02f,9.999679923e-01f,7.999914698e-03f,9.999967813e-01f,2.529819263e-03f,
-9.111302495e-01f,4.121184945e-01f,-9.566441774e-01f,2.912592292e-01f,6.216099262e-01f,7.833269238e-01f,9.597726464e-01f,2.807783186e-01f,
9.959527254e-01f,8.987854421e-02f,9.995950460e-01f,2.845665626e-02f,9.999595284e-01f,8.999879472e-03f,9.999959469e-01f,2.846045885e-03f,
-8.390715122e-01f,-5.440211296e-01f,-9.997860789e-01f,-2.068356983e-02f,5.403022766e-01f,8.414709568e-01f,9.504153132e-01f,3.109835684e-01f,
9.950041771e-01f,9.983341396e-02f,9.995000362e-01f,3.161750361e-02f,9.999499917e-01f,9.999834001e-03f,9.999949932e-01f,3.162272274e-03f,
4.425697960e-03f,-9.999902248e-01f,-9.437797666e-01f,-3.305749595e-01f,4.535960853e-01f,8.912073970e-01f,9.401075840e-01f,3.408778608e-01f,
9.939560890e-01f,1.097782999e-01f,9.993950725e-01f,3.477803990e-02f,9.999395013e-01f,1.099977922e-02f,9.999939203e-01f,3.478498431e-03f,
8.438539505e-01f,-5.365729332e-01f,-7.941793799e-01f,-6.076834202e-01f,3.623577058e-01f,9.320390821e-01f,9.288598895e-01f,3.704313040e-01f,
9.928086400e-01f,1.197122037e-01f,9.992800951e-01f,3.793822229e-02f,9.999279976e-01f,1.199971233e-02f,9.999927878e-01f,3.794723889e-03f,
9.074468017e-01f,4.201670289e-01f,-5.658205152e-01f,-8.245284557e-01f,2.674987614e-01f,9.635581970e-01f,9.166833758e-01f,3.996143043e-01f,
9.915618896e-01f,1.296341419e-01f,9.991551042e-01f,4.109803215e-02f,9.999154806e-01f,1.299963426e-02f,9.999915361e-01f,4.110949114e-03f,
1.367372125e-01f,9.906073809e-01f,-2.813494802e-01f,-9.596053958e-01f,1.699671596e-01f,9.854497313e-01f,9.035902619e-01f,4.283977747e-01f,
9.902160168e-01f,1.395431161e-01f,9.990201592e-01f,4.425742477e-02f,9.999020100e-01f,1.399954315e-02f,9.999902248e-01f,4.427174106e-03f,
-7.596879005e-01f,6.502878666e-01f,3.102235124e-02f,-9.995186925e-01f,7.073719800e-02f,9.974949956e-01f,8.895936012e-01f,4.567528665e-01f,
9.887710810e-01f,1.494381279e-01f,9.988752007e-01f,4.741638154e-02f,9.998875260e-01f,1.499943808e-02f,9.999887347e-01f,4.743398633e-03f,
-9.576594830e-01f,-2.879033089e-01f,3.403181732e-01f,-9.403103590e-01f,-2.919954620e-02f,9.995735884e-01f,8.747074604e-01f,4.846512377e-01f,
9.872272611e-01f,1.593182087e-01f,9.987202883e-01f,5.057485774e-02f,9.998720288e-01f,1.599931903e-02f,9.999871850e-01f,5.059622694e-03f,
-2.751633525e-01f,-9.613974690e-01f,6.158648133e-01f,-7.878518701e-01f,-1.288445443e-01f,9.916648269e-01f,8.589466810e-01f,5.120649934e-01f,
9.855847955e-01f,1.691823453e-01f,9.985553622e-01f,5.373282731e-02f,9.998555183e-01f,1.699918136e-02f,9.999855757e-01f,5.375845823e-03f,
6.603167057e-01f,-7.509872317e-01f,8.303361535e-01f,-5.572628975e-01f,-2.272021621e-01f,9.738476276e-01f,8.423270583e-01f,5.389667153e-01f,
9.838436842e-01f,1.790295690e-01f,9.983804226e-01f,5.689026415e-02f,9.998379946e-01f,1.799902879e-02f,9.999837875e-01f,5.692068953e-03f,
9.887046218e-01f,1.498772055e-01f,9.624637961e-01f,-2.714101076e-01f,-3.232895434e-01f,9.463000894e-01f,8.248651624e-01f,5.653295517e-01f,
9.820042253e-01f,1.888588965e-01f,9.981955290e-01f,6.004713103e-02f,9.998195171e-01f,1.899885759e-02f,9.999819398e-01f,6.008291151e-03f,
4.080820680e-01f,9.129452705e-01f,9.991443753e-01f,4.135828838e-02f,-4.161468446e-01f,9.092974067e-01f,8.065784574e-01f,5.911270380e-01f,
9.800665975e-01f,1.986693144e-01f,9.980006814e-01f,6.320339441e-02f,9.998000264e-01f,1.999866776e-02f,9.999799728e-01f,6.324512884e-03f,
-5.477292538e-01f,8.366556168e-01f,9.367404580e-01f,3.500247598e-01f,-5.048462152e-01f,8.632093072e-01f,7.874851823e-01f,6.163335443e-01f,
9.780309200e-01f,2.084598988e-01f,9.977958202e-01f,6.635902822e-02f,9.997795224e-01f,2.099845745e-02f,9.999779463e-01f,6.640734151e-03f,
-9.999608397e-01f,-8.851309307e-03f,7.814403772e-01f,6.239799261e-01f,-5.885011554e-01f,8.084963560e-01f,7.676045895e-01f,6.409237385e-01f,
9.758974314e-01f,2.182296216e-01f,9.975810051e-01f,6.951400638e-02f,9.997580051e-01f,2.199822664e-02f,9.999758005e-01f,6.956954487e-03f,
-5.328330398e-01f,-8.462204337e-01f,5.486452579e-01f,8.360552788e-01f,-6.662759781e-01f,7.457052469e-01f,7.469564080e-01f,6.648730636e-01f,
9.736663699e-01f,2.279775143e-01f,9.973561764e-01f,7.266827673e-02f,9.997355342e-01f,2.299797349e-02f,9.999735355e-01f,7.273174357e-03f,
4.241790175e-01f,-9.055783749e-01f,2.614416778e-01f,9.652192593e-01f,-7.373937964e-01f,6.754631400e-01f,7.255613208e-01f,6.881574988e-01f,
9.713379741e-01f,2.377026230e-01f,9.971213937e-01f,7.582182437e-02f,9.997119904e-01f,2.399769612e-02f,9.999712110e-01f,7.589393295e-03f,
9.912028313e-01f,-1.323517561e-01f,-5.168933049e-02f,9.986631870e-01f,-8.011435866e-01f,5.984721184e-01f,7.034407258e-01f,7.107539177e-01f,
9.689124227e-01f,2.474039644e-01f,9.968766570e-01f,7.897461206e-02f,9.996874928e-01f,2.499739639e-02f,9.999687672e-01f,7.905611768e-03f,
6.469193101e-01f,7.625584602e-01f,-3.596943319e-01f,9.330701828e-01f,-8.568888307e-01f,5.155012608e-01f,6.806167960e-01f,7.326396108e-01f,
9.663899541e-01f,2.570805550e-01f,9.966219068e-01f,8.212661743e-02f,9.996620417e-01f,2.599707060e-02f,9.999662042e-01f,8.221829310e-03f,
-2.921388149e-01f,9.563759565e-01f,-6.320286393e-01f,7.749450207e-01f,-9.040721655e-01f,4.273798466e-01f,6.571123004e-01f,7.537927032e-01f,
9.637709260e-01f,2.667314112e-01f,9.963572025e-01f,8.527779579e-02f,9.996355176e-01f,2.699672058e-02f,9.999635220e-01f,8.538045920e-03f,
-9.626058936e-01f,2.709057927e-01f,-8.416849375e-01f,5.399689674e-01f,-9.422222972e-01f,3.349882066e-01f,6.329506636e-01f,7.741920948e-01f,
9.610554576e-01f,2.763556540e-01f,9.960825443e-01f,8.842811733e-02f,9.996080399e-01f,2.799634263e-02f,9.999607801e-01f,8.854261599e-03f,
-7.480575442e-01f,-6.636338830e-01f,-9.678714871e-01f,2.514453232e-01f,-9.709581733e-01f,2.392492294e-01f,6.081562042e-01f,7.938174009e-01f,
9.582439065e-01f,2.859522104e-01f,9.957979321e-01f,9.157756716e-02f,9.995795488e-01f,2.899593674e-02f,9.999579787e-01f,9.170476347e-03f,
1.542514563e-01f,-9.880316257e-01f,-9.980752468e-01f,-6.201484054e-02f,-9.899924994e-01f,1.411200017e-01f,5.827536583e-01f,8.126488924e-01f,
9.553365111e-01f,2.955201864e-01f,9.955033660e-01f,9.472609311e-02f,9.995500445e-01f,2.999550104e-02f,9.999549985e-01f,9.486690164e-03f,
9.147423506e-01f,-4.040376544e-01f,-9.293003082e-01f,-3.693250120e-01f,-9.991351366e-01f,4.158052057e-02f,5.567683578e-01f,8.306677938e-01f,
9.523335695e-01f,3.050586283e-01f,9.951988459e-01f,9.787366539e-02f,9.995195270e-01f,3.099503554e-02f,9.999519587e-01f,9.802903049e-03f,
8.342233896e-01f,5.514267087e-01f,-7.683671117e-01f,-6.400094032e-01f,-9.982947707e-01f,-5.837419257e-02f,5.302263498e-01f,8.478561044e-01f,
9.492354393e-01f,3.145665526e-01f,9.948843718e-01f,1.010202691e-01f,9.994880557e-01f,3.199454024e-02f,9.999487996e-01f,1.011911593e-02f,
-1.327674743e-02f,9.999118447e-01f,-5.312352777e-01f,-8.472243547e-01f,-9.874798059e-01f,-1.577456445e-01f,5.031541586e-01f,8.641966581e-01f,
9.460423589e-01f,3.240430057e-01f,9.945599437e-01f,1.041658595e-01f,9.994555712e-01f,3.299400955e-02f,9.999455214e-01f,1.043532696e-02f,
-8.485702872e-01f,5.290827155e-01f,-2.414211184e-01f,-9.704204202e-01f,-9.667981863e-01f,-2.555412054e-01f,4.755789042e-01f,8.796730638e-01f,
9.427546859e-01f,3.334870934e-01f,9.942255616e-01f,1.073104069e-01f,9.994220734e-01f,3.399345279e-02f,9.999421835e-01f,1.075153705e-02f,
-9.036921859e-01f,-4.281826615e-01f,7.233466953e-02f,-9.973804355e-01f,-9.364566803e-01f,-3.507832289e-01f,4.475280643e-01f,8.942698836e-01f,
9.393727183e-01f,3.428978026e-01f,9.938812256e-01f,1.104538813e-01f,9.993875623e-01f,3.499285504e-02f,9.999387264e-01f,1.106774528e-02f,
-1.279636919e-01f,-9.917788506e-01f,3.789161742e-01f,-9.254310131e-01f,-8.967583776e-01f,-4.425205588e-01f,4.190297425e-01f,9.079725146e-01f,
9.358968139e-01f,3.522742093e-01f,9.935269952e-01f,1.135962531e-01f,9.993520975e-01f,3.599222749e-02f,9.999352098e-01f,1.138395350e-02f,
7.654140592e-01f,-6.435381174e-01f,6.479216814e-01f,-7.617069483e-01f,-8.481000066e-01f,-5.298361778e-01f,3.901124299e-01f,9.207672477e-01f,
9.323273301e-01f,3.616154492e-01f,9.931628108e-01f,1.167374924e-01f,9.993155599e-01f,3.699155897e-02f,9.999315739e-01f,1.170015987e-02f,
9.550736547e-01f,2.963685691e-01f,8.526731133e-01f,-5.224447846e-01f,-7.909677625e-01f,-6.118578315e-01f,3.608050346e-01f,9.326412678e-01f,
9.286646247e-01f,3.709204793e-01f,9.927886724e-01f,1.198775545e-01f,9.992780685e-01f,3.799085692e-02f,9.999278188e-01f,1.201636530e-02f,
2.666429281e-01f,9.637953639e-01f,9.728653431e-01f,-2.313720137e-01f,-7.259322405e-01f,-6.877662539e-01f,3.311368525e-01f,9.435827136e-01f,
9.249090552e-01f,3.801884055e-01f,9.924046397e-01f,1.230164245e-01f,9.992396235e-01f,3.899011388e-02f,9.999239445e-01f,1.233256981e-02f,
-6.669380665e-01f,7.451131344e-01f,9.965789914e-01f,8.264580369e-02f,-6.536436081e-01f,-7.568024993e-01f,3.011375964e-01f,9.535806775e-01f,
9.210609794e-01f,3.894183338e-01f,9.920106530e-01f,1.261540651e-01f,9.992001057e-01f,3.998933733e-02f,9.999200106e-01f,1.264877338e-02f,
-9.873392582e-01f,-1.586226672e-01f,9.214623570e-01f,3.884676993e-01f,-5.748240352e-01f,-8.182770610e-01f,2.708370686e-01f,9.626252055e-01f,
9.171208143e-01f,3.986093104e-01f,9.916067719e-01f,1.292904317e-01f,9.991596341e-01f,4.098851606e-02f,9.999159575e-01f,1.296497509e-02f,
-3.999853134e-01f,-9.165215492e-01f,7.549653649e-01f,6.557646990e-01f,-4.902605712e-01f,-8.715758920e-01f,2.402658761e-01f,9.707071185e-01f,
9.130889177e-01f,4.077604413e-01f,9.911929369e-01f,1.324255317e-01f,9.991181493e-01f,4.198765755e-02f,9.999117851e-01f,1.328117587e-02f,
5.551133156e-01f,-8.317747712e-01f,5.135984421e-01f,8.580306768e-01f,-4.007990062e-01f,-9.161660075e-01f,2.094544172e-01f,9.778184295e-01f,
9.089657664e-01f,4.168707728e-01f,9.907692075e-01f,1.355592906e-01f,9.990756512e-01f,4.298675060e-02f,9.999075532e-01f,1.359737478e-02f,
9.998432994e-01f,1.770192571e-02f,2.212981731e-01f,9.752061963e-01f,-3.073327839e-01f,-9.516021013e-01f,1.784335226e-01f,9.839519858e-01f,
9.047516584e-01f,4.259394705e-01f,9.903355837e-01f,1.386916935e-01f,9.990321398e-01f,4.398580641e-02f,9.999032021e-01f,1.391357277e-02f,
5.253219604e-01f,8.509035110e-01f,-9.294810891e-02f,9.956709743e-01f,-2.107958049e-01f,-9.775301218e-01f,1.472342163e-01f,9.891016483e-01f,
9.004471302e-01f,4.349655211e-01f,9.898920655e-01f,1.418227106e-01f,9.989876747e-01f,4.498481750e-02f,9.998987317e-01f,1.422976889e-02f,
-4.321779311e-01f,9.017883539e-01f,-3.979767561e-01f,9.173954725e-01f,-1.121526212e-01f,-9.936909676e-01f,1.158876941e-01f,9.932623506e-01f,
8.960524797e-01f,4.439480901e-01f,9.894386530e-01f,1.449523121e-01f,9.989421964e-01f,4.598378390e-02f,9.998942018e-01f,1.454596408e-02f,
-9.923354983e-01f,1.235731244e-01f,-6.635382771e-01f,7.481423616e-01f,-1.238837745e-02f,-9.999232888e-01f,8.442528546e-02f,9.964298010e-01f,
8.915683031e-01f,4.528862834e-01f,9.889753461e-01f,1.480804533e-01f,9.988957047e-01f,4.698270187e-02f,9.998895526e-01f,1.486215740e-02f,
-6.401443481e-01f,-7.682546377e-01f,-8.632965088e-01f,5.046970844e-01f,8.749917150e-02f,-9.961646199e-01f,5.287845805e-02f,9.986009598e-01f,
8.869948983e-01f,4.617791772e-01f,9.885020852e-01f,1.512071192e-01f,9.988481998e-01f,4.798157141e-02f,9.998847842e-01f,1.517834887e-02f,
3.005925417e-01f,-9.537526369e-01f,-9.774427414e-01f,2.112006545e-01f,1.865124702e-01f,-9.824525714e-01f,2.127875760e-02f,9.997735620e-01f,
8.823328614e-01f,4.706258774e-01f,9.880189896e-01f,1.543322802e-01f,9.987997413e-01f,4.898039624e-02f,9.998799562e-01f,1.549453940e-02f,
9.649659991e-01f,-2.623748481e-01f,-9.946564436e-01f,-1.032404602e-01f,2.836622000e-01f,-9.589242935e-01f,-1.034221891e-02f,9.999465346e-01f,
8.775825500e-01f,4.794255495e-01f,9.875259995e-01f,1.574558914e-01f,9.987502694e-01f,4.997916892e-02f,9.998750091e-01f,1.581072807e-02f,
7.421541810e-01f,6.702291965e-01f,-9.132301211e-01f,-4.074441493e-01f,3.779776692e-01f,-9.258147478e-01f,-4.195285589e-02f,9.991195798e-01f,
8.727445006e-01f,4.881772399e-01f,9.870231748e-01f,1.605779380e-01f,9.986997843e-01f,5.097789690e-02f,9.998699427e-01f,1.612691768e-02f,
-1.629907787e-01f,9.866275787e-01f,-7.412399650e-01f,-6.712401509e-01f,4.685169160e-01f,-8.834545016e-01f,-7.352153957e-02f,9.972936511e-01f,
8.678191900e-01f,4.968801141e-01f,9.865104556e-01f,1.636983752e-01f,9.986482859e-01f,5.197656900e-02f,9.998648167e-01f,1.644310169e-02f,
-9.182828069e-01f,3.959251642e-01f,-4.957418144e-01f,-8.684699535e-01f,5.543745160e-01f,-8.322673440e-01f,-1.050167084e-01f,9.944704771e-01f,
8.628070951e-01f,5.055333376e-01f,9.859878421e-01f,1.668171734e-01f,9.985958338e-01f,5.297519267e-02f,9.998595715e-01f,1.675928757e-02f,
-8.293098211e-01f,-5.587890744e-01f,-2.010796219e-01f,-9.795749187e-01f,6.346929669e-01f,-7.727644444e-01f,-1.364068687e-01f,9.906529188e-01f,
8.577086926e-01f,5.141359568e-01f,9.854553938e-01f,1.699342877e-01f,9.985423684e-01f,5.397376046e-02f,9.998542070e-01f,1.707546785e-02f,
2.212675661e-02f,-9.997551441e-01f,1.135217771e-01f,-9.935355186e-01f,7.086697817e-01f,-7.055402994e-01f,-1.676606387e-01f,9.858447909e-01f,
8.525245190e-01f,5.226872563e-01f,9.849131107e-01f,1.730497181e-01f,9.984878898e-01f,5.497227982e-02f,9.998487830e-01f,1.739165001e-02f,
8.532201052e-01f,-5.215510130e-01f,4.168670774e-01f,-9.089674354e-01f,7.755658031e-01f,-6.312667131e-01f,-1.987468749e-01f,9.800508618e-01f,
8.472551107e-01f,5.311862230e-01f,9.843609333e-01f,1.761634201e-01f,9.984323978e-01f,5.597073585e-02f,9.998431802e-01f,1.770782843e-02f,
8.998668194e-01f,4.361647666e-01f,6.788702011e-01f,-7.342582941e-01f,8.347129226e-01f,-5.506852865e-01f,-2.296342701e-01f,9.732769728e-01f,
8.419010043e-01f,5.396320224e-01f,9.837989211e-01f,1.792753637e-01f,9.983759522e-01f,5.696914345e-02f,9.998375773e-01f,1.802400686e-02f,
1.191801354e-01f,9.928726554e-01f,8.735505342e-01f,-4.867334962e-01f,8.855196238e-01f,-4.646020234e-01f,-2.602920532e-01f,9.655299187e-01f,
8.364626765e-01f,5.480239391e-01f,9.832270741e-01f,1.823855042e-01f,9.983184934e-01f,5.796748772e-02f,9.998317957e-01f,1.834018156e-02f,
-7.710801959e-01f,6.367380023e-01f,9.816020727e-01f,-1.909380108e-01f,9.274784923e-01f,-3.738765717e-01f,-2.906895578e-01f,9.568174481e-01f,
8.309407234e-01f,5.563610196e-01f,9.826454520e-01f,1.854938269e-01f,9.982600212e-01f,5.896577984e-02f,9.998259544e-01f,1.865635626e-02f,
-9.524129629e-01f,-3.048106134e-01f,9.923083186e-01f,1.237909496e-01f,9.601702690e-01f,-2.794154882e-01f,-3.207964003e-01f,9.471482038e-01f,
8.253356218e-01f,5.646424294e-01f,9.820539355e-01f,1.886002868e-01f,9.982005358e-01f,5.996400863e-02f,9.998199940e-01f,1.897252724e-02f,
-2.581016421e-01f,-9.661177993e-01f,9.046075940e-01f,4.262454212e-01f,9.832684398e-01f,-1.821625978e-01f,-3.505824506e-01f,9.365318418e-01f,
8.196480274e-01f,5.728674531e-01f,9.814526439e-01f,1.917048544e-01f,9.981400967e-01f,6.096218154e-02f,9.998139739e-01f,1.928869821e-02f,
6.735071540e-01f,-7.391806841e-01f,7.271980643e-01f,6.864276528e-01f,9.965420961e-01f,-8.308912069e-02f,-3.800179660e-01f,9.249790907e-01f,
8.138784766e-01f,5.810351372e-01f,9.808415174e-01f,1.948075294e-01f,9.980786443e-01f,6.196028739e-02f,9.998078346e-01f,1.960486546e-02f,
9.858965874e-01f,1.673557013e-01f,4.776714444e-01f,8.785385489e-01f,9.998586178e-01f,1.681409031e-02f,-4.090735018e-01f,9.125014544e-01f,
8.080275059e-01f,5.891447663e-01f,9.802205563e-01f,1.979082376e-01f,9.980161786e-01f,6.295833737e-02f,9.998015761e-01f,1.992103085e-02f,
};

#define GAS __attribute__((address_space(1)))
#define LAS __attribute__((address_space(3)))
typedef unsigned short bf16;
template <class T> __device__ __forceinline__ GAS T* gp(T* p) { return (GAS T*)p; }
template <class T> __device__ __forceinline__ const GAS T* gp(const T* p) { return (const GAS T*)p; }
typedef unsigned v4u __attribute__((ext_vector_type(4)));
typedef float f32x4 __attribute__((ext_vector_type(4)));
typedef short bf16x8 __attribute__((ext_vector_type(8)));
typedef GAS unsigned gu32;
typedef GAS unsigned long long gu64;
#define RLX_AGENT __ATOMIC_RELAXED, __HIP_MEMORY_SCOPE_AGENT
#define LDS_WAIT() asm volatile("s_waitcnt lgkmcnt(0)" ::: "memory")
#define VM_WAIT() asm volatile("s_waitcnt vmcnt(0)" ::: "memory")
__device__ __forceinline__ unsigned long long rt() { return __builtin_amdgcn_s_memrealtime(); }
__device__ __forceinline__ unsigned f2bf(float f) { unsigned u = __builtin_bit_cast(unsigned, f); return (u + 0x7fffu + ((u >> 16) & 1u)) >> 16; }
__device__ __forceinline__ unsigned pk2(float lo, float hi) { return f2bf(lo) | (f2bf(hi) << 16); }

#define XB_TMO      128
#define XB_XCNT(j)  (256  + 64 * (j))
#define XB_XSUB(j)  (1280 + 64 * (j))
#define XB_XGEN(j)  (2304 + 64 * (j))
#define XB_TOP      3328
#define XB_TOPGEN   3392
#define XCD_BAR_WORDS 3456
#define XB_SPIN_CAP (1u << 18)

__device__ __forceinline__ unsigned xb_ld(unsigned* p)              { return __hip_atomic_load(p, __ATOMIC_RELAXED, __HIP_MEMORY_SCOPE_AGENT); }
__device__ __forceinline__ unsigned xb_add(unsigned* p, unsigned v) { return __hip_atomic_fetch_add(p, v, __ATOMIC_RELAXED, __HIP_MEMORY_SCOPE_AGENT); }
__device__ __forceinline__ unsigned xb_xcc_id() { return (unsigned)__builtin_amdgcn_s_getreg((3 << 11) | 20) & 0xFu; }
#define XB_SPIN(cond, bar) do { unsigned _sp = 0; while (cond) { __builtin_amdgcn_s_sleep(1); \
    if ((++_sp & 255u) == 0u) { if (xb_ld(&(bar)[XB_TMO])) break; if (_sp > XB_SPIN_CAP) { atomicAdd(&(bar)[XB_TMO], 1u); break; } } } } while (0)

struct XcdBarrier {
    unsigned* bar; unsigned x;
    volatile LAS unsigned* st;
};

__device__ __forceinline__ XcdBarrier xcd_barrier_post(unsigned* bar, volatile LAS unsigned* st) {
    XcdBarrier b; b.bar = bar; b.x = xb_xcc_id(); b.st = st;
    if (threadIdx.x == 0) (void)xb_add(&bar[XB_XCNT(b.x)], 1u);
    return b;
}
__device__ __forceinline__ void xcd_barrier_complete(unsigned* bar, unsigned x, unsigned& nloc, unsigned& nx) {
    const unsigned G = gridDim.x * gridDim.y * gridDim.z;
    unsigned sum, cnt, mine, sp = 0u;
    for (;;) {
        sum = 0u; cnt = 0u; mine = 0u;
#pragma unroll
        for (unsigned j = 0; j < 16; ++j) { const unsigned c = xb_ld(&bar[XB_XCNT(j)]); sum += c; cnt += (c > 0u) ? 1u : 0u; mine = (j == x) ? c : mine; }
        if (sum == G) break;
        __builtin_amdgcn_s_sleep(1);
        if ((++sp & 255u) == 0u) { if (xb_ld(&bar[XB_TMO])) break; if (sp > XB_SPIN_CAP) { atomicAdd(&bar[XB_TMO], 1u); break; } }
    }
    nloc = mine > 0u ? mine : 1u; nx = cnt > 0u ? cnt : 1u;
}

__device__ __forceinline__ void xcd_barrier(const XcdBarrier& b) {
    asm volatile("s_waitcnt vmcnt(0)" ::: "memory");
    __syncthreads();
    if (threadIdx.x == 0) {
        unsigned* bar = b.bar; unsigned bx_ = b.x; asm volatile("" : "+s"(bar));
        __builtin_amdgcn_s_waitcnt(0);
        unsigned nloc = b.st[0], nx = b.st[1];
        if (nloc == 0u) { xcd_barrier_complete(bar, bx_, nloc, nx); b.st[0] = nloc; b.st[1] = nx; }
        const unsigned old = xb_add(&bar[XB_XSUB(bx_)], 1u);
        const unsigned gen = old / nloc;
        if (old + 1u == (gen + 1u) * nloc) {
            __builtin_amdgcn_fence(__ATOMIC_RELEASE, "agent");
            asm volatile("s_waitcnt vmcnt(0)" ::: "memory");
            const unsigned og = xb_add(&bar[XB_TOP], 1u);
            const unsigned tg = og / nx;
            if (og + 1u == (tg + 1u) * nx) xb_add(&bar[XB_TOPGEN], 1u);
            else XB_SPIN(xb_ld(&bar[XB_TOPGEN]) == tg, bar);
            __builtin_amdgcn_fence(__ATOMIC_ACQUIRE, "agent");
            xb_add(&bar[XB_XGEN(bx_)], 1u);
            asm volatile("s_waitcnt vmcnt(0)" ::: "memory");
        } else {
            XB_SPIN(xb_ld(&bar[XB_XGEN(bx_)]) == gen, bar);
            __builtin_amdgcn_fence(__ATOMIC_ACQUIRE, "agent");
            asm volatile("s_waitcnt vmcnt(0)" ::: "memory");
        }
    }
    __syncthreads();
}

constexpr int NLAT = 16384, NCTXR = 1024, MALL = 17408, DM = 1024, PIN = 2464, PINP = 2560, FF = 4096, KEYS = 4352;
constexpr float EPS = 1e-6f, LOG2E = 1.4426950408889634f;
constexpr float QSCALE = 0.10206207261596575f * 1.4426950408889634f;
constexpr float NA_C2 = 0.125f * 1.4426950408889634f;
constexpr int NWAVES = 8;
constexpr size_t MiB = 1u << 20;
constexpr size_t WS_CTL = 0, CTL_ZERO_BYTES = 64 * 1024;
constexpr size_t WS_MOD = 1 * MiB, WS_RSQ = 1 * MiB + 256 * 1024, WS_RSKV = 1 * MiB + 384 * 1024;
constexpr size_t WS_WIN = 2 * MiB, WS_WOUT = 7 * MiB, WS_W1 = 9 * MiB, WS_W2 = 17 * MiB, WS_WUQ = 25 * MiB, WS_WUKV = 25 * MiB + 256 * 1024, WS_WPW = 25 * MiB + 512 * 1024;
constexpr size_t WS_R0C = 26 * MiB, WS_R1 = 30 * MiB, WS_U = 98 * MiB, WS_Y = 183 * MiB, WS_QM = 217 * MiB, WS_A1 = 98 * MiB, WS_KM = 234 * MiB, WS_VTM = WS_KM + (size_t)16 * 4352 * 96 * 2;
constexpr size_t WS_NVT = WS_R1, WS_SCF = WS_R1 + 16 * MiB;
static_assert(WS_VTM + (size_t)16 * 64 * 4352 * 2 <= 256 * MiB, "ws map");
static_assert(WS_QM + (size_t)MALL * 384 * 2 <= WS_KM && WS_A1 + (size_t)MALL * FF * 2 <= WS_KM, "ws map");
constexpr int CW_BAR = 1024;
constexpr int RING_BYTES = 131072, MISC_OFF = RING_BYTES + 320, LDS_BYTES = 147456;

typedef unsigned v2u __attribute__((ext_vector_type(2)));
typedef float f32x16 __attribute__((ext_vector_type(16)));
__device__ __forceinline__ float bflo(unsigned w) { return __builtin_bit_cast(float, w << 16); }
__device__ __forceinline__ float bfhi(unsigned w) { return __builtin_bit_cast(float, w & 0xffff0000u); }
__device__ __forceinline__ float bf1(bf16 h) { return __builtin_bit_cast(float, (unsigned)h << 16); }
__device__ __forceinline__ float wave_sum(float v) {
#pragma unroll
    for (int o = 1; o < 64; o <<= 1) v += __shfl_xor(v, o);
    return v;
}
__device__ __forceinline__ float sigmoidf_(float x) { return 1.0f / (1.0f + __expf(-x)); }

struct Args { const float* in[25]; float* out; unsigned char* ws; int never; int pad; };

struct Frame {
    LAS unsigned char* lds;
    int tid, lane, wave, vcu, G;
    unsigned char* ws;
};
constexpr int PTAB_OFF = 131072 + 1024;
__device__ __forceinline__ const float* fin(const Frame& F, int i) {
    const volatile LAS unsigned* t = (const volatile LAS unsigned*)(F.lds + PTAB_OFF) + 2 * i;
    const unsigned lo = __builtin_amdgcn_readfirstlane(t[0]), hi = __builtin_amdgcn_readfirstlane(t[1]);
    return (const float*)(((unsigned long long)hi << 32) | lo);
}
__device__ __forceinline__ float* fout(const Frame& F) { return (float*)fin(F, 25); }
__device__ __forceinline__ unsigned char* wsl(const Frame& F) { return F.ws; }

struct AttnDesc { const bf16* q; int qpitch; bf16* o; const bf16* k0; const bf16* k1; const bf16* v0; const bf16* v1; int kpitch; int nseg0; int nt; int cq; int offr0; const LAS float* rpb; };
__device__ __forceinline__ int crow(int r, int hi) { return (r & 3) + 8 * (r >> 2) + 4 * hi; }

template <int DQK, int NGRP, int MODE>
__device__ __forceinline__ void attn_unit(LAS unsigned char* lds, const AttnDesc d) {
    constexpr int KP = DQK + 8, VP = 68, KBYTES = 64 * KP * 2, VBYTES = 64 * VP * 2, TG = 512 / NGRP, NKC = 64 * DQK / 8, NKI = (NKC + TG - 1) / TG, NVI = 512 / TG, CPR = DQK / 8, NKS = DQK / 16;
    int tid_ = threadIdx.x; asm volatile("" : "+v"(tid_));
    const int tid = tid_, lane = tid & 63, r32 = lane & 31, hi = lane >> 5;
    const int g = tid / TG, tg = tid % TG;
    LAS unsigned char* Ks = lds + g * (KBYTES + VBYTES); LAS unsigned char* Vs = Ks + KBYTES;
    bf16x8 qf[NKS];
#pragma unroll
    for (int ks = 0; ks < NKS; ++ks) qf[ks] = *(const GAS bf16x8*)(d.q + (size_t)r32 * d.qpitch + ks * 16 + hi * 8);
    f32x16 o0, o1;
#pragma unroll
    for (int r = 0; r < 16; ++r) { o0[r] = 0.f; o1[r] = 0.f; }
    float mrun = -INFINITY, lrun = 0.f;
    v4u kreg[NKI], vreg[NVI];
#define ATT_LOAD(kt_) do { const int kt__ = (kt_); \
        const bf16* kb_ = kt__ < d.nseg0 ? d.k0 + (size_t)kt__ * 64 * d.kpitch : d.k1 + (size_t)(kt__ - d.nseg0) * 64 * d.kpitch; \
        const bf16* vb_ = kt__ < d.nseg0 ? d.v0 + kt__ * 64 : d.v1 + (kt__ - d.nseg0) * 64; \
        _Pragma("unroll") for (int i = 0; i < NKI; ++i) { const int c = tg + i * TG; if ((NKC % TG == 0) || c < NKC) { const int row = c / CPR, cc = c % CPR; kreg[i] = *(const GAS v4u*)(kb_ + (size_t)row * d.kpitch + cc * 8); } } \
        _Pragma("unroll") for (int i = 0; i < NVI; ++i) { const int c = tg + i * TG; const int row = c >> 3, cc = c & 7; vreg[i] = *(const GAS v4u*)(vb_ + (size_t)row * KEYS + cc * 8); } } while (0)
    ATT_LOAD(0);
    for (int kt = 0; kt < d.nt; ++kt) {
        __syncthreads();
#pragma unroll
        for (int i = 0; i < NKI; ++i) { const int c = tg + i * TG; if ((NKC % TG == 0) || c < NKC) { const int row = c / CPR, cc = c % CPR; *(LAS v4u*)(Ks + row * (KP * 2) + cc * 16) = kreg[i]; } }
#pragma unroll
        for (int i = 0; i < NVI; ++i) { const int c = tg + i * TG; const int row = c >> 3, cc = c & 7; LAS v2u* p = (LAS v2u*)(Vs + row * (VP * 2) + cc * 16); p[0] = (v2u){vreg[i].x, vreg[i].y}; p[1] = (v2u){vreg[i].z, vreg[i].w}; }
        __syncthreads();
        if (kt + 1 < d.nt) ATT_LOAD(kt + 1);
        f32x16 s0, s1;
#pragma unroll
        for (int r = 0; r < 16; ++r) { s0[r] = 0.f; s1[r] = 0.f; }
#pragma unroll
        for (int ks = 0; ks < NKS; ++ks) {
            const bf16x8 kf0 = *(const LAS bf16x8*)(Ks + r32 * (KP * 2) + ks * 32 + hi * 16);
            const bf16x8 kf1 = *(const LAS bf16x8*)(Ks + (32 + r32) * (KP * 2) + ks * 32 + hi * 16);
            s0 = __builtin_amdgcn_mfma_f32_32x32x16_bf16(kf0, qf[ks], s0, 0, 0, 0);
            s1 = __builtin_amdgcn_mfma_f32_32x32x16_bf16(kf1, qf[ks], s1, 0, 0, 0);
        }
        if (MODE == 1) {
#pragma unroll
            for (int r = 0; r < 16; ++r) { s0[r] *= NA_C2; s1[r] *= NA_C2; }
        }
        if (MODE == 2) {
            if (kt < 8) {
                const int cqa = d.cq + r32; const int cs = min(max(cqa - 8, 0), 48);
                const LAS float* rp = d.rpb + (d.offr0 + kt) * 31 + (15 - cqa);
#pragma unroll
                for (int r = 0; r < 16; ++r) {
                    const int ck0 = crow(r, hi), ck1 = 32 + ck0;
                    const bool ok0 = (ck0 >= cs) && (ck0 < cs + 16), ok1 = (ck1 >= cs) && (ck1 < cs + 16);
                    const float b0 = ok0 ? rp[ck0] : 0.f, b1 = ok1 ? rp[ck1] : 0.f;
                    s0[r] = ok0 ? s0[r] * NA_C2 + b0 : -INFINITY; s1[r] = ok1 ? s1[r] * NA_C2 + b1 : -INFINITY;
                }
            } else {
#pragma unroll
                for (int r = 0; r < 16; ++r) { s0[r] *= NA_C2; s1[r] *= NA_C2; }
            }
        }
        float mx = fmaxf(s0[0], s1[0]);
#pragma unroll
        for (int r = 1; r < 16; ++r) mx = fmaxf(mx, fmaxf(s0[r], s1[r]));
        mx = fmaxf(mx, __shfl_xor(mx, 32));
        const float mnew = fmaxf(mrun, mx);
        const float alpha = __builtin_amdgcn_exp2f(mrun - mnew);
        mrun = mnew;
        float ps = 0.f;
#pragma unroll
        for (int r = 0; r < 16; ++r) { s0[r] = __builtin_amdgcn_exp2f(s0[r] - mnew); s1[r] = __builtin_amdgcn_exp2f(s1[r] - mnew); ps += s0[r] + s1[r]; }
        lrun = lrun * alpha + ps;
#pragma unroll
        for (int r = 0; r < 16; ++r) { o0[r] *= alpha; o1[r] *= alpha; }
        bf16x8 pf[2][2];
#pragma unroll
        for (int sp = 0; sp < 2; ++sp) {
            v4u w0, w1;
            w0.x = pg8::cvt_pk_bf16(s0[8 * sp + 0], s0[8 * sp + 1]); w0.y = pg8::cvt_pk_bf16(s0[8 * sp + 2], s0[8 * sp + 3]); w0.z = pg8::cvt_pk_bf16(s0[8 * sp + 4], s0[8 * sp + 5]); w0.w = pg8::cvt_pk_bf16(s0[8 * sp + 6], s0[8 * sp + 7]);
            w1.x = pg8::cvt_pk_bf16(s1[8 * sp + 0], s1[8 * sp + 1]); w1.y = pg8::cvt_pk_bf16(s1[8 * sp + 2], s1[8 * sp + 3]); w1.z = pg8::cvt_pk_bf16(s1[8 * sp + 4], s1[8 * sp + 5]); w1.w = pg8::cvt_pk_bf16(s1[8 * sp + 6], s1[8 * sp + 7]);
            pf[0][sp] = __builtin_bit_cast(bf16x8, w0); pf[1][sp] = __builtin_bit_cast(bf16x8, w1);
        }
#pragma unroll
        for (int sub = 0; sub < 2; ++sub)
#pragma unroll
            for (int sp = 0; sp < 2; ++sp) {
                const int koff = (sub * 32 + 16 * sp + 4 * hi) * 2;
                const LAS v2u* pa = (const LAS v2u*)(Vs + r32 * (VP * 2) + koff);
                const LAS v2u* pb = (const LAS v2u*)(Vs + (32 + r32) * (VP * 2) + koff);
                const v2u a0 = pa[0], a1 = pa[2], b0 = pb[0], b1 = pb[2];
                const bf16x8 vf0 = __builtin_bit_cast(bf16x8, (v4u){a0.x, a0.y, a1.x, a1.y});
                const bf16x8 vf1 = __builtin_bit_cast(bf16x8, (v4u){b0.x, b0.y, b1.x, b1.y});
                o0 = __builtin_amdgcn_mfma_f32_32x32x16_bf16(vf0, pf[sub][sp], o0, 0, 0, 0);
                o1 = __builtin_amdgcn_mfma_f32_32x32x16_bf16(vf1, pf[sub][sp], o1, 0, 0, 0);
            }
    }
#undef ATT_LOAD
    const float ltot = lrun + __shfl_xor(lrun, 32);
    const float inv = 1.0f / ltot;
    bf16* orow = d.o + (size_t)r32 * 1024 + 4 * hi;
#pragma unroll
    for (int g4 = 0; g4 < 4; ++g4) {
        v2u w; w.x = pg8::cvt_pk_bf16(o0[4 * g4 + 0] * inv, o0[4 * g4 + 1] * inv); w.y = pg8::cvt_pk_bf16(o0[4 * g4 + 2] * inv, o0[4 * g4 + 3] * inv);
        *(GAS v2u*)(orow + 8 * g4) = w;
        v2u x; x.x = pg8::cvt_pk_bf16(o1[4 * g4 + 0] * inv, o1[4 * g4 + 1] * inv); x.y = pg8::cvt_pk_bf16(o1[4 * g4 + 2] * inv, o1[4 * g4 + 3] * inv);
        *(GAS v2u*)(orow + 32 + 8 * g4) = x;
    }
}

__device__ __forceinline__ void p0_transpose_item(const float* W, int K, int N, bf16* WT, int row_off, LAS float* scr, int item, int lane) {
    const int nblk = N / 32, kb = item / nblk, nb = item % nblk, k0 = 64 * kb, n0 = 32 * nb;
    float wv[32];
#pragma unroll
    for (int i = 0; i < 32; ++i) { const int kk = 2 * i + (lane >> 5); wv[i] = *(const GAS float*)(W + (size_t)(k0 + kk) * N + n0 + (lane & 31)); }
#pragma unroll
    for (int i = 0; i < 32; ++i) { const int kk = 2 * i + (lane >> 5); scr[kk * 33 + (lane & 31)] = wv[i]; }
    LDS_WAIT(); asm volatile("" ::: "memory");
    const int c = lane & 7;
#pragma unroll
    for (int j = 0; j < 4; ++j) { const int n = (lane >> 3) + 8 * j; const LAS float* s = scr + (8 * c) * 33 + n;
        v4u o; o.x = pk2(s[0 * 33], s[1 * 33]); o.y = pk2(s[2 * 33], s[3 * 33]); o.z = pk2(s[4 * 33], s[5 * 33]); o.w = pk2(s[6 * 33], s[7 * 33]);
        *(GAS v4u*)(WT + (size_t)(row_off + n0 + n) * K + k0 + 8 * c) = o; }
    LDS_WAIT(); asm volatile("" ::: "memory");
}
__device__ __forceinline__ void convert_weights(Frame& F, int L) {
    unsigned char* const ws_ = wsl(F);
    LAS float* scr = (LAS float*)(F.lds + F.wave * 16384);
    const int gw = F.vcu * NWAVES + F.wave, NGW = F.G * NWAVES;
    const float* w_in = fin(F, 7) + (size_t)L * DM * PIN; const float* w_out = fin(F, 19) + (size_t)L * DM * DM;
    const float* w1 = fin(F, 22) + (size_t)L * DM * FF; const float* w2 = fin(F, 23) + (size_t)L * FF * DM;
    bf16* WIN = (bf16*)(ws_ + WS_WIN); bf16* WOUT = (bf16*)(ws_ + WS_WOUT); bf16* W1 = (bf16*)(ws_ + WS_W1); bf16* W2 = (bf16*)(ws_ + WS_W2);
    constexpr int I_IN = (DM / 64) * (PIN / 32), I_O = (DM / 64) * (DM / 32), I_1 = (DM / 64) * (FF / 32), I_2 = (FF / 64) * (DM / 32);
    constexpr int NITEMS = I_IN + I_O + I_1 + I_2;
    for (int it = gw; it < NITEMS; it += NGW) {
        int r = it;
        if (r < I_IN) { p0_transpose_item(w_in, DM, PIN, WIN, 0, scr, r, F.lane); continue; } r -= I_IN;
        if (r < I_O) { p0_transpose_item(w_out, DM, DM, WOUT, 0, scr, r, F.lane); continue; } r -= I_O;
        if (r < I_1) { p0_transpose_item(w1, DM, FF, W1, 0, scr, r, F.lane); continue; } r -= I_1;
        p0_transpose_item(w2, FF, DM, W2, 0, scr, r, F.lane);
    }
    const float* w_uq = fin(F, 10) + (size_t)L * 256 * 384; const float* g_q = fin(F, 9) + L * 256;
    const float* w_ukv = fin(F, 12) + (size_t)L * 128 * 512; const float* g_kv = fin(F, 11) + L * 128;
    const float* w_pw = fin(F, 17) + (size_t)L * 256 * 256;
    bf16* WUQ = (bf16*)(ws_ + WS_WUQ); bf16* WUKV = (bf16*)(ws_ + WS_WUKV); bf16* WPW = (bf16*)(ws_ + WS_WPW);
    const int gt = F.vcu * 512 + F.tid, NGT = F.G * 512;
    constexpr int E_UQ = 512 * 256, E_UKV = 512 * 256, E_PW = 256 * 256, E_PAD = (PINP - PIN) * DM;
    for (int e = gt; e < E_UQ + E_UKV + E_PW + E_PAD; e += NGT) {
        int r = e;
        if (r < E_UQ) { const int n = r >> 8, k = r & 255; float v = 0.f;
            if (n < 384) { const int head = n / 96, d = n % 96; int od = d;
                if (d >= 64) { const int j = d - 64; od = 64 + (j < 16 ? (j & 1) * 8 + (j >> 1) : 16 + ((j - 16) & 1) * 8 + ((j - 16) >> 1)); }
                v = w_uq[(size_t)k * 384 + head * 96 + od] * g_q[k]; }
            WUQ[r] = (bf16)f2bf(v); continue; } r -= E_UQ;
        if (r < E_UKV) { const int n = r >> 8, k = r & 255; float v = 0.f; if (k < 128) v = w_ukv[(size_t)k * 512 + n] * g_kv[k]; WUKV[r] = (bf16)f2bf(v); continue; } r -= E_UKV;
        if (r < E_PW) { const int n = r >> 8, k = r & 255; WPW[r] = (bf16)f2bf(w_pw[(size_t)k * 256 + n]); continue; } r -= E_PW;
        WIN[(size_t)PIN * DM + r] = 0;
    }
}
__device__ __forceinline__ void mod_gemv(Frame& F) {
    unsigned char* const ws_ = wsl(F);
    LAS float* red = (LAS float*)F.lds;
    float* MOD = (float*)(ws_ + WS_MOD);
    const float* c = fin(F, 1); const float* cctx = fin(F, 3);
    for (int unit = F.vcu; unit < 192; unit += F.G) {
        const int L = unit / 96, n0 = (unit % 96) * 64;
        const float* W = fin(F, 4) + (size_t)L * DM * 6144; const float* bm = fin(F, 5) + L * 6144;
        const int cg = F.tid & 15, ks = F.tid >> 4;
        float acc[5][4];
#pragma unroll
        for (int v = 0; v < 5; ++v)
#pragma unroll
            for (int e = 0; e < 4; ++e) acc[v][e] = 0.f;
        for (int kk = 0; kk < 32; ++kk) { const int k = ks * 32 + kk;
            const f32x4 w = *(const GAS f32x4*)(W + (size_t)k * 6144 + n0 + cg * 4);
#pragma unroll
            for (int v = 0; v < 5; ++v) { const float cv = v < 4 ? c[v * DM + k] : cctx[k]; const float s = cv * sigmoidf_(cv);
#pragma unroll
                for (int e = 0; e < 4; ++e) acc[v][e] += s * w[e]; } }
        __syncthreads();
#pragma unroll
        for (int v = 0; v < 5; ++v)
#pragma unroll
            for (int e = 0; e < 4; ++e) red[(ks * 5 + v) * 64 + cg * 4 + e] = acc[v][e];
        __syncthreads();
        if (F.tid < 320) { const int v = F.tid >> 6, col = F.tid & 63; float s = 0.f;
            for (int j = 0; j < 32; ++j) s += red[(j * 5 + v) * 64 + col];
            MOD[((size_t)L * 5 + v) * 6144 + n0 + col] = s + bm[n0 + col]; }
        __syncthreads();
    }
}

__device__ __forceinline__ const float* xrow_src(Frame& F, int L, int row) {
    if (L == 0) return row < NLAT ? fin(F, 0) + (size_t)row * DM : fin(F, 2) + (size_t)(row - NLAT) * DM;
    return row < NLAT ? fout(F) + (size_t)row * DM : (const float*)(F.ws + WS_R0C) + (size_t)(row - NLAT) * DM;
}
__device__ __forceinline__ float* r0row(Frame& F, int row) { return row < NLAT ? fout(F) + (size_t)row * DM : (float*)(F.ws + WS_R0C) + (size_t)(row - NLAT) * DM; }
__device__ __forceinline__ void load_row(const float* p, int lane, f32x4 (&v)[4]) {
#pragma unroll
    for (int j = 0; j < 4; ++j) v[j] = *(const GAS f32x4*)(p + 4 * lane + 256 * j);
}
__device__ __forceinline__ float row_rstd(const f32x4 (&v)[4]) {
    float s = 0.f;
#pragma unroll
    for (int j = 0; j < 4; ++j) s += (v[j].x * v[j].x + v[j].y * v[j].y) + (v[j].z * v[j].z + v[j].w * v[j].w);
    return 1.0f / sqrtf(wave_sum(s) * (1.0f / DM) + EPS);
}
__device__ __forceinline__ void write_modnorm(const f32x4 (&x)[4], float rstd, const float* g, const float* sc, const float* sh, bf16* dst, int lane) {
#pragma unroll
    for (int j = 0; j < 4; ++j) { const int c = 4 * lane + 256 * j;
        const f32x4 gv = *(const GAS f32x4*)(g + c), scv = *(const GAS f32x4*)(sc + c), shv = *(const GAS f32x4*)(sh + c);
        const f32x4 h = (x[j] * rstd * gv) * (scv + 1.0f) + shv;
        v2u w; w.x = pk2(h.x, h.y); w.y = pk2(h.z, h.w);
        *(GAS v2u*)(dst + c) = w; }
}
__device__ __forceinline__ void pass_prep(Frame& F, int L) {
    unsigned char* const ws_ = wsl(F);
    const int gw = F.vcu * NWAVES + F.wave, NGW = F.G * NWAVES;
    const float* MOD = (const float*)(ws_ + WS_MOD) + (size_t)L * 5 * 6144;
    const float* g = fin(F, 6) + L * DM;
    for (int row = gw; row < MALL; row += NGW) {
        f32x4 x[4]; load_row(xrow_src(F, L, row), F.lane, x);
        const float rstd = row_rstd(x);
        const float* mv = MOD + (row < NLAT ? (row >> 12) : 4) * 6144;
        write_modnorm(x, rstd, g, mv + 1024, mv + 0, (bf16*)(ws_ + WS_R1 + (size_t)row * 4096), F.lane);
    }
}
__device__ __forceinline__ void pass_postwo(Frame& F, int L, int nrows) {
    unsigned char* const ws_ = wsl(F);
    const int gw = F.vcu * NWAVES + F.wave, NGW = F.G * NWAVES;
    const float* MOD = (const float*)(ws_ + WS_MOD) + (size_t)L * 5 * 6144;
    const float* gpost = fin(F, 20) + L * DM; const float* gpre = fin(F, 21) + L * DM;
    for (int row = gw; row < nrows; row += NGW) {
        float* yrow = (float*)(ws_ + WS_R1 + (size_t)row * 4096);
        f32x4 y[4], x[4];
        if (L == 0 && row >= NLAT) { const float* sl = (const float*)(ws_ + WS_U) + (size_t)(row - NLAT) * DM; f32x4 t[4]; load_row(sl, F.lane, y);
#pragma unroll
            for (int q = 1; q < 4; ++q) { load_row(sl + (size_t)q * NCTXR * DM, F.lane, t);
#pragma unroll
                for (int j = 0; j < 4; ++j) y[j] = y[j] + t[j]; } }
        else load_row(yrow, F.lane, y);
        load_row(xrow_src(F, L, row), F.lane, x);
        const float ry = row_rstd(y);
        const float* mv = MOD + (row < NLAT ? (row >> 12) : 4) * 6144;
#pragma unroll
        for (int j = 0; j < 4; ++j) { const int c = 4 * F.lane + 256 * j;
            const f32x4 gv = *(const GAS f32x4*)(gpost + c), ga = *(const GAS f32x4*)(mv + 2048 + c);
            x[j] = x[j] + ga * (y[j] * ry * gv); }
        float* xo = r0row(F, row);
#pragma unroll
        for (int j = 0; j < 4; ++j) *(GAS f32x4*)(xo + 4 * F.lane + 256 * j) = x[j];
        const float r1 = row_rstd(x);
        write_modnorm(x, r1, gpre, mv + 4096, mv + 3072, (bf16*)yrow, F.lane);
    }
}
__device__ __forceinline__ void pass_postmlp(Frame& F, int L, int nrows) {
    unsigned char* const ws_ = wsl(F);
    const int gw = F.vcu * NWAVES + F.wave, NGW = F.G * NWAVES;
    const float* MOD = (const float*)(ws_ + WS_MOD) + (size_t)L * 5 * 6144;
    const float* gpost = fin(F, 24) + L * DM;
    for (int row = gw; row < nrows; row += NGW) {
        float* mrow = (float*)(ws_ + WS_R1 + (size_t)row * 4096);
        float* xo = r0row(F, row);
        f32x4 y[4], x[4];
        if (L == 0 && row >= NLAT) { const float* sl = (const float*)(ws_ + WS_KM) + (size_t)(row - NLAT) * DM; f32x4 t[4]; load_row(sl, F.lane, y);
#pragma unroll
            for (int q = 1; q < 4; ++q) { load_row(sl + (size_t)q * NCTXR * DM, F.lane, t);
#pragma unroll
                for (int j = 0; j < 4; ++j) y[j] = y[j] + t[j]; } }
        else load_row(mrow, F.lane, y);
        load_row(xo, F.lane, x);
        const float ry = row_rstd(y);
        const float* mv = MOD + (row < NLAT ? (row >> 12) : 4) * 6144;
#pragma unroll
        for (int j = 0; j < 4; ++j) { const int c = 4 * F.lane + 256 * j;
            const f32x4 gv = *(const GAS f32x4*)(gpost + c), ga = *(const GAS f32x4*)(mv + 5120 + c);
            x[j] = x[j] + ga * (y[j] * ry * gv); }
#pragma unroll
        for (int j = 0; j < 4; ++j) *(GAS f32x4*)(xo + 4 * F.lane + 256 * j) = x[j];
        if (L == 0) {
            const float* mv1 = mv + 5 * 6144;
            const float r1 = row_rstd(x);
            write_modnorm(x, r1, fin(F, 6) + DM, mv1 + 1024, mv1 + 0, (bf16*)mrow, F.lane);
        }
    }
}

__device__ __forceinline__ void row_bk(int row, int& b, int& kk) { if (row < NLAT) { b = row >> 12; kk = row & 4095; } else { const int r2 = row - NLAT; b = r2 >> 8; kk = 4096 + (r2 & 255); } }
__device__ __forceinline__ void pass_mix(Frame& F, int L) {
    unsigned char* const ws_ = wsl(F);
    const bf16* U = (const bf16*)(ws_ + WS_U); bf16* Y = (bf16*)(ws_ + WS_Y);
    {
        const float* wsc = fin(F, 8) + L * 3 * 256;
        const int gt = F.vcu * 512 + F.tid, NGT = F.G * 512;
        for (int idx = gt; idx < MALL * 32; idx += NGT) {
            const int row = idx >> 5, c8 = idx & 31;
            int t, len; if (row < NLAT) { t = row & 4095; len = 4096; } else { t = (row - NLAT) & 255; len = 256; }
            const bf16* ur = U + (size_t)row * PINP + c8 * 8;
            float acc[8];
#pragma unroll
            for (int e = 0; e < 8; ++e) acc[e] = 0.f;
#pragma unroll
            for (int k = 0; k < 3; ++k) { const int tt = t + k - 1; if (tt < 0 || tt >= len) continue;
                const bf16* up = ur + (ptrdiff_t)(k - 1) * PINP;
                const v4u xi = *(const GAS v4u*)(up), cg = *(const GAS v4u*)(up + 512);
                const f32x4 w0 = *(const f32x4*)(wsc + k * 256 + c8 * 8), w1 = *(const f32x4*)(wsc + k * 256 + c8 * 8 + 4);
                acc[0] += w0.x * (bflo(xi.x) * bflo(cg.x)); acc[1] += w0.y * (bfhi(xi.x) * bfhi(cg.x));
                acc[2] += w0.z * (bflo(xi.y) * bflo(cg.y)); acc[3] += w0.w * (bfhi(xi.y) * bfhi(cg.y));
                acc[4] += w1.x * (bflo(xi.z) * bflo(cg.z)); acc[5] += w1.y * (bfhi(xi.z) * bfhi(cg.z));
                acc[6] += w1.z * (bflo(xi.w) * bflo(cg.w)); acc[7] += w1.w * (bfhi(xi.w) * bfhi(cg.w)); }
            const v4u bg = *(const GAS v4u*)(ur + 256);
            v4u o; o.x = pk2(acc[0] * bflo(bg.x), acc[1] * bfhi(bg.x)); o.y = pk2(acc[2] * bflo(bg.y), acc[3] * bfhi(bg.y));
            o.z = pk2(acc[4] * bflo(bg.z), acc[5] * bfhi(bg.z)); o.w = pk2(acc[6] * bflo(bg.w), acc[7] * bfhi(bg.w));
            *(GAS v4u*)(Y + (size_t)row * DM + c8 * 8) = o;
        }
    }
    {
        const int gw = F.vcu * NWAVES + F.wave, NGW = F.G * NWAVES;
        float* RSQ = (float*)(ws_ + WS_RSQ); float* RSKV = (float*)(ws_ + WS_RSKV); bf16* KM = (bf16*)(ws_ + WS_KM);
        for (int row = gw; row < MALL; row += NGW) {
            const bf16* ur = U + (size_t)row * PINP;
            float sq = 0.f, skv = 0.f;
            if (F.lane < 48) { const v4u w = *(const GAS v4u*)(ur + 768 + F.lane * 8);
                float s = bflo(w.x) * bflo(w.x) + bfhi(w.x) * bfhi(w.x) + bflo(w.y) * bflo(w.y) + bfhi(w.y) * bfhi(w.y) + bflo(w.z) * bflo(w.z) + bfhi(w.z) * bfhi(w.z) + bflo(w.w) * bflo(w.w) + bfhi(w.w) * bfhi(w.w);
                if (F.lane < 32) sq = s; else skv = s; }
            sq = wave_sum(sq); skv = wave_sum(skv);
            if (F.lane == 0) { RSQ[row] = 1.0f / sqrtf(sq * (1.0f / 256.0f) + EPS); RSKV[row] = 1.0f / sqrtf(skv * (1.0f / 128.0f) + EPS); }
            if (F.lane < 16) { const int part = F.lane >> 3, i = F.lane & 7;
                float x1 = bf1(ur[1152 + part * 16 + i]), x2 = bf1(ur[1152 + part * 16 + 8 + i]);
                int b, kk; row_bk(row, b, kk);
                if (row < NLAT) { const int t = row & 4095, pos = part ? (t & 63) : (t >> 6); const float c = ROPE_TAB[(pos * 8 + i) * 2], s = ROPE_TAB[(pos * 8 + i) * 2 + 1];
                    const float a = x1 * c - x2 * s, bb = x1 * s + x2 * c; x1 = a; x2 = bb; }
                const unsigned w = pk2(x1, x2);
#pragma unroll
                for (int h = 0; h < 4; ++h) *(unsigned*)(KM + ((size_t)((b * 4 + h) * KEYS + kk)) * 96 + 64 + part * 16 + 2 * i) = w; }
        }
    }
    {
        LAS float* Z = (LAS float*)F.lds;
        LAS float* YL = (LAS float*)(F.lds + 62 * 1024);
        bf16* SCF = (bf16*)(ws_ + WS_SCF);
        const float* wdw = fin(F, 13) + (size_t)L * 31 * 256; const float* bdw = fin(F, 14) + L * 256; const float* lng = fin(F, 15) + L * 256; const float* lnb = fin(F, 16) + L * 256;
        for (int tile = F.vcu; tile < MALL / 32; tile += F.G) {
            const int row0 = tile * 32;
            int t0, len, base; if (row0 < NLAT) { t0 = row0 & 4095; len = 4096; base = row0 - t0; } else { t0 = (row0 - NLAT) & 255; len = 256; base = row0 - t0; }
            __syncthreads();
            for (int idx = F.tid; idx < 62 * 32; idx += 512) { const int tt = idx >> 5, c8 = idx & 31; const int tp = t0 + tt - 15;
                float z[8];
                if (tp >= 0 && tp < len) { const bf16* ur = U + (size_t)(base + tp) * PINP + 1184 + c8 * 8;
                    const v4u a = *(const GAS v4u*)ur, gg = *(const GAS v4u*)(ur + 256);
                    z[0] = bflo(a.x) * sigmoidf_(bflo(gg.x)); z[1] = bfhi(a.x) * sigmoidf_(bfhi(gg.x)); z[2] = bflo(a.y) * sigmoidf_(bflo(gg.y)); z[3] = bfhi(a.y) * sigmoidf_(bfhi(gg.y));
                    z[4] = bflo(a.z) * sigmoidf_(bflo(gg.z)); z[5] = bfhi(a.z) * sigmoidf_(bfhi(gg.z)); z[6] = bflo(a.w) * sigmoidf_(bflo(gg.w)); z[7] = bfhi(a.w) * sigmoidf_(bfhi(gg.w));
                } else {
#pragma unroll
                    for (int e = 0; e < 8; ++e) z[e] = 0.f; }
                *(LAS f32x4*)(Z + tt * 256 + c8 * 8) = (f32x4){z[0], z[1], z[2], z[3]}; *(LAS f32x4*)(Z + tt * 256 + c8 * 8 + 4) = (f32x4){z[4], z[5], z[6], z[7]}; }
            __syncthreads();
            { const int c = F.tid & 255, half = F.tid >> 8; const float bias = bdw[c];
                float acc[16];
#pragma unroll
                for (int i = 0; i < 16; ++i) acc[i] = bias;
                for (int k = 0; k < 31; ++k) { const float w = wdw[k * 256 + c];
#pragma unroll
                    for (int i = 0; i < 16; ++i) acc[i] += w * Z[(half * 16 + i + k) * 256 + c]; }
#pragma unroll
                for (int i = 0; i < 16; ++i) YL[(half * 16 + i) * 256 + c] = acc[i]; }
            __syncthreads();
#pragma unroll
            for (int q = 0; q < 4; ++q) { const int tok = F.wave * 4 + q;
                const f32x4 v = *(const LAS f32x4*)(YL + tok * 256 + F.lane * 4);
                const float mean = wave_sum((v.x + v.y) + (v.z + v.w)) * (1.0f / 256.0f);
                const f32x4 dv = v - mean;
                const float var = wave_sum((dv.x * dv.x + dv.y * dv.y) + (dv.z * dv.z + dv.w * dv.w)) * (1.0f / 256.0f);
                const float rs = 1.0f / sqrtf(var + EPS);
                const f32x4 gv = *(const f32x4*)(lng + F.lane * 4), bv = *(const f32x4*)(lnb + F.lane * 4);
                f32x4 o = dv * rs * gv + bv;
                o.x = o.x * sigmoidf_(o.x); o.y = o.y * sigmoidf_(o.y); o.z = o.z * sigmoidf_(o.z); o.w = o.w * sigmoidf_(o.w);
                v2u w; w.x = pk2(o.x, o.y); w.y = pk2(o.z, o.w);
                *(GAS v2u*)(SCF + (size_t)(row0 + tok) * 256 + F.lane * 4) = w; }
        }
        __syncthreads();
    }
    {
        const int gw = F.vcu * NWAVES + F.wave, NGW = F.G * NWAVES;
        bf16* NVT = (bf16*)(ws_ + WS_NVT);
        for (int task = gw; task < (MALL / 64) * 32; task += NGW) {
            const int kb = task >> 5, ch = task & 31, h = ch >> 3, dv0 = (ch & 7) * 8;
            const int row = kb * 64 + F.lane; int b, kk; row_bk(row, b, kk);
            const v4u w = *(const GAS v4u*)(U + (size_t)row * PINP + 2208 + ch * 8);
            GAS bf16* vp = (GAS bf16*)(NVT + ((size_t)((b * 4 + h) * 64 + dv0)) * KEYS + kk);
            vp[0 * KEYS] = (bf16)(w.x & 0xffffu); vp[1 * KEYS] = (bf16)(w.x >> 16); vp[2 * KEYS] = (bf16)(w.y & 0xffffu); vp[3 * KEYS] = (bf16)(w.y >> 16);
            vp[4 * KEYS] = (bf16)(w.z & 0xffffu); vp[5 * KEYS] = (bf16)(w.z >> 16); vp[6 * KEYS] = (bf16)(w.w & 0xffffu); vp[7 * KEYS] = (bf16)(w.w >> 16);
        }
    }
}

__device__ __forceinline__ void pass_attn(Frame& F, int L) {
    unsigned char* const ws_ = wsl(F);
    const bf16* U = (const bf16*)(ws_ + WS_U); bf16* Y = (bf16*)(ws_ + WS_Y);
    const bf16* QM = (const bf16*)(ws_ + WS_QM); const bf16* KM = (const bf16*)(ws_ + WS_KM); const bf16* VTM = (const bf16*)(ws_ + WS_VTM); const bf16* NVT = (const bf16*)(ws_ + WS_NVT);
    for (int u = F.vcu; u < 256; u += F.G) {
        const int b = u >> 6, h = (u >> 4) & 3, qb = u & 15; const int row = b * 4096 + qb * 256 + F.wave * 32;
        AttnDesc d; d.q = QM + (size_t)row * 384 + h * 96; d.qpitch = 384; d.o = Y + (size_t)row * DM + 256 + h * 64;
        d.k0 = KM + (size_t)((b * 4 + h) * KEYS) * 96; d.k1 = d.k0; d.kpitch = 96; d.nseg0 = 68; d.nt = 68;
        d.v0 = VTM + (size_t)((b * 4 + h) * 64) * KEYS; d.v1 = d.v0; d.cq = 0; d.offr0 = 0; d.rpb = nullptr;
        attn_unit<96, 1, 0>(F.lds, d);
    }
    {
        LAS float* RP = (LAS float*)(F.lds + 4 * (64 * 72 * 2 + 64 * 68 * 2));
        const float* rpb = fin(F, 18) + (size_t)L * 4 * 15 * 31;
        __syncthreads();
        for (int i = F.tid; i < 4 * 15 * 31; i += 512) RP[i] = rpb[i] * LOG2E;
        for (int u = F.vcu; u < 256; u += F.G) {
            const int b = u >> 6, r = u & 63, h = F.wave >> 1, half = F.wave & 1; const int row = b * 4096 + r * 64 + half * 32;
            const int rs = min(max(r - 4, 0), 56);
            AttnDesc d; d.q = U + (size_t)row * PINP + 1696 + h * 64; d.qpitch = PINP; d.o = Y + (size_t)row * DM + 768 + h * 64;
            d.k0 = U + (size_t)(b * 4096 + rs * 64) * PINP + 1952 + h * 64; d.k1 = U + (size_t)(NLAT + b * 256) * PINP + 1952 + h * 64; d.kpitch = PINP; d.nseg0 = 8; d.nt = 12;
            d.v0 = NVT + (size_t)((b * 4 + h) * 64) * KEYS + rs * 64; d.v1 = NVT + (size_t)((b * 4 + h) * 64) * KEYS + 4096;
            d.cq = half * 32; d.offr0 = rs - r + 7; d.rpb = RP + h * 465;
            attn_unit<64, 4, 2>(F.lds, d);
        }
    }
    if (L == 0) {
        for (int u = F.vcu; u < 32; u += F.G) {
            const int bh = u & 15, b = bh >> 2, h = bh & 3; const int row = NLAT + b * 256 + F.wave * 32;
            AttnDesc d; d.cq = 0; d.offr0 = 0; d.rpb = nullptr; d.nseg0 = 4; d.nt = 4;
            if (u < 16) {
                d.q = QM + (size_t)row * 384 + h * 96; d.qpitch = 384; d.o = Y + (size_t)row * DM + 256 + h * 64;
                d.k0 = KM + (size_t)((b * 4 + h) * KEYS + 4096) * 96; d.k1 = d.k0; d.kpitch = 96;
                d.v0 = VTM + (size_t)((b * 4 + h) * 64) * KEYS + 4096; d.v1 = d.v0;
                attn_unit<96, 1, 0>(F.lds, d);
            } else {
                d.q = U + (size_t)row * PINP + 1696 + h * 64; d.qpitch = PINP; d.o = Y + (size_t)row * DM + 768 + h * 64;
                d.k0 = U + (size_t)(NLAT + b * 256) * PINP + 1952 + h * 64; d.k1 = d.k0; d.kpitch = PINP;
                d.v0 = NVT + (size_t)((b * 4 + h) * 64) * KEYS + 4096; d.v1 = d.v0;
                attn_unit<64, 1, 1>(F.lds, d);
            }
        }
    }
    __syncthreads();
}

__global__ void __launch_bounds__(NWAVES * 64, 2) hybrid_fwd(Args args) {
    extern __shared__ __attribute__((aligned(16))) unsigned char lds[];
    Frame F0;
    F0.lds = (LAS unsigned char*)lds;
    F0.tid = 0; F0.lane = 0; F0.wave = __builtin_amdgcn_readfirstlane((int)threadIdx.x >> 6);
    F0.G = gridDim.x; { const int bx = blockIdx.x; F0.vcu = (F0.G % 8 == 0) ? (bx % 8) * (F0.G / 8) + bx / 8 : bx; }
    F0.ws = args.ws;
    if (args.never) cooperative_groups::this_grid().sync();
    volatile LAS unsigned* MISC = (volatile LAS unsigned*)(F0.lds + MISC_OFF);
    for (int u = threadIdx.x; u < (LDS_BYTES - RING_BYTES) / 4; u += NWAVES * 64) ((LAS unsigned*)(F0.lds + RING_BYTES))[u] = 0u;
    __syncthreads();
    if (threadIdx.x == 0) { LAS unsigned* t = (LAS unsigned*)(F0.lds + PTAB_OFF);
#pragma unroll
        for (int i = 0; i < 25; ++i) { const unsigned long long p = (unsigned long long)args.in[i]; t[2 * i] = (unsigned)p; t[2 * i + 1] = (unsigned)(p >> 32); }
        const unsigned long long po = (unsigned long long)args.out; t[50] = (unsigned)po; t[51] = (unsigned)(po >> 32); }
    __syncthreads();
    unsigned* ctl = (unsigned*)(F0.ws + WS_CTL);
    XcdBarrier bar = xcd_barrier_post(ctl + CW_BAR, MISC + 8);
#define GRID_BAR() xcd_barrier(bar)
    const int bx0 = (int)blockIdx.x;

#define MKFRAME() Frame F = F0; int bx = bx0; { int t_ = threadIdx.x; asm volatile("" : "+v"(t_)); F.tid = t_; F.lane = t_ & 63; } \
        asm volatile("" : "+s"(F.wave), "+s"(F.vcu), "+s"(F.G), "+s"(F.ws), "+s"(bx)); LAS unsigned char* ring = F.lds; (void)ring; (void)bx
    constexpr int NPH = 20;
#pragma nounroll
    for (int ph = 0; ph < NPH; ++ph) {
        const int kind = ph < 2 ? ph : 2 + (ph - 2) % 9, L = ph < 2 ? 0 : (ph - 2) / 9;
        const int MR = (L == 0) ? MALL : NLAT;
        if (kind == 0) { MKFRAME(); mod_gemv(F); convert_weights(F, 0); }
        if (kind == 1) { MKFRAME(); pass_prep(F, 0); }
        if (kind == 3) { MKFRAME(); pass_mix(F, L); }
        if (kind == 4) {
            MKFRAME(); unsigned char* const ws_ = wsl(F);
            { pg8::Gemm g{(const pg8::bf16_t*)(ws_ + WS_U) + 768, (const pg8::bf16_t*)(ws_ + WS_WUQ), MALL, 512, 256, PINP, 256}; pg8::StaticOrder S; S.init(MALL, 512, F.G, bx);
              pg8::EpiUQ E{(pg8::bf16_t*)(ws_ + WS_QM), (const float*)(ws_ + WS_RSQ), ROPE_TAB, QSCALE};
              pg8::gemm_phase<pg8::EpiUQ, pg8::StaticOrder, true, true>(ring, g, S, E); }
            { pg8::Gemm g{(const pg8::bf16_t*)(ws_ + WS_U) + 1024, (const pg8::bf16_t*)(ws_ + WS_WUKV), MALL, 512, 256, PINP, 256}; pg8::StaticOrder S; S.init(MALL, 512, F.G, (bx + 136) % F.G);
              pg8::EpiUKV E{(pg8::bf16_t*)(ws_ + WS_KM), (pg8::bf16_t*)(ws_ + WS_VTM), (const float*)(ws_ + WS_RSKV)};
              pg8::gemm_phase<pg8::EpiUKV, pg8::StaticOrder, true, true>(ring, g, S, E); }
        }
        if (kind == 2 || kind == 4 || kind == 8) {
            MKFRAME(); unsigned char* const ws_ = wsl(F);
            pg8::Gemm g; pg8::EpiBf16 E; int c = bx;
            if (kind == 2) { g = pg8::Gemm{(const pg8::bf16_t*)(ws_ + WS_R1), (const pg8::bf16_t*)(ws_ + WS_WIN), MALL, PINP, DM, 2048, DM}; E = pg8::EpiBf16{(pg8::bf16_t*)(ws_ + WS_U), PINP, 0}; }
            else if (kind == 4) { g = pg8::Gemm{(const pg8::bf16_t*)(ws_ + WS_SCF), (const pg8::bf16_t*)(ws_ + WS_WPW), MALL, 256, 256, 256, 256}; E = pg8::EpiBf16{(pg8::bf16_t*)(ws_ + WS_Y) + 512, DM, 0}; c = (bx + 16) % F.G; }
            else { g = pg8::Gemm{(const pg8::bf16_t*)(ws_ + WS_R1), (const pg8::bf16_t*)(ws_ + WS_W1), MR, FF, DM, 2048, DM}; E = pg8::EpiBf16{(pg8::bf16_t*)(ws_ + WS_A1), FF, 2}; }
            pg8::StaticOrder S; S.init(g.M, g.N, F.G, c);
            pg8::gemm_phase<pg8::EpiBf16, pg8::StaticOrder, true, true>(ring, g, S, E);
        }
        if (kind == 5) { MKFRAME(); pass_attn(F, L); }
        if (kind == 6 || kind == 9) {
            MKFRAME(); unsigned char* const ws_ = wsl(F);
            pg8::Gemm g;
            if (kind == 6) g = pg8::Gemm{(const pg8::bf16_t*)(ws_ + WS_Y), (const pg8::bf16_t*)(ws_ + WS_WOUT), MR, DM, DM, DM, DM};
            else g = pg8::Gemm{(const pg8::bf16_t*)(ws_ + WS_A1), (const pg8::bf16_t*)(ws_ + WS_W2), MR, DM, FF, FF, FF};
            g.M = NLAT;
            pg8::StaticOrder S; S.init(g.M, g.N, F.G, bx);
            pg8::EpiF32 E{(float*)(ws_ + WS_R1), DM};
            pg8::gemm_phase<pg8::EpiF32, pg8::StaticOrder, true, true>(ring, g, S, E);
        }
        if ((kind == 6 || kind == 9) && L == 0) {
            MKFRAME(); unsigned char* const ws_ = wsl(F);
            const int K = (kind == 6) ? DM : FF;
            const int u = bx >> 2, slice = bx & 3, ks = K >> 2;
            pg8::OneUnit S1{64 + (u >> 2), u & 3, u < 16 ? 1 : 0};
            pg8::Gemm g2;
            if (kind == 6) g2 = pg8::Gemm{(const pg8::bf16_t*)(ws_ + WS_Y) + slice * ks, (const pg8::bf16_t*)(ws_ + WS_WOUT) + slice * ks, MALL, DM, ks, DM, DM};
            else g2 = pg8::Gemm{(const pg8::bf16_t*)(ws_ + WS_A1) + slice * ks, (const pg8::bf16_t*)(ws_ + WS_W2) + slice * ks, MALL, DM, ks, FF, FF};
            float* Cc = (float*)(ws_ + (kind == 6 ? WS_U : WS_KM)) + (size_t)slice * NCTXR * DM;
            pg8::EpiF32 E2{Cc - (size_t)NLAT * DM, DM};
            pg8::gemm_phase<pg8::EpiF32, pg8::OneUnit, true, true>(ring, g2, S1, E2);
        }
        if (kind == 7) { MKFRAME(); pass_postwo(F, L, MR); }
        if (kind == 10) { MKFRAME(); pass_postmlp(F, L, MR); if (L == 0) convert_weights(F, 1); }
        if (ph + 1 < NPH) GRID_BAR();
    }
#undef GRID_BAR
}

extern "C" void kernel_launch(void* const* d_in, const int* in_sizes, int n_in, void* d_out, int out_size, void* d_ws, size_t ws_size, hipStream_t stream) {
    static int grid = 0;
    if (grid == 0) {
        if (n_in != 25 || out_size != NLAT * DM || ws_size < 256 * MiB) { fprintf(stderr, "kernel_launch: unexpected shapes (n_in %d out %d ws %zu)\n", n_in, out_size, ws_size); grid = -1; return; }
        int dev = 0, cus = 0;
        if (hipGetDevice(&dev) != hipSuccess || hipDeviceGetAttribute(&cus, hipDeviceAttributeMultiprocessorCount, dev) != hipSuccess) { grid = -1; return; }
        if (hipFuncSetAttribute((const void*)hybrid_fwd, hipFuncAttributeMaxDynamicSharedMemorySize, LDS_BYTES) != hipSuccess) { fprintf(stderr, "kernel_launch: hipFuncSetAttribute failed\n"); grid = -1; return; }
        (void)hipGetLastError();
        grid = cus;
    }
    if (grid < 0) return;
    if (hipMemsetAsync((char*)d_ws + WS_CTL, 0, CTL_ZERO_BYTES, stream) != hipSuccess) { fprintf(stderr, "kernel_launch: memset failed\n"); return; }
    Args a{};
    for (int i = 0; i < 25; ++i) a.in[i] = (const float*)d_in[i];
    a.out = (float*)d_out; a.ws = (unsigned char*)d_ws; a.never = 0; a.pad = 0;
    void* kargs[] = {&a};
    hipError_t e = hipLaunchCooperativeKernel((const void*)hybrid_fwd, dim3(grid), dim3(NWAVES * 64), kargs, LDS_BYTES, stream);
    if (e != hipSuccess) fprintf(stderr, "kernel_launch: cooperative launch failed: %s (grid %d)\n", hipGetErrorString(e), grid);
}
```

```cpp
#include <hip/hip_runtime.h>
#include <cstdio>
#include <cstdint>
#include <hip/hip_cooperative_groups.h>
namespace pg8 {
#define PG8_LAS __attribute__((address_space(3)))
typedef unsigned short bf16_t;
typedef short bf16x8 __attribute__((ext_vector_type(8)));
typedef float f32x4 __attribute__((ext_vector_type(4)));
typedef unsigned u32x4 __attribute__((ext_vector_type(4)));
constexpr int BM = 256, BK = 64, HALF = 128, HTB = HALF * BK * 2  , STAGE_BYTES = 8 * HTB, NXCD = 8, WGM = 8;

__host__ __device__ __forceinline__ int lds_byte(int r, int c) { const int st = (r >> 4) * 2 + (c >> 5), rr = r & 15, cc = c & 31, ob = rr * 64 + cc * 2; return st * 1024 + (ob ^ (((ob >> 9) & 1) << 5)); }
__host__ __device__ __forceinline__ void stage_rc(int b, int& R, int& C) { const int st = b / 1024, sb = b % 1024, swz = sb ^ (((sb >> 9) & 1) << 5); R = (st >> 1) * 16 + swz / 64; C = (st & 1) * 32 + (swz % 64) / 2; }
__host__ __device__ __forceinline__ int perm32(int rho) { const int n = rho >> 4, i = rho & 15; return 8 * (i >> 2) + 4 * n + (i & 3); }

struct Unit { int pm, pn; };
struct Gemm { const bf16_t* A; const bf16_t* Bt; int M, N, K, lda, ldb; };

struct StaticOrder {
    int nM, nN, nwg, G, c;
    __host__ __device__ void init(int M, int N, int G_, int c_) { nM = M / BM; nN = N / BM; nwg = nM * nN; G = G_; c = c_; }
    __host__ __device__ bool next(int i, Unit& u) const {
        const long L = (long)i * G + c; if (L >= nwg) return false;
        int wgid = (int)L; { const int q = nwg / NXCD, r = nwg % NXCD, xcd = wgid % NXCD, off = wgid / NXCD; wgid = (xcd < r ? xcd * (q + 1) : r * (q + 1) + (xcd - r) * q) + off; }
        const int nig = WGM * nN, gid = wgid / nig, fm = gid * WGM, gsz = (nM - fm) < WGM ? (nM - fm) : WGM;
        u.pm = fm + ((wgid % nig) % gsz); u.pn = (wgid % nig) / gsz; return true;
    }
    __device__ __forceinline__ void a_ready(const Unit&) const {}
    __device__ __forceinline__ void done(const Unit&) const {}
};

__device__ __forceinline__ unsigned cvt_pk_bf16(float lo, float hi) { unsigned r; asm volatile("v_cvt_pk_bf16_f32 %0, %1, %2" : "=v"(r) : "v"(lo), "v"(hi)); return r; }
typedef float f32x2 __attribute__((ext_vector_type(2)));
struct EpiF32 {
    static constexpr bool PERM = false, AFTER_DRAIN = false;
    float* C; int ldc;
    __device__ __forceinline__ void operator()(const f32x4 (&acc)[2][2][4][2], const Unit& u, int wr, int wc, int fr, int fq) const {
        const int row0 = u.pm * BM + wr * 64 + fr, col0 = u.pn * BM + wc * 32 + 4 * fq;
#pragma unroll
        for (int ai = 0; ai < 2; ++ai)
#pragma unroll
            for (int m = 0; m < 4; ++m) { float* rowp = C + (size_t)(row0 + ai * HALF + m * 16) * ldc + col0;
#pragma unroll
                for (int bj = 0; bj < 2; ++bj)
#pragma unroll
                    for (int n = 0; n < 2; ++n) *(__attribute__((address_space(1))) f32x4*)(rowp + bj * HALF + n * 16) = acc[ai][bj][m][n]; }
    }
};
struct OneUnit {
    int pm, pn, on;
    __device__ __forceinline__ bool next(int i, Unit& u) const { if (i != 0 || !on) return false; u.pm = pm; u.pn = pn; return true; }
    __device__ __forceinline__ void a_ready(const Unit&) const {}
    __device__ __forceinline__ void done(const Unit&) const {}
};
struct EpiBf16 {
    static constexpr bool PERM = true, AFTER_DRAIN = false;
    bf16_t* O; int ldc; int ACT;
    __device__ __forceinline__ void operator()(const f32x4 (&acc)[2][2][4][2], const Unit& u, int wr, int wc, int fr, int fq) const {
        const int row0 = u.pm * BM + wr * 64 + fr, col0 = u.pn * BM + wc * 32 + 8 * fq;
#pragma unroll
        for (int ai = 0; ai < 2; ++ai)
#pragma unroll
            for (int m = 0; m < 4; ++m) { bf16_t* rowp = O + (size_t)(row0 + ai * HALF + m * 16) * ldc + col0;
#pragma unroll
                for (int bj = 0; bj < 2; ++bj) { f32x4 v0 = acc[ai][bj][m][0], v1 = acc[ai][bj][m][1];
                    if (ACT == 2) {
#pragma unroll
                        for (int e = 0; e < 4; ++e) { const float a = fmaxf(v0[e], 0.f), b = fmaxf(v1[e], 0.f); v0[e] = a * a; v1[e] = b * b; } }
                    u32x4 w; w.x = cvt_pk_bf16(v0[0], v0[1]); w.y = cvt_pk_bf16(v0[2], v0[3]); w.z = cvt_pk_bf16(v1[0], v1[1]); w.w = cvt_pk_bf16(v1[2], v1[3]);
                    *(__attribute__((address_space(1))) u32x4*)(rowp + bj * HALF) = w; } }
    }
};
struct EpiUQ {
    static constexpr bool PERM = true, AFTER_DRAIN = false;
    bf16_t* Q; const float* rstd; const float* tab; float qscale;
    __device__ __forceinline__ void operator()(const f32x4 (&acc)[2][2][4][2], const Unit& u, int wr, int wc, int fr, int fq) const {
        const int row0 = u.pm * BM + wr * 64 + fr, col0 = u.pn * BM + wc * 32 + 8 * fq;
#pragma unroll
        for (int ai = 0; ai < 2; ++ai)
#pragma unroll
            for (int m = 0; m < 4; ++m) { const int row = row0 + ai * HALF + m * 16; const float rs = rstd[row] * qscale;
                const bool latent = row < 16384; const int t = row & 4095, prow = t >> 6, pcol = t & 63;
#pragma unroll
                for (int bj = 0; bj < 2; ++bj) { const int col = col0 + bj * HALF; if (col >= 384) continue;
                    f32x4 v0 = acc[ai][bj][m][0] * rs, v1 = acc[ai][bj][m][1] * rs;
                    const int d0 = col % 96;
                    if (d0 >= 64 && latent) { const int j0 = d0 - 64, part = j0 >> 4, i0 = (j0 & 15) >> 1; const int pos = part ? pcol : prow;
                        const float* cs = tab + (pos * 8 + i0) * 2;
                        float x1, x2, c, s;
                        x1 = v0[0]; x2 = v0[1]; c = cs[0]; s = cs[1]; v0[0] = x1 * c - x2 * s; v0[1] = x1 * s + x2 * c;
                        x1 = v0[2]; x2 = v0[3]; c = cs[2]; s = cs[3]; v0[2] = x1 * c - x2 * s; v0[3] = x1 * s + x2 * c;
                        x1 = v1[0]; x2 = v1[1]; c = cs[4]; s = cs[5]; v1[0] = x1 * c - x2 * s; v1[1] = x1 * s + x2 * c;
                        x1 = v1[2]; x2 = v1[3]; c = cs[6]; s = cs[7]; v1[2] = x1 * c - x2 * s; v1[3] = x1 * s + x2 * c; }
                    u32x4 w; w.x = cvt_pk_bf16(v0[0], v0[1]); w.y = cvt_pk_bf16(v0[2], v0[3]); w.z = cvt_pk_bf16(v1[0], v1[1]); w.w = cvt_pk_bf16(v1[2], v1[3]);
                    *(__attribute__((address_space(1))) u32x4*)(Q + (size_t)row * 384 + col) = w; } }
    }
};
struct EpiUKV {
    static constexpr bool PERM = true, AFTER_DRAIN = false;
    bf16_t* KM; bf16_t* VT; const float* rstd;
    __device__ __forceinline__ void operator()(const f32x4 (&acc)[2][2][4][2], const Unit& u, int wr, int wc, int fr, int fq) const {
        const int row0 = u.pm * BM + wr * 64 + fr, col0 = u.pn * BM + wc * 32 + 8 * fq;
#pragma unroll
        for (int ai = 0; ai < 2; ++ai)
#pragma unroll
            for (int m = 0; m < 4; ++m) { const int row = row0 + ai * HALF + m * 16; const float rs = rstd[row];
                int b, kk; if (row < 16384) { b = row >> 12; kk = row & 4095; } else { const int r2 = row - 16384; b = r2 >> 8; kk = 4096 + (r2 & 255); }
#pragma unroll
                for (int bj = 0; bj < 2; ++bj) { const int col = col0 + bj * HALF; const int head = col >> 7, d = col & 127;
                    const f32x4 v0 = acc[ai][bj][m][0] * rs, v1 = acc[ai][bj][m][1] * rs;
                    u32x4 w; w.x = cvt_pk_bf16(v0[0], v0[1]); w.y = cvt_pk_bf16(v0[2], v0[3]); w.z = cvt_pk_bf16(v1[0], v1[1]); w.w = cvt_pk_bf16(v1[2], v1[3]);
                    if (d < 64) { *(__attribute__((address_space(1))) u32x4*)(KM + ((size_t)((b * 4 + head) * 4352 + kk)) * 96 + d) = w; }
                    else { __attribute__((address_space(1))) bf16_t* vp = (__attribute__((address_space(1))) bf16_t*)(VT + ((size_t)((b * 4 + head) * 64 + (d - 64))) * 4352 + kk);
                        vp[0 * 4352] = (bf16_t)(w.x & 0xffffu); vp[1 * 4352] = (bf16_t)(w.x >> 16); vp[2 * 4352] = (bf16_t)(w.y & 0xffffu); vp[3 * 4352] = (bf16_t)(w.y >> 16);
                        vp[4 * 4352] = (bf16_t)(w.z & 0xffffu); vp[5 * 4352] = (bf16_t)(w.z >> 16); vp[6 * 4352] = (bf16_t)(w.w & 0xffffu); vp[7 * 4352] = (bf16_t)(w.w >> 16); } } }
    }
};
template <class Epi, class Sched, bool ALIGN_EPI = false, bool SP2 = false>
__device__ __forceinline__ void gemm_phase(PG8_LAS unsigned char* lds, const Gemm g, const Sched& S, const Epi& E, const int tid_in) {
    int tid_ = tid_in; asm volatile("" : "+v"(tid_));
    const int tid = tid_, wid = __builtin_amdgcn_readfirstlane(tid >> 6), lane = tid & 63, wr = wid >> 2, wc = wid & 3, fr = lane & 15, fq = lane >> 4;
    const int K = g.K, nt = K / BK;
    unsigned voffA, voffB;
    { int R, C; stage_rc(tid * 16, R, C); const int Rb = Epi::PERM ? ((R & ~31) + perm32(R & 31)) : R;
        voffA = (unsigned)(R * g.lda + C) * 2u; voffB = (unsigned)(Rb * g.ldb + C) * 2u; }
    const size_t pstepA = (size_t)64 * g.lda * 2, pstepB = (size_t)64 * g.ldb * 2;
    const size_t kstep = (size_t)(BK * 2);
    const size_t hstep = (size_t)HALF * g.ldb * 2;
    const size_t tstep = 2 * hstep; const size_t hstepA = (size_t)HALF * g.lda * 2, tstepA = 2 * hstepA;
    const unsigned ldsw = (unsigned)wid * 1024u;
    const int aoff = lds_byte(wr * 64 + fr, fq * 8), boff = lds_byte(wc * 32 + fr, fq * 8);
#define PG8_SA(b, h) (((b) * 2 + (h)) * HTB)
#define PG8_SB(b, h) ((4 + (b) * 2 + (h)) * HTB)
#define PG8_STAGE(bufoff, gbase, voff) do { _Pragma("unroll") for (int _i = 0; _i < 2; ++_i) \
        __builtin_amdgcn_global_load_lds((const unsigned*)((const char*)(gbase) + (size_t)_i * PG8_PSTEP_##voff + (voff)), (PG8_LAS unsigned*)(lds + (bufoff) + ldsw + _i * 8192), 16, 0, 0); } while (0)
#define PG8_PSTEP_voffA pstepA
#define PG8_PSTEP_voffB pstepB
#define PG8_LDA(dst, b, h) do { _Pragma("unroll") for (int m = 0; m < 4; ++m) _Pragma("unroll") for (int k = 0; k < 2; ++k) dst[m][k] = *(const PG8_LAS bf16x8*)(lds + PG8_SA(b, h) + aoff + m * 2048 + k * 1024); } while (0)
#define PG8_LDB(dst, b, h) do { _Pragma("unroll") for (int n = 0; n < 2; ++n) _Pragma("unroll") for (int k = 0; k < 2; ++k) dst[n][k] = *(const PG8_LAS bf16x8*)(lds + PG8_SB(b, h) + boff + n * 2048 + k * 1024); } while (0)
#define PG8_MMA(ai, bj, At, Bt) do { __builtin_amdgcn_s_setprio(1); _Pragma("unroll") for (int m = 0; m < 4; ++m) _Pragma("unroll") for (int n = 0; n < 2; ++n) _Pragma("unroll") for (int k = 0; k < 2; ++k) \
        acc[ai][bj][m][n] = __builtin_amdgcn_mfma_f32_16x16x32_bf16(Bt[n][k], At[m][k], acc[ai][bj][m][n], 0, 0, 0); __builtin_amdgcn_s_setprio(0); } while (0)
#define PG8_WAIT_V(n) asm volatile("s_waitcnt vmcnt(" #n ")" ::: "memory")
#define PG8_WAIT_L(n) asm volatile("s_waitcnt lgkmcnt(" #n ")" ::: "memory")
#define PG8_BAR __builtin_amdgcn_s_barrier()
#define PG8_SCHED __builtin_amdgcn_sched_barrier(0)
    Unit cur, nxt; int ui = 0;
    if (!S.next(0, cur)) return;
    f32x4 acc[2][2][4][2];
#pragma unroll
    for (int a = 0; a < 2; ++a)
#pragma unroll
        for (int b = 0; b < 2; ++b)
#pragma unroll
            for (int m = 0; m < 4; ++m)
#pragma unroll
                for (int n = 0; n < 2; ++n) acc[a][b][m][n] = (f32x4){0.f, 0.f, 0.f, 0.f};
    bf16x8 At[4][2], B0[2][2], B1[2][2];
    const char* cA = (const char*)g.A + (size_t)cur.pm * tstepA; const char* cB = (const char*)g.Bt + (size_t)cur.pn * tstep;
    S.a_ready(cur);
    if constexpr (SP2) {
        PG8_STAGE(PG8_SB(0, 0), cB, voffB); PG8_STAGE(PG8_SB(0, 1), cB + hstep, voffB); PG8_STAGE(PG8_SA(0, 0), cA, voffA); PG8_STAGE(PG8_SA(0, 1), cA + hstepA, voffA);
        if (wr == 1) PG8_BAR;
        PG8_WAIT_V(2); PG8_BAR;
        PG8_STAGE(PG8_SB(1, 0), cB + kstep, voffB); PG8_STAGE(PG8_SA(1, 0), cA + kstep, voffA); PG8_STAGE(PG8_SB(1, 1), cB + hstep + kstep, voffB);
        PG8_WAIT_V(6); PG8_BAR;
    } else {
        PG8_STAGE(PG8_SB(0, 0), cB, voffB); PG8_STAGE(PG8_SA(0, 0), cA, voffA); PG8_STAGE(PG8_SB(0, 1), cB + hstep, voffB); PG8_STAGE(PG8_SA(0, 1), cA + hstepA, voffA);
        if (wr == 1) PG8_BAR;
        PG8_WAIT_V(4); PG8_BAR;
        PG8_STAGE(PG8_SB(1, 0), cB + kstep, voffB); PG8_STAGE(PG8_SA(1, 0), cA + kstep, voffA); PG8_STAGE(PG8_SB(1, 1), cB + hstep + kstep, voffB);
        PG8_WAIT_V(6); PG8_BAR;
    }
    for (;;) {
        const bool has_next = S.next(ui + 1, nxt);
        const char* nA = has_next ? (const char*)g.A + (size_t)nxt.pm * tstepA : cA; const char* nB = has_next ? (const char*)g.Bt + (size_t)nxt.pn * tstep : cB;
        for (int t = 0; t < nt; t += 2) {
            const bool last = (t == nt - 2);
            const char* a1 = cA + (size_t)(t + 1) * kstep;
            const char* a2 = last ? nA : cA + (size_t)(t + 2) * kstep; const char* b2 = last ? nB : cB + (size_t)(t + 2) * kstep;
            const char* a3 = a2 + kstep; const char* b3 = b2 + kstep;
            if (last && has_next) S.a_ready(nxt);
            if constexpr (SP2) {
            PG8_LDB(B0, 0, 0); PG8_LDB(B1, 0, 1); PG8_SCHED; PG8_LDA(At, 0, 0); PG8_STAGE(PG8_SA(1, 1), a1 + hstepA, voffA);
            PG8_WAIT_V(8); PG8_WAIT_L(0); PG8_BAR; PG8_MMA(0, 0, At, B0); PG8_MMA(0, 1, At, B1); PG8_BAR; PG8_SCHED;
            PG8_LDA(At, 0, 1); PG8_STAGE(PG8_SB(0, 0), b2, voffB); PG8_STAGE(PG8_SB(0, 1), b2 + hstep, voffB); PG8_STAGE(PG8_SA(0, 0), a2, voffA);
            PG8_WAIT_V(8); PG8_WAIT_L(0); PG8_BAR; PG8_MMA(1, 0, At, B0); PG8_MMA(1, 1, At, B1); PG8_BAR; PG8_SCHED;
            PG8_LDB(B0, 1, 0); PG8_LDB(B1, 1, 1); PG8_SCHED; PG8_LDA(At, 1, 0); PG8_STAGE(PG8_SA(0, 1), a2 + hstepA, voffA);
            PG8_WAIT_V(8); PG8_WAIT_L(0); PG8_BAR; PG8_MMA(0, 0, At, B0); PG8_MMA(0, 1, At, B1); PG8_BAR; PG8_SCHED;
            PG8_LDA(At, 1, 1); PG8_STAGE(PG8_SB(1, 0), b3, voffB); PG8_STAGE(PG8_SB(1, 1), b3 + hstep, voffB); PG8_STAGE(PG8_SA(1, 0), a3, voffA);
            PG8_WAIT_V(8); PG8_WAIT_L(0); PG8_BAR; PG8_MMA(1, 0, At, B0); PG8_MMA(1, 1, At, B1); PG8_BAR; PG8_SCHED;
            } else {
            PG8_LDB(B0, 0, 0); PG8_SCHED; PG8_LDA(At, 0, 0); PG8_STAGE(PG8_SA(1, 1), a1 + hstepA, voffA);
            PG8_WAIT_L(8); PG8_BAR; PG8_WAIT_L(0); PG8_MMA(0, 0, At, B0); PG8_BAR; PG8_SCHED;
            PG8_LDB(B1, 0, 1); PG8_STAGE(PG8_SB(0, 0), b2, voffB);
            PG8_BAR; PG8_WAIT_L(0); PG8_MMA(0, 1, At, B1); PG8_BAR;
            PG8_LDA(At, 0, 1); PG8_STAGE(PG8_SA(0, 0), a2, voffA);
            PG8_BAR; PG8_WAIT_L(0); PG8_MMA(1, 0, At, B0); PG8_BAR; PG8_SCHED;
            PG8_STAGE(PG8_SB(0, 1), b2 + hstep, voffB);
            PG8_WAIT_V(6); PG8_BAR; PG8_MMA(1, 1, At, B1); PG8_BAR;
            PG8_LDB(B0, 1, 0); PG8_SCHED; PG8_LDA(At, 1, 0); PG8_STAGE(PG8_SA(0, 1), a2 + hstepA, voffA);
            PG8_WAIT_L(8); PG8_BAR; PG8_WAIT_L(0); PG8_MMA(0, 0, At, B0); PG8_BAR; PG8_SCHED;
            PG8_LDB(B1, 1, 1); PG8_STAGE(PG8_SB(1, 0), b3, voffB);
            PG8_BAR; PG8_WAIT_L(0); PG8_MMA(0, 1, At, B1); PG8_BAR;
            PG8_LDA(At, 1, 1); PG8_STAGE(PG8_SA(1, 0), a3, voffA);
            PG8_BAR; PG8_WAIT_L(0); PG8_MMA(1, 0, At, B0); PG8_BAR; PG8_SCHED;
            PG8_STAGE(PG8_SB(1, 1), b3 + hstep, voffB);
            PG8_WAIT_V(6); PG8_BAR; PG8_MMA(1, 1, At, B1); PG8_BAR;
            }
        }
        if constexpr (ALIGN_EPI) { if (wr == 0) PG8_BAR; }
        if constexpr (!Epi::AFTER_DRAIN) { E(acc, cur, wr, wc, fr, fq); S.done(cur); }
        if (!has_next) break;
#pragma unroll
        for (int a = 0; a < 2; ++a)
#pragma unroll
            for (int b = 0; b < 2; ++b)
#pragma unroll
                for (int m = 0; m < 4; ++m)
#pragma unroll
                    for (int n = 0; n < 2; ++n) acc[a][b][m][n] = (f32x4){0.f, 0.f, 0.f, 0.f};
        cur = nxt; cA = nA; cB = nB; ++ui;
        if constexpr (ALIGN_EPI) { if (wr == 1) PG8_BAR; }
    }
    PG8_WAIT_V(0);
    if constexpr (!ALIGN_EPI) { if (wr == 0) PG8_BAR; }
    PG8_BAR;
    if constexpr (Epi::AFTER_DRAIN) { E.fused(acc, cur, wr, wc, fr, fq, lds, wid, lane); S.done(cur); }
#undef PG8_SA
#undef PG8_SB
#undef PG8_STAGE
#undef PG8_LDA
#undef PG8_LDB
#undef PG8_MMA
#undef PG8_WAIT_V
#undef PG8_WAIT_L
#undef PG8_BAR
#undef PG8_SCHED
}
}

__device__ const float ROPE_TAB[1024] = {
1.000000000e+00f,0.000000000e+00f,1.000000000e+00f,0.000000000e+00f,1.000000000e+00f,0.000000000e+00f,1.000000000e+00f,0.000000000e+00f,
1.000000000e+00f,0.000000000e+00f,1.000000000e+00f,0.000000000e+00f,1.000000000e+00f,0.000000000e+00f,1.000000000e+00f,0.000000000e+00f,
5.403022766e-01f,8.414709568e-01f,9.504152536e-01f,3.109835982e-01f,9.950041771e-01f,9.983342141e-02f,9.995000362e-01f,3.161750361e-02f,
9.999499917e-01f,9.999833070e-03f,9.999949932e-01f,3.162272274e-03f,9.999995232e-01f,9.999999311e-04f,9.999999404e-01f,3.162277571e-04f,
-4.161468446e-01f,9.092974067e-01f,8.065783978e-01f,5.911270976e-01f,9.800665975e-01f,1.986693293e-01f,9.980006814e-01f,6.320339441e-02f,
9.998000264e-01f,1.999866590e-02f,9.999799728e-01f,6.324512884e-03f,9.999979734e-01f,1.999998698e-03f,9.999998212e-01f,6.324554561e-04f,
-9.899924994e-01f,1.411200017e-01f,5.827536583e-01f,8.126488924e-01f,9.553365111e-01f,2.955202162e-01f,9.955033660e-01f,9.472608566e-02f,
9.995500445e-01f,2.999549918e-02f,9.999549985e-01f,9.486690164e-03f,9.999955297e-01f,2.999995602e-03f,9.999995232e-01f,9.486831259e-04f,
-6.536436081e-01f,-7.568024993e-01f,3.011374772e-01f,9.535807371e-01f,9.210609794e-01f,3.894183338e-01f,9.920106530e-01f,1.261540651e-01f,
9.992001057e-01f,3.998933360e-02f,9.999200106e-01f,1.264877338e-02f,9.999920130e-01f,3.999989480e-03f,9.999992251e-01f,1.264910679e-03f,
2.836622000e-01f,-9.589242935e-01f,-1.034233812e-02f,9.999465346e-01f,8.775825500e-01f,4.794255495e-01f,9.875259995e-01f,1.574558765e-01f,
9.987502694e-01f,4.997916520e-02f,9.998750091e-01f,1.581072807e-02f,9.999874830e-01f,4.999979399e-03f,9.999987483e-01f,1.581138116e-03f,
9.601702690e-01f,-2.794154882e-01f,-3.207964003e-01f,9.471482038e-01f,8.253356218e-01f,5.646424890e-01f,9.820539355e-01f,1.886002719e-01f,
9.982005358e-01f,5.996400490e-02f,9.998199940e-01f,1.897252724e-02f,9.999819994e-01f,5.999964196e-03f,9.999982119e-01f,1.897365320e-03f,
7.539022565e-01f,6.569865942e-01f,-5.994374752e-01f,8.004215956e-01f,7.648422122e-01f,6.442176700e-01f,9.755998850e-01f,2.195560932e-01f,
9.975510240e-01f,6.994284689e-02f,9.997550249e-01f,2.213413455e-02f,9.999755025e-01f,6.999942940e-03f,9.999975562e-01f,2.213592408e-03f,
-1.455000341e-01f,9.893582463e-01f,-8.186324239e-01f,5.743177533e-01f,6.967067122e-01f,7.173560858e-01f,9.681702852e-01f,2.502923310e-01f,
9.968017340e-01f,7.991468906e-02f,9.996800423e-01f,2.529552206e-02f,9.999679923e-01f,7.999914698e-03f,9.999967813e-01f,2.529819263e-03f,
-9.111302495e-01f,4.121184945e-01f,-9.566441774e-01f,2.912592292e-01f,6.216099262e-01f,7.833269238e-01f,9.597726464e-01f,2.807783186e-01f,
9.959527254e-01f,8.987854421e-02f,9.995950460e-01f,2.845665626e-02f,9.999595284e-01f,8.999879472e-03f,9.999959469e-01f,2.846045885e-03f,
-8.390715122e-01f,-5.440211296e-01f,-9.997860789e-01f,-2.068356983e-02f,5.403022766e-01f,8.414709568e-01f,9.504153132e-01f,3.109835684e-01f,
9.950041771e-01f,9.983341396e-02f,9.995000362e-01f,3.161750361e-02f,9.999499917e-01f,9.999834001e-03f,9.999949932e-01f,3.162272274e-03f,
4.425697960e-03f,-9.999902248e-01f,-9.437797666e-01f,-3.305749595e-01f,4.535960853e-01f,8.912073970e-01f,9.401075840e-01f,3.408778608e-01f,
9.939560890e-01f,1.097782999e-01f,9.993950725e-01f,3.477803990e-02f,9.999395013e-01f,1.099977922e-02f,9.999939203e-01f,3.478498431e-03f,
8.438539505e-01f,-5.365729332e-01f,-7.941793799e-01f,-6.076834202e-01f,3.623577058e-01f,9.320390821e-01f,9.288598895e-01f,3.704313040e-01f,
9.928086400e-01f,1.197122037e-01f,9.992800951e-01f,3.793822229e-02f,9.999279976e-01f,1.199971233e-02f,9.999927878e-01f,3.794723889e-03f,
9.074468017e-01f,4.201670289e-01f,-5.658205152e-01f,-8.245284557e-01f,2.674987614e-01f,9.635581970e-01f,9.166833758e-01f,3.996143043e-01f,
9.915618896e-01f,1.296341419e-01f,9.991551042e-01f,4.109803215e-02f,9.999154806e-01f,1.299963426e-02f,9.999915361e-01f,4.110949114e-03f,
1.367372125e-01f,9.906073809e-01f,-2.813494802e-01f,-9.596053958e-01f,1.699671596e-01f,9.854497313e-01f,9.035902619e-01f,4.283977747e-01f,
9.902160168e-01f,1.395431161e-01f,9.990201592e-01f,4.425742477e-02f,9.999020100e-01f,1.399954315e-02f,9.999902248e-01f,4.427174106e-03f,
-7.596879005e-01f,6.502878666e-01f,3.102235124e-02f,-9.995186925e-01f,7.073719800e-02f,9.974949956e-01f,8.895936012e-01f,4.567528665e-01f,
9.887710810e-01f,1.494381279e-01f,9.988752007e-01f,4.741638154e-02f,9.998875260e-01f,1.499943808e-02f,9.999887347e-01f,4.743398633e-03f,
-9.576594830e-01f,-2.879033089e-01f,3.403181732e-01f,-9.403103590e-01f,-2.919954620e-02f,9.995735884e-01f,8.747074604e-01f,4.846512377e-01f,
9.872272611e-01f,1.593182087e-01f,9.987202883e-01f,5.057485774e-02f,9.998720288e-01f,1.599931903e-02f,9.999871850e-01f,5.059622694e-03f,
-2.751633525e-01f,-9.613974690e-01f,6.158648133e-01f,-7.878518701e-01f,-1.288445443e-01f,9.916648269e-01f,8.589466810e-01f,5.120649934e-01f,
9.855847955e-01f,1.691823453e-01f,9.985553622e-01f,5.373282731e-02f,9.998555183e-01f,1.699918136e-02f,9.999855757e-01f,5.375845823e-03f,
6.603167057e-01f,-7.509872317e-01f,8.303361535e-01f,-5.572628975e-01f,-2.272021621e-01f,9.738476276e-01f,8.423270583e-01f,5.389667153e-01f,
9.838436842e-01f,1.790295690e-01f,9.983804226e-01f,5.689026415e-02f,9.998379946e-01f,1.799902879e-02f,9.999837875e-01f,5.692068953e-03f,
9.887046218e-01f,1.498772055e-01f,9.624637961e-01f,-2.714101076e-01f,-3.232895434e-01f,9.463000894e-01f,8.248651624e-01f,5.653295517e-01f,
9.820042253e-01f,1.888588965e-01f,9.981955290e-01f,6.004713103e-02f,9.998195171e-01f,1.899885759e-02f,9.999819398e-01f,6.008291151e-03f,
4.080820680e-01f,9.129452705e-01f,9.991443753e-01f,4.135828838e-02f,-4.161468446e-01f,9.092974067e-01f,8.065784574e-01f,5.911270380e-01f,
9.800665975e-01f,1.986693144e-01f,9.980006814e-01f,6.320339441e-02f,9.998000264e-01f,1.999866776e-02f,9.999799728e-01f,6.324512884e-03f,
-5.477292538e-01f,8.366556168e-01f,9.367404580e-01f,3.500247598e-01f,-5.048462152e-01f,8.632093072e-01f,7.874851823e-01f,6.163335443e-01f,
9.780309200e-01f,2.084598988e-01f,9.977958202e-01f,6.635902822e-02f,9.997795224e-01f,2.099845745e-02f,9.999779463e-01f,6.640734151e-03f,
-9.999608397e-01f,-8.851309307e-03f,7.814403772e-01f,6.239799261e-01f,-5.885011554e-01f,8.084963560e-01f,7.676045895e-01f,6.409237385e-01f,
9.758974314e-01f,2.182296216e-01f,9.975810051e-01f,6.951400638e-02f,9.997580051e-01f,2.199822664e-02f,9.999758005e-01f,6.956954487e-03f,
-5.328330398e-01f,-8.462204337e-01f,5.486452579e-01f,8.360552788e-01f,-6.662759781e-01f,7.457052469e-01f,7.469564080e-01f,6.648730636e-01f,
9.736663699e-01f,2.279775143e-01f,9.973561764e-01f,7.266827673e-02f,9.997355342e-01f,2.299797349e-02f,9.999735355e-01f,7.273174357e-03f,
4.241790175e-01f,-9.055783749e-01f,2.614416778e-01f,9.652192593e-01f,-7.373937964e-01f,6.754631400e-01f,7.255613208e-01f,6.881574988e-01f,
9.713379741e-01f,2.377026230e-01f,9.971213937e-01f,7.582182437e-02f,9.997119904e-01f,2.399769612e-02f,9.999712110e-01f,7.589393295e-03f,
9.912028313e-01f,-1.323517561e-01f,-5.168933049e-02f,9.986631870e-01f,-8.011435866e-01f,5.984721184e-01f,7.034407258e-01f,7.107539177e-01f,
9.689124227e-01f,2.474039644e-01f,9.968766570e-01f,7.897461206e-02f,9.996874928e-01f,2.499739639e-02f,9.999687672e-01f,7.905611768e-03f,
6.469193101e-01f,7.625584602e-01f,-3.596943319e-01f,9.330701828e-01f,-8.568888307e-01f,5.155012608e-01f,6.806167960e-01f,7.326396108e-01f,
9.663899541e-01f,2.570805550e-01f,9.966219068e-01f,8.212661743e-02f,9.996620417e-01f,2.599707060e-02f,9.999662042e-01f,8.221829310e-03f,
-2.921388149e-01f,9.563759565e-01f,-6.320286393e-01f,7.749450207e-01f,-9.040721655e-01f,4.273798466e-01f,6.571123004e-01f,7.537927032e-01f,
9.637709260e-01f,2.667314112e-01f,9.963572025e-01f,8.527779579e-02f,9.996355176e-01f,2.699672058e-02f,9.999635220e-01f,8.538045920e-03f,
-9.626058936e-01f,2.709057927e-01f,-8.416849375e-01f,5.399689674e-01f,-9.422222972e-01f,3.349882066e-01f,6.329506636e-01f,7.741920948e-01f,
9.610554576e-01f,2.763556540e-01f,9.960825443e-01f,8.842811733e-02f,9.996080399e-01f,2.799634263e-02f,9.999607801e-01f,8.854261599e-03f,
-7.480575442e-01f,-6.636338830e-01f,-9.678714871e-01f,2.514453232e-01f,-9.709581733e-01f,2.392492294e-01f,6.081562042e-01f,7.938174009e-01f,
9.582439065e-01f,2.859522104e-01f,9.957979321e-01f,9.157756716e-02f,9.995795488e-01f,2.899593674e-02f,9.999579787e-01f,9.170476347e-03f,
1.542514563e-01f,-9.880316257e-01f,-9.980752468e-01f,-6.201484054e-02f,-9.899924994e-01f,1.411200017e-01f,5.827536583e-01f,8.126488924e-01f,
9.553365111e-01f,2.955201864e-01f,9.955033660e-01f,9.472609311e-02f,9.995500445e-01f,2.999550104e-02f,9.999549985e-01f,9.486690164e-03f,
9.147423506e-01f,-4.040376544e-01f,-9.293003082e-01f,-3.693250120e-01f,-9.991351366e-01f,4.158052057e-02f,5.567683578e-01f,8.306677938e-01f,
9.523335695e-01f,3.050586283e-01f,9.951988459e-01f,9.787366539e-02f,9.995195270e-01f,3.099503554e-02f,9.999519587e-01f,9.802903049e-03f,
8.342233896e-01f,5.514267087e-01f,-7.683671117e-01f,-6.400094032e-01f,-9.982947707e-01f,-5.837419257e-02f,5.302263498e-01f,8.478561044e-01f,
9.492354393e-01f,3.145665526e-01f,9.948843718e-01f,1.010202691e-01f,9.994880557e-01f,3.199454024e-02f,9.999487996e-01f,1.011911593e-02f,
-1.327674743e-02f,9.999118447e-01f,-5.312352777e-01f,-8.472243547e-01f,-9.874798059e-01f,-1.577456445e-01f,5.031541586e-01f,8.641966581e-01f,
9.460423589e-01f,3.240430057e-01f,9.945599437e-01f,1.041658595e-01f,9.994555712e-01f,3.299400955e-02f,9.999455214e-01f,1.043532696e-02f,
-8.485702872e-01f,5.290827155e-01f,-2.414211184e-01f,-9.704204202e-01f,-9.667981863e-01f,-2.555412054e-01f,4.755789042e-01f,8.796730638e-01f,
9.427546859e-01f,3.334870934e-01f,9.942255616e-01f,1.073104069e-01f,9.994220734e-01f,3.399345279e-02f,9.999421835e-01f,1.075153705e-02f,
-9.036921859e-01f,-4.281826615e-01f,7.233466953e-02f,-9.973804355e-01f,-9.364566803e-01f,-3.507832289e-01f,4.475280643e-01f,8.942698836e-01f,
9.393727183e-01f,3.428978026e-01f,9.938812256e-01f,1.104538813e-01f,9.993875623e-01f,3.499285504e-02f,9.999387264e-01f,1.106774528e-02f,
-1.279636919e-01f,-9.917788506e-01f,3.789161742e-01f,-9.254310131e-01f,-8.967583776e-01f,-4.425205588e-01f,4.190297425e-01f,9.079725146e-01f,
9.358968139e-01f,3.522742093e-01f,9.935269952e-01f,1.135962531e-01f,9.993520975e-01f,3.599222749e-02f,9.999352098e-01f,1.138395350e-02f,
7.654140592e-01f,-6.435381174e-01f,6.479216814e-01f,-7.617069483e-01f,-8.481000066e-01f,-5.298361778e-01f,3.901124299e-01f,9.207672477e-01f,
9.323273301e-01f,3.616154492e-01f,9.931628108e-01f,1.167374924e-01f,9.993155599e-01f,3.699155897e-02f,9.999315739e-01f,1.170015987e-02f,
9.550736547e-01f,2.963685691e-01f,8.526731133e-01f,-5.224447846e-01f,-7.909677625e-01f,-6.118578315e-01f,3.608050346e-01f,9.326412678e-01f,
9.286646247e-01f,3.709204793e-01f,9.927886724e-01f,1.198775545e-01f,9.992780685e-01f,3.799085692e-02f,9.999278188e-01f,1.201636530e-02f,
2.666429281e-01f,9.637953639e-01f,9.728653431e-01f,-2.313720137e-01f,-7.259322405e-01f,-6.877662539e-01f,3.311368525e-01f,9.435827136e-01f,
9.249090552e-01f,3.801884055e-01f,9.924046397e-01f,1.230164245e-01f,9.992396235e-01f,3.899011388e-02f,9.999239445e-01f,1.233256981e-02f,
-6.669380665e-01f,7.451131344e-01f,9.965789914e-01f,8.264580369e-02f,-6.536436081e-01f,-7.568024993e-01f,3.011375964e-01f,9.535806775e-01f,
9.210609794e-01f,3.894183338e-01f,9.920106530e-01f,1.261540651e-01f,9.992001057e-01f,3.998933733e-02f,9.999200106e-01f,1.264877338e-02f,
-9.873392582e-01f,-1.586226672e-01f,9.214623570e-01f,3.884676993e-01f,-5.748240352e-01f,-8.182770610e-01f,2.708370686e-01f,9.626252055e-01f,
9.171208143e-01f,3.986093104e-01f,9.916067719e-01f,1.292904317e-01f,9.991596341e-01f,4.098851606e-02f,9.999159575e-01f,1.296497509e-02f,
-3.999853134e-01f,-9.165215492e-01f,7.549653649e-01f,6.557646990e-01f,-4.902605712e-01f,-8.715758920e-01f,2.402658761e-01f,9.707071185e-01f,
9.130889177e-01f,4.077604413e-01f,9.911929369e-01f,1.324255317e-01f,9.991181493e-01f,4.198765755e-02f,9.999117851e-01f,1.328117587e-02f,
5.551133156e-01f,-8.317747712e-01f,5.135984421e-01f,8.580306768e-01f,-4.007990062e-01f,-9.161660075e-01f,2.094544172e-01f,9.778184295e-01f,
9.089657664e-01f,4.168707728e-01f,9.907692075e-01f,1.355592906e-01f,9.990756512e-01f,4.298675060e-02f,9.999075532e-01f,1.359737478e-02f,
9.998432994e-01f,1.770192571e-02f,2.212981731e-01f,9.752061963e-01f,-3.073327839e-01f,-9.516021013e-01f,1.784335226e-01f,9.839519858e-01f,
9.047516584e-01f,4.259394705e-01f,9.903355837e-01f,1.386916935e-01f,9.990321398e-01f,4.398580641e-02f,9.999032021e-01f,1.391357277e-02f,
5.253219604e-01f,8.509035110e-01f,-9.294810891e-02f,9.956709743e-01f,-2.107958049e-01f,-9.775301218e-01f,1.472342163e-01f,9.891016483e-01f,
9.004471302e-01f,4.349655211e-01f,9.898920655e-01f,1.418227106e-01f,9.989876747e-01f,4.498481750e-02f,9.998987317e-01f,1.422976889e-02f,
-4.321779311e-01f,9.017883539e-01f,-3.979767561e-01f,9.173954725e-01f,-1.121526212e-01f,-9.936909676e-01f,1.158876941e-01f,9.932623506e-01f,
8.960524797e-01f,4.439480901e-01f,9.894386530e-01f,1.449523121e-01f,9.989421964e-01f,4.598378390e-02f,9.998942018e-01f,1.454596408e-02f,
-9.923354983e-01f,1.235731244e-01f,-6.635382771e-01f,7.481423616e-01f,-1.238837745e-02f,-9.999232888e-01f,8.442528546e-02f,9.964298010e-01f,
8.915683031e-01f,4.528862834e-01f,9.889753461e-01f,1.480804533e-01f,9.988957047e-01f,4.698270187e-02f,9.998895526e-01f,1.486215740e-02f,
-6.401443481e-01f,-7.682546377e-01f,-8.632965088e-01f,5.046970844e-01f,8.749917150e-02f,-9.961646199e-01f,5.287845805e-02f,9.986009598e-01f,
8.869948983e-01f,4.617791772e-01f,9.885020852e-01f,1.512071192e-01f,9.988481998e-01f,4.798157141e-02f,9.998847842e-01f,1.517834887e-02f,
3.005925417e-01f,-9.537526369e-01f,-9.774427414e-01f,2.112006545e-01f,1.865124702e-01f,-9.824525714e-01f,2.127875760e-02f,9.997735620e-01f,
8.823328614e-01f,4.706258774e-01f,9.880189896e-01f,1.543322802e-01f,9.987997413e-01f,4.898039624e-02f,9.998799562e-01f,1.549453940e-02f,
9.649659991e-01f,-2.623748481e-01f,-9.946564436e-01f,-1.032404602e-01f,2.836622000e-01f,-9.589242935e-01f,-1.034221891e-02f,9.999465346e-01f,
8.775825500e-01f,4.794255495e-01f,9.875259995e-01f,1.574558914e-01f,9.987502694e-01f,4.997916892e-02f,9.998750091e-01f,1.581072807e-02f,
7.421541810e-01f,6.702291965e-01f,-9.132301211e-01f,-4.074441493e-01f,3.779776692e-01f,-9.258147478e-01f,-4.195285589e-02f,9.991195798e-01f,
8.727445006e-01f,4.881772399e-01f,9.870231748e-01f,1.605779380e-01f,9.986997843e-01f,5.097789690e-02f,9.998699427e-01f,1.612691768e-02f,
-1.629907787e-01f,9.866275787e-01f,-7.412399650e-01f,-6.712401509e-01f,4.685169160e-01f,-8.834545016e-01f,-7.352153957e-02f,9.972936511e-01f,
8.678191900e-01f,4.968801141e-01f,9.865104556e-01f,1.636983752e-01f,9.986482859e-01f,5.197656900e-02f,9.998648167e-01f,1.644310169e-02f,
-9.182828069e-01f,3.959251642e-01f,-4.957418144e-01f,-8.684699535e-01f,5.543745160e-01f,-8.322673440e-01f,-1.050167084e-01f,9.944704771e-01f,
8.628070951e-01f,5.055333376e-01f,9.859878421e-01f,1.668171734e-01f,9.985958338e-01f,5.297519267e-02f,9.998595715e-01f,1.675928757e-02f,
-8.293098211e-01f,-5.587890744e-01f,-2.010796219e-01f,-9.795749187e-01f,6.346929669e-01f,-7.727644444e-01f,-1.364068687e-01f,9.906529188e-01f,
8.577086926e-01f,5.141359568e-01f,9.854553938e-01f,1.699342877e-01f,9.985423684e-01f,5.397376046e-02f,9.998542070e-01f,1.707546785e-02f,
2.212675661e-02f,-9.997551441e-01f,1.135217771e-01f,-9.935355186e-01f,7.086697817e-01f,-7.055402994e-01f,-1.676606387e-01f,9.858447909e-01f,
8.525245190e-01f,5.226872563e-01f,9.849131107e-01f,1.730497181e-01f,9.984878898e-01f,5.497227982e-02f,9.998487830e-01f,1.739165001e-02f,
8.532201052e-01f,-5.215510130e-01f,4.168670774e-01f,-9.089674354e-01f,7.755658031e-01f,-6.312667131e-01f,-1.987468749e-01f,9.800508618e-01f,
8.472551107e-01f,5.311862230e-01f,9.843609333e-01f,1.761634201e-01f,9.984323978e-01f,5.597073585e-02f,9.998431802e-01f,1.770782843e-02f,
8.998668194e-01f,4.361647666e-01f,6.788702011e-01f,-7.342582941e-01f,8.347129226e-01f,-5.506852865e-01f,-2.296342701e-01f,9.732769728e-01f,
8.419010043e-01f,5.396320224e-01f,9.837989211e-01f,1.792753637e-01f,9.983759522e-01f,5.696914345e-02f,9.998375773e-01f,1.802400686e-02f,
1.191801354e-01f,9.928726554e-01f,8.735505342e-01f,-4.867334962e-01f,8.855196238e-01f,-4.646020234e-01f,-2.602920532e-01f,9.655299187e-01f,
8.364626765e-01f,5.480239391e-01f,9.832270741e-01f,1.823855042e-01f,9.983184934e-01f,5.796748772e-02f,9.998317957e-01f,1.834018156e-02f,
-7.710801959e-01f,6.367380023e-01f,9.816020727e-01f,-1.909380108e-01f,9.274784923e-01f,-3.738765717e-01f,-2.906895578e-01f,9.568174481e-01f,
8.309407234e-01f,5.563610196e-01f,9.826454520e-01f,1.854938269e-01f,9.982600212e-01f,5.896577984e-02f,9.998259544e-01f,1.865635626e-02f,
-9.524129629e-01f,-3.048106134e-01f,9.923083186e-01f,1.237909496e-01f,9.601702690e-01f,-2.794154882e-01f,-3.207964003e-01f,9.471482038e-01f,
8.253356218e-01f,5.646424294e-01f,9.820539355e-01f,1.886002868e-01f,9.982005358e-01f,5.996400863e-02f,9.998199940e-01f,1.897252724e-02f,
-2.581016421e-01f,-9.661177993e-01f,9.046075940e-01f,4.262454212e-01f,9.832684398e-01f,-1.821625978e-01f,-3.505824506e-01f,9.365318418e-01f,
8.196480274e-01f,5.728674531e-01f,9.814526439e-01f,1.917048544e-01f,9.981400967e-01f,6.096218154e-02f,9.998139739e-01f,1.928869821e-02f,
6.735071540e-01f,-7.391806841e-01f,7.271980643e-01f,6.864276528e-01f,9.965420961e-01f,-8.308912069e-02f,-3.800179660e-01f,9.249790907e-01f,
8.138784766e-01f,5.810351372e-01f,9.808415174e-01f,1.948075294e-01f,9.980786443e-01f,6.196028739e-02f,9.998078346e-01f,1.960486546e-02f,
9.858965874e-01f,1.673557013e-01f,4.776714444e-01f,8.785385489e-01f,9.998586178e-01f,1.681409031e-02f,-4.090735018e-01f,9.125014544e-01f,
8.080275059e-01f,5.891447663e-01f,9.802205563e-01f,1.979082376e-01f,9.980161786e-01f,6.295833737e-02f,9.998015761e-01f,1.992103085e-02f,
};

#define GAS __attribute__((address_space(1)))
#define LAS __attribute__((address_space(3)))
typedef unsigned short bf16;
template <class T> __device__ __forceinline__ GAS T* gp(T* p) { return (GAS T*)p; }
template <class T> __device__ __forceinline__ const GAS T* gp(const T* p) { return (const GAS T*)p; }
typedef unsigned v4u __attribute__((ext_vector_type(4)));
typedef float f32x4 __attribute__((ext_vector_type(4)));
typedef short bf16x8 __attribute__((ext_vector_type(8)));
typedef GAS unsigned gu32;
typedef GAS unsigned long long gu64;
#define RLX_AGENT __ATOMIC_RELAXED, __HIP_MEMORY_SCOPE_AGENT
#define LDS_WAIT() asm volatile("s_waitcnt lgkmcnt(0)" ::: "memory")
#define VM_WAIT() asm volatile("s_waitcnt vmcnt(0)" ::: "memory")
__device__ __forceinline__ unsigned long long rt() { return __builtin_amdgcn_s_memrealtime(); }
__device__ __forceinline__ unsigned f2bf(float f) { unsigned u = __builtin_bit_cast(unsigned, f); return (u + 0x7fffu + ((u >> 16) & 1u)) >> 16; }
__device__ __forceinline__ unsigned pk2(float lo, float hi) { return f2bf(lo) | (f2bf(hi) << 16); }

#define XB_TMO      128
#define XB_XCNT(j)  (256  + 64 * (j))
#define XB_XSUB(j)  (1280 + 64 * (j))
#define XB_XGEN(j)  (2304 + 64 * (j))
#define XB_TOP      3328
#define XB_TOPGEN   3392
#define XCD_BAR_WORDS 3456
#define XB_SPIN_CAP (1u << 18)

__device__ __forceinline__ unsigned xb_ld(unsigned* p)              { return __hip_atomic_load(p, __ATOMIC_RELAXED, __HIP_MEMORY_SCOPE_AGENT); }
__device__ __forceinline__ unsigned xb_add(unsigned* p, unsigned v) { return __hip_atomic_fetch_add(p, v, __ATOMIC_RELAXED, __HIP_MEMORY_SCOPE_AGENT); }
__device__ __forceinline__ unsigned xb_xcc_id() { return (unsigned)__builtin_amdgcn_s_getreg((3 << 11) | 20) & 0xFu; }
#define XB_SPIN(cond, bar) do { unsigned _sp = 0; while (cond) { __builtin_amdgcn_s_sleep(1); \
    if ((++_sp & 255u) == 0u) { if (xb_ld(&(bar)[XB_TMO])) break; if (_sp > XB_SPIN_CAP) { atomicAdd(&(bar)[XB_TMO], 1u); break; } } } } while (0)

struct XcdBarrier {
    unsigned* bar; unsigned x; unsigned w0;
    volatile LAS unsigned* st;
};

__device__ __forceinline__ XcdBarrier xcd_barrier_post(unsigned* bar, volatile LAS unsigned* st) {
    XcdBarrier b; b.bar = bar; b.x = xb_xcc_id(); b.st = st;
    if (threadIdx.x == 0) (void)xb_add(&bar[XB_XCNT(b.x)], 1u);
    return b;
}
__device__ __forceinline__ void xcd_barrier_complete(unsigned* bar, unsigned x, unsigned& nloc, unsigned& nx) {
    const unsigned G = gridDim.x * gridDim.y * gridDim.z;
    unsigned sum, cnt, mine, sp = 0u;
    for (;;) {
        sum = 0u; cnt = 0u; mine = 0u;
#pragma unroll
        for (unsigned j = 0; j < 16; ++j) { const unsigned c = xb_ld(&bar[XB_XCNT(j)]); sum += c; cnt += (c > 0u) ? 1u : 0u; mine = (j == x) ? c : mine; }
        if (sum == G) break;
        __builtin_amdgcn_s_sleep(1);
        if ((++sp & 255u) == 0u) { if (xb_ld(&bar[XB_TMO])) break; if (sp > XB_SPIN_CAP) { atomicAdd(&bar[XB_TMO], 1u); break; } }
    }
    nloc = mine > 0u ? mine : 1u; nx = cnt > 0u ? cnt : 1u;
}

__device__ __forceinline__ void xcd_barrier(const XcdBarrier& b) {
    asm volatile("s_waitcnt vmcnt(0)" ::: "memory");
    __syncthreads();
    unsigned zb_ = 0u; asm volatile("" : "+v"(zb_));
    if (b.w0 && __builtin_amdgcn_mbcnt_hi(~0u, __builtin_amdgcn_mbcnt_lo(~0u, zb_)) == 0u) {
        unsigned* bar = b.bar; unsigned bx_ = b.x; asm volatile("" : "+s"(bar));
        __builtin_amdgcn_s_waitcnt(0);
        unsigned nloc = b.st[0], nx = b.st[1];
        if (nloc == 0u) { xcd_barrier_complete(bar, bx_, nloc, nx); b.st[0] = nloc; b.st[1] = nx; }
        const unsigned old = xb_add(&bar[XB_XSUB(bx_)], 1u);
        const unsigned gen = old / nloc;
        if (old + 1u == (gen + 1u) * nloc) {
            __builtin_amdgcn_fence(__ATOMIC_RELEASE, "agent");
            asm volatile("s_waitcnt vmcnt(0)" ::: "memory");
            const unsigned og = xb_add(&bar[XB_TOP], 1u);
            const unsigned tg = og / nx;
            if (og + 1u == (tg + 1u) * nx) xb_add(&bar[XB_TOPGEN], 1u);
            else XB_SPIN(xb_ld(&bar[XB_TOPGEN]) == tg, bar);
            __builtin_amdgcn_fence(__ATOMIC_ACQUIRE, "agent");
            xb_add(&bar[XB_XGEN(bx_)], 1u);
            asm volatile("s_waitcnt vmcnt(0)" ::: "memory");
        } else {
            XB_SPIN(xb_ld(&bar[XB_XGEN(bx_)]) == gen, bar);
            __builtin_amdgcn_fence(__ATOMIC_ACQUIRE, "agent");
            asm volatile("s_waitcnt vmcnt(0)" ::: "memory");
        }
    }
    __syncthreads();
}

constexpr int NLAT = 16384, NCTXR = 1024, MALL = 17408, DM = 1024, PIN = 2464, PINP = 2560, FF = 4096, KEYS = 4352;
constexpr float EPS = 1e-6f, LOG2E = 1.4426950408889634f;
constexpr float QSCALE = 0.10206207261596575f * 1.4426950408889634f;
constexpr float NA_C2 = 0.125f * 1.4426950408889634f;
constexpr int NWAVES = 8;
constexpr size_t MiB = 1u << 20;
constexpr size_t WS_CTL = 0, CTL_ZERO_BYTES = 64 * 1024;
constexpr size_t WS_MOD = 1 * MiB, WS_RSQ = 1 * MiB + 256 * 1024, WS_RSKV = 1 * MiB + 384 * 1024;
constexpr size_t WS_WIN = 2 * MiB, WS_WOUT = 7 * MiB, WS_W1 = 9 * MiB, WS_W2 = 17 * MiB, WS_WUQ = 25 * MiB, WS_WUKV = 25 * MiB + 256 * 1024, WS_WPW = 25 * MiB + 512 * 1024;
constexpr size_t WS_R0C = 26 * MiB, WS_R1 = 30 * MiB, WS_U = 98 * MiB, WS_Y = 183 * MiB, WS_QM = 217 * MiB, WS_A1 = 98 * MiB, WS_KM = 234 * MiB, WS_VTM = WS_KM + (size_t)16 * 4352 * 96 * 2;
constexpr size_t WS_NVT = WS_R1, WS_SCF = WS_R1 + 16 * MiB;
static_assert(WS_VTM + (size_t)16 * 64 * 4352 * 2 <= 256 * MiB, "ws map");
static_assert(WS_QM + (size_t)MALL * 384 * 2 <= WS_KM && WS_A1 + (size_t)MALL * FF * 2 <= WS_KM, "ws map");
constexpr int CW_BAR = 1024;
constexpr int RING_BYTES = 131072, MISC_OFF = RING_BYTES + 320, LDS_BYTES = 147456;

typedef unsigned v2u __attribute__((ext_vector_type(2)));
typedef float f32x16 __attribute__((ext_vector_type(16)));
__device__ __forceinline__ float bflo(unsigned w) { return __builtin_bit_cast(float, w << 16); }
__device__ __forceinline__ float bfhi(unsigned w) { return __builtin_bit_cast(float, w & 0xffff0000u); }
__device__ __forceinline__ float bf1(bf16 h) { return __builtin_bit_cast(float, (unsigned)h << 16); }
__device__ __forceinline__ float wave_sum(float v) {
#pragma unroll
    for (int o = 1; o < 64; o <<= 1) v += __shfl_xor(v, o);
    return v;
}
__device__ __forceinline__ float sigmoidf_(float x) { return 1.0f / (1.0f + __expf(-x)); }

struct Args { const float* in[25]; float* out; unsigned char* ws; int never; int pad; };

struct Frame {
    LAS unsigned char* lds;
    int tid, lane, wave, vcu, G;
    unsigned char* ws;
};
constexpr int PTAB_OFF = 131072 + 1024;
__device__ __forceinline__ const float* fin(const Frame& F, int i) {
    const volatile LAS unsigned* t = (const volatile LAS unsigned*)(F.lds + PTAB_OFF) + 2 * i;
    const unsigned lo = __builtin_amdgcn_readfirstlane(t[0]), hi = __builtin_amdgcn_readfirstlane(t[1]);
    return (const float*)(((unsigned long long)hi << 32) | lo);
}
__device__ __forceinline__ float* fout(const Frame& F) { return (float*)fin(F, 25); }
__device__ __forceinline__ unsigned char* wsl(const Frame& F) { return F.ws; }

struct AttnDesc { const bf16* q; int qpitch; bf16* o; const bf16* k0; const bf16* k1; const bf16* v0; const bf16* v1; int kpitch; int nseg0; int nt; int cq; int offr0; const LAS float* rpb; };
__device__ __forceinline__ int crow(int r, int hi) { return (r & 3) + 8 * (r >> 2) + 4 * hi; }

template <int DQK, int NGRP, int MODE>
__device__ __forceinline__ void attn_unit(LAS unsigned char* lds, const AttnDesc d, const int tid_in) {
    constexpr int KP = DQK + 8, VP = 68, KBYTES = 64 * KP * 2, VBYTES = 64 * VP * 2, TG = 512 / NGRP, NKC = 64 * DQK / 8, NKI = (NKC + TG - 1) / TG, NVI = 512 / TG, CPR = DQK / 8, NKS = DQK / 16;
    int tid_ = tid_in; asm volatile("" : "+v"(tid_));
    const int tid = tid_, lane = tid & 63, r32 = lane & 31, hi = lane >> 5;
    const int g = tid / TG, tg = tid % TG;
    LAS unsigned char* Ks = lds + g * (KBYTES + VBYTES); LAS unsigned char* Vs = Ks + KBYTES;
    bf16x8 qf[NKS];
#pragma unroll
    for (int ks = 0; ks < NKS; ++ks) qf[ks] = *(const GAS bf16x8*)(d.q + (size_t)r32 * d.qpitch + ks * 16 + hi * 8);
    f32x16 o0, o1;
#pragma unroll
    for (int r = 0; r < 16; ++r) { o0[r] = 0.f; o1[r] = 0.f; }
    float mrun = -INFINITY, lrun = 0.f;
    v4u kreg[NKI], vreg[NVI];
#define ATT_LOAD(kt_) do { const int kt__ = (kt_); \
        const bf16* kb_ = kt__ < d.nseg0 ? d.k0 + (size_t)kt__ * 64 * d.kpitch : d.k1 + (size_t)(kt__ - d.nseg0) * 64 * d.kpitch; \
        const bf16* vb_ = kt__ < d.nseg0 ? d.v0 + kt__ * 64 : d.v1 + (kt__ - d.nseg0) * 64; \
        _Pragma("unroll") for (int i = 0; i < NKI; ++i) { const int c = tg + i * TG; if ((NKC % TG == 0) || c < NKC) { const int row = c / CPR, cc = c % CPR; kreg[i] = *(const GAS v4u*)(kb_ + (size_t)row * d.kpitch + cc * 8); } } \
        _Pragma("unroll") for (int i = 0; i < NVI; ++i) { const int c = tg + i * TG; const int row = c >> 3, cc = c & 7; vreg[i] = *(const GAS v4u*)(vb_ + (size_t)row * KEYS + cc * 8); } } while (0)
    ATT_LOAD(0);
    for (int kt = 0; kt < d.nt; ++kt) {
        __syncthreads();
#pragma unroll
        for (int i = 0; i < NKI; ++i) { const int c = tg + i * TG; if ((NKC % TG == 0) || c < NKC) { const int row = c / CPR, cc = c % CPR; *(LAS v4u*)(Ks + row * (KP * 2) + cc * 16) = kreg[i]; } }
#pragma unroll
        for (int i = 0; i < NVI; ++i) { const int c = tg + i * TG; const int row = c >> 3, cc = c & 7; LAS v2u* p = (LAS v2u*)(Vs + row * (VP * 2) + cc * 16); p[0] = (v2u){vreg[i].x, vreg[i].y}; p[1] = (v2u){vreg[i].z, vreg[i].w}; }
        __syncthreads();
        if (kt + 1 < d.nt) ATT_LOAD(kt + 1);
        f32x16 s0, s1;
#pragma unroll
        for (int r = 0; r < 16; ++r) { s0[r] = 0.f; s1[r] = 0.f; }
#pragma unroll
        for (int ks = 0; ks < NKS; ++ks) {
            const bf16x8 kf0 = *(const LAS bf16x8*)(Ks + r32 * (KP * 2) + ks * 32 + hi * 16);
            const bf16x8 kf1 = *(const LAS bf16x8*)(Ks + (32 + r32) * (KP * 2) + ks * 32 + hi * 16);
            s0 = __builtin_amdgcn_mfma_f32_32x32x16_bf16(kf0, qf[ks], s0, 0, 0, 0);
            s1 = __builtin_amdgcn_mfma_f32_32x32x16_bf16(kf1, qf[ks], s1, 0, 0, 0);
        }
        if (MODE == 1) {
#pragma unroll
            for (int r = 0; r < 16; ++r) { s0[r] *= NA_C2; s1[r] *= NA_C2; }
        }
        if (MODE == 2) {
            if (kt < 8) {
                const int cqa = d.cq + r32; const int cs = min(max(cqa - 8, 0), 48);
                const LAS float* rp = d.rpb + (d.offr0 + kt) * 31 + (15 - cqa);
#pragma unroll
                for (int r = 0; r < 16; ++r) {
                    const int ck0 = crow(r, hi), ck1 = 32 + ck0;
                    const bool ok0 = (ck0 >= cs) && (ck0 < cs + 16), ok1 = (ck1 >= cs) && (ck1 < cs + 16);
                    const float b0 = ok0 ? rp[ck0] : 0.f, b1 = ok1 ? rp[ck1] : 0.f;
                    s0[r] = ok0 ? s0[r] * NA_C2 + b0 : -INFINITY; s1[r] = ok1 ? s1[r] * NA_C2 + b1 : -INFINITY;
                }
            } else {
#pragma unroll
                for (int r = 0; r < 16; ++r) { s0[r] *= NA_C2; s1[r] *= NA_C2; }
            }
        }
        float mx = fmaxf(s0[0], s1[0]);
#pragma unroll
        for (int r = 1; r < 16; ++r) mx = fmaxf(mx, fmaxf(s0[r], s1[r]));
        mx = fmaxf(mx, __shfl_xor(mx, 32));
        const float mnew = fmaxf(mrun, mx);
        const float alpha = __builtin_amdgcn_exp2f(mrun - mnew);
        mrun = mnew;
        float ps = 0.f;
#pragma unroll
        for (int r = 0; r < 16; ++r) { s0[r] = __builtin_amdgcn_exp2f(s0[r] - mnew); s1[r] = __builtin_amdgcn_exp2f(s1[r] - mnew); ps += s0[r] + s1[r]; }
        lrun = lrun * alpha + ps;
#pragma unroll
        for (int r = 0; r < 16; ++r) { o0[r] *= alpha; o1[r] *= alpha; }
        bf16x8 pf[2][2];
#pragma unroll
        for (int sp = 0; sp < 2; ++sp) {
            v4u w0, w1;
            w0.x = pg8::cvt_pk_bf16(s0[8 * sp + 0], s0[8 * sp + 1]); w0.y = pg8::cvt_pk_bf16(s0[8 * sp + 2], s0[8 * sp + 3]); w0.z = pg8::cvt_pk_bf16(s0[8 * sp + 4], s0[8 * sp + 5]); w0.w = pg8::cvt_pk_bf16(s0[8 * sp + 6], s0[8 * sp + 7]);
            w1.x = pg8::cvt_pk_bf16(s1[8 * sp + 0], s1[8 * sp + 1]); w1.y = pg8::cvt_pk_bf16(s1[8 * sp + 2], s1[8 * sp + 3]); w1.z = pg8::cvt_pk_bf16(s1[8 * sp + 4], s1[8 * sp + 5]); w1.w = pg8::cvt_pk_bf16(s1[8 * sp + 6], s1[8 * sp + 7]);
            pf[0][sp] = __builtin_bit_cast(bf16x8, w0); pf[1][sp] = __builtin_bit_cast(bf16x8, w1);
        }
#pragma unroll
        for (int sub = 0; sub < 2; ++sub)
#pragma unroll
            for (int sp = 0; sp < 2; ++sp) {
                const int koff = (sub * 32 + 16 * sp + 4 * hi) * 2;
                const LAS v2u* pa = (const LAS v2u*)(Vs + r32 * (VP * 2) + koff);
                const LAS v2u* pb = (const LAS v2u*)(Vs + (32 + r32) * (VP * 2) + koff);
                const v2u a0 = pa[0], a1 = pa[2], b0 = pb[0], b1 = pb[2];
                const bf16x8 vf0 = __builtin_bit_cast(bf16x8, (v4u){a0.x, a0.y, a1.x, a1.y});
                const bf16x8 vf1 = __builtin_bit_cast(bf16x8, (v4u){b0.x, b0.y, b1.x, b1.y});
                o0 = __builtin_amdgcn_mfma_f32_32x32x16_bf16(vf0, pf[sub][sp], o0, 0, 0, 0);
                o1 = __builtin_amdgcn_mfma_f32_32x32x16_bf16(vf1, pf[sub][sp], o1, 0, 0, 0);
            }
    }
#undef ATT_LOAD
    const float ltot = lrun + __shfl_xor(lrun, 32);
    const float inv = 1.0f / ltot;
    bf16* orow = d.o + (size_t)r32 * 1024 + 4 * hi;
#pragma unroll
    for (int g4 = 0; g4 < 4; ++g4) {
        v2u w; w.x = pg8::cvt_pk_bf16(o0[4 * g4 + 0] * inv, o0[4 * g4 + 1] * inv); w.y = pg8::cvt_pk_bf16(o0[4 * g4 + 2] * inv, o0[4 * g4 + 3] * inv);
        *(GAS v2u*)(orow + 8 * g4) = w;
        v2u x; x.x = pg8::cvt_pk_bf16(o1[4 * g4 + 0] * inv, o1[4 * g4 + 1] * inv); x.y = pg8::cvt_pk_bf16(o1[4 * g4 + 2] * inv, o1[4 * g4 + 3] * inv);
        *(GAS v2u*)(orow + 32 + 8 * g4) = x;
    }
}


__device__ __forceinline__ void attn_mla(LAS unsigned char* lds, const AttnDesc d, const int tid_in) {
    constexpr int KP = 104, VP = 68, KBYTES = 64 * KP * 2, VBYTES = 64 * VP * 2, BUF = KBYTES + VBYTES, NKS = 6;
    int tid_ = tid_in; asm volatile("" : "+v"(tid_));
    const int tid = tid_, lane = tid & 63, r32 = lane & 31, hi = lane >> 5;
    bf16x8 qf[NKS];
#pragma unroll
    for (int ks = 0; ks < NKS; ++ks) qf[ks] = *(const GAS bf16x8*)(d.q + (size_t)r32 * d.qpitch + ks * 16 + hi * 8);
    f32x16 o0, o1, sc0, sc1;
#pragma unroll
    for (int r = 0; r < 16; ++r) { o0[r] = 0.f; o1[r] = 0.f; }
    float mrun = -INFINITY, lrun = 0.f;
    v4u kreg0, kreg1, vreg0;
    const int krow0 = tid / 12, kcc0 = tid % 12, krow1 = (tid + 512) / 12, kcc1 = (tid + 512) % 12, vrow = tid >> 3, vcc = tid & 7;
    const int nt = d.nt;
#define MLA_LOAD(kt_) do { const bf16* kb_ = d.k0 + (size_t)(kt_) * 64 * 96; const bf16* vb_ = d.v0 + (kt_) * 64; \
        kreg0 = *(const GAS v4u*)(kb_ + krow0 * 96 + kcc0 * 8); if (tid < 256) kreg1 = *(const GAS v4u*)(kb_ + krow1 * 96 + kcc1 * 8); \
        vreg0 = *(const GAS v4u*)(vb_ + (size_t)vrow * KEYS + vcc * 8); } while (0)
#define MLA_STORE(bi_) do { LAS unsigned char* Kb_ = lds + (bi_) * BUF; LAS unsigned char* Vb_ = Kb_ + KBYTES; \
        *(LAS v4u*)(Kb_ + krow0 * (KP * 2) + kcc0 * 16) = kreg0; if (tid < 256) *(LAS v4u*)(Kb_ + krow1 * (KP * 2) + kcc1 * 16) = kreg1; \
        LAS v2u* p_ = (LAS v2u*)(Vb_ + vrow * (VP * 2) + vcc * 16); p_[0] = (v2u){vreg0.x, vreg0.y}; p_[1] = (v2u){vreg0.z, vreg0.w}; } while (0)
#define MLA_QK(S0, S1, bi_) do { const LAS unsigned char* Kb_ = lds + (bi_) * BUF; \
        _Pragma("unroll") for (int r = 0; r < 16; ++r) { S0[r] = 0.f; S1[r] = 0.f; } \
        _Pragma("unroll") for (int ks = 0; ks < NKS; ++ks) { \
            const bf16x8 kf0 = *(const LAS bf16x8*)(Kb_ + r32 * (KP * 2) + ks * 32 + hi * 16); \
            const bf16x8 kf1 = *(const LAS bf16x8*)(Kb_ + (32 + r32) * (KP * 2) + ks * 32 + hi * 16); \
            S0 = __builtin_amdgcn_mfma_f32_32x32x16_bf16(kf0, qf[ks], S0, 0, 0, 0); \
            S1 = __builtin_amdgcn_mfma_f32_32x32x16_bf16(kf1, qf[ks], S1, 0, 0, 0); } } while (0)
    __syncthreads();
    MLA_LOAD(0); MLA_STORE(0);
    MLA_LOAD(1);
    __syncthreads();
    MLA_QK(sc0, sc1, 0);
    int bcur = 0, bnext = 1;
    for (int kt = 0; kt < nt; ++kt) {
        const bool has_next = kt + 1 < nt;
        if (has_next) MLA_STORE(bnext);
        if (kt + 2 < nt) MLA_LOAD(kt + 2);
        __syncthreads();
        f32x16 sn0, sn1;
        if (has_next) MLA_QK(sn0, sn1, bnext);
        float mx = fmaxf(sc0[0], sc1[0]);
#pragma unroll
        for (int r = 1; r < 16; ++r) mx = fmaxf(mx, fmaxf(sc0[r], sc1[r]));
        mx = fmaxf(mx, __shfl_xor(mx, 32));
        const float mnew = fmaxf(mrun, mx);
        const float alpha = __builtin_amdgcn_exp2f(mrun - mnew);
        mrun = mnew;
        float ps = 0.f;
#pragma unroll
        for (int r = 0; r < 16; ++r) { sc0[r] = __builtin_amdgcn_exp2f(sc0[r] - mnew); sc1[r] = __builtin_amdgcn_exp2f(sc1[r] - mnew); ps += sc0[r] + sc1[r]; }
        lrun = lrun * alpha + ps;
#pragma unroll
        for (int r = 0; r < 16; ++r) { o0[r] *= alpha; o1[r] *= alpha; }
        bf16x8 pf[2][2];
#pragma unroll
        for (int sp = 0; sp < 2; ++sp) {
            v4u w0, w1;
            w0.x = pg8::cvt_pk_bf16(sc0[8 * sp + 0], sc0[8 * sp + 1]); w0.y = pg8::cvt_pk_bf16(sc0[8 * sp + 2], sc0[8 * sp + 3]); w0.z = pg8::cvt_pk_bf16(sc0[8 * sp + 4], sc0[8 * sp + 5]); w0.w = pg8::cvt_pk_bf16(sc0[8 * sp + 6], sc0[8 * sp + 7]);
            w1.x = pg8::cvt_pk_bf16(sc1[8 * sp + 0], sc1[8 * sp + 1]); w1.y = pg8::cvt_pk_bf16(sc1[8 * sp + 2], sc1[8 * sp + 3]); w1.z = pg8::cvt_pk_bf16(sc1[8 * sp + 4], sc1[8 * sp + 5]); w1.w = pg8::cvt_pk_bf16(sc1[8 * sp + 6], sc1[8 * sp + 7]);
            pf[0][sp] = __builtin_bit_cast(bf16x8, w0); pf[1][sp] = __builtin_bit_cast(bf16x8, w1);
        }
        const LAS unsigned char* Vs = lds + bcur * BUF + KBYTES;
#pragma unroll
        for (int sub = 0; sub < 2; ++sub)
#pragma unroll
            for (int sp = 0; sp < 2; ++sp) {
                const int koff = (sub * 32 + 16 * sp + 4 * hi) * 2;
                const LAS v2u* pa = (const LAS v2u*)(Vs + r32 * (VP * 2) + koff);
                const LAS v2u* pb = (const LAS v2u*)(Vs + (32 + r32) * (VP * 2) + koff);
                const v2u a0 = pa[0], a1 = pa[2], b0 = pb[0], b1 = pb[2];
                const bf16x8 vf0 = __builtin_bit_cast(bf16x8, (v4u){a0.x, a0.y, a1.x, a1.y});
                const bf16x8 vf1 = __builtin_bit_cast(bf16x8, (v4u){b0.x, b0.y, b1.x, b1.y});
                o0 = __builtin_amdgcn_mfma_f32_32x32x16_bf16(vf0, pf[sub][sp], o0, 0, 0, 0);
                o1 = __builtin_amdgcn_mfma_f32_32x32x16_bf16(vf1, pf[sub][sp], o1, 0, 0, 0);
            }
        if (has_next) { sc0 = sn0; sc1 = sn1; }
        bcur = bnext; bnext = (bnext == 2) ? 0 : bnext + 1;
    }
#undef MLA_LOAD
#undef MLA_STORE
#undef MLA_QK
    const float ltot = lrun + __shfl_xor(lrun, 32);
    const float inv = 1.0f / ltot;
    bf16* orow = d.o + (size_t)r32 * 1024 + 4 * hi;
#pragma unroll
    for (int g4 = 0; g4 < 4; ++g4) {
        v2u w; w.x = pg8::cvt_pk_bf16(o0[4 * g4 + 0] * inv, o0[4 * g4 + 1] * inv); w.y = pg8::cvt_pk_bf16(o0[4 * g4 + 2] * inv, o0[4 * g4 + 3] * inv);
        *(GAS v2u*)(orow + 8 * g4) = w;
        v2u x; x.x = pg8::cvt_pk_bf16(o1[4 * g4 + 0] * inv, o1[4 * g4 + 1] * inv); x.y = pg8::cvt_pk_bf16(o1[4 * g4 + 2] * inv, o1[4 * g4 + 3] * inv);
        *(GAS v2u*)(orow + 32 + 8 * g4) = x;
    }
}

__device__ __forceinline__ void p0_transpose_item(const float* W, int K, int N, bf16* WT, int row_off, LAS float* scr, int item, int lane) {
    const int nblk = N / 32, kb = item / nblk, nb = item % nblk, k0 = 64 * kb, n0 = 32 * nb;
    float wv[32];
#pragma unroll
    for (int i = 0; i < 32; ++i) { const int kk = 2 * i + (lane >> 5); wv[i] = *(const GAS float*)(W + (size_t)(k0 + kk) * N + n0 + (lane & 31)); }
#pragma unroll
    for (int i = 0; i < 32; ++i) { const int kk = 2 * i + (lane >> 5); scr[kk * 33 + (lane & 31)] = wv[i]; }
    LDS_WAIT(); asm volatile("" ::: "memory");
    const int c = lane & 7;
#pragma unroll
    for (int j = 0; j < 4; ++j) { const int n = (lane >> 3) + 8 * j; const LAS float* s = scr + (8 * c) * 33 + n;
        v4u o; o.x = pk2(s[0 * 33], s[1 * 33]); o.y = pk2(s[2 * 33], s[3 * 33]); o.z = pk2(s[4 * 33], s[5 * 33]); o.w = pk2(s[6 * 33], s[7 * 33]);
        *(GAS v4u*)(WT + (size_t)(row_off + n0 + n) * K + k0 + 8 * c) = o; }
    LDS_WAIT(); asm volatile("" ::: "memory");
}
__device__ __forceinline__ void convert_weights(Frame& F, int L) {
    unsigned char* const ws_ = wsl(F);
    LAS float* scr = (LAS float*)(F.lds + F.wave * 16384);
    const int gw = F.vcu * NWAVES + F.wave, NGW = F.G * NWAVES;
    const float* w_in = fin(F, 7) + (size_t)L * DM * PIN; const float* w_out = fin(F, 19) + (size_t)L * DM * DM;
    const float* w1 = fin(F, 22) + (size_t)L * DM * FF; const float* w2 = fin(F, 23) + (size_t)L * FF * DM;
    bf16* WIN = (bf16*)(ws_ + WS_WIN); bf16* WOUT = (bf16*)(ws_ + WS_WOUT); bf16* W1 = (bf16*)(ws_ + WS_W1); bf16* W2 = (bf16*)(ws_ + WS_W2);
    constexpr int I_IN = (DM / 64) * (PIN / 32), I_O = (DM / 64) * (DM / 32), I_1 = (DM / 64) * (FF / 32), I_2 = (FF / 64) * (DM / 32);
    constexpr int NITEMS = I_IN + I_O + I_1 + I_2;
    for (int it = gw; it < NITEMS; it += NGW) {
        int r = it;
        if (r < I_IN) { p0_transpose_item(w_in, DM, PIN, WIN, 0, scr, r, F.lane); continue; } r -= I_IN;
        if (r < I_O) { p0_transpose_item(w_out, DM, DM, WOUT, 0, scr, r, F.lane); continue; } r -= I_O;
        if (r < I_1) { p0_transpose_item(w1, DM, FF, W1, 0, scr, r, F.lane); continue; } r -= I_1;
        p0_transpose_item(w2, FF, DM, W2, 0, scr, r, F.lane);
    }
    const float* w_uq = fin(F, 10) + (size_t)L * 256 * 384; const float* g_q = fin(F, 9) + L * 256;
    const float* w_ukv = fin(F, 12) + (size_t)L * 128 * 512; const float* g_kv = fin(F, 11) + L * 128;
    const float* w_pw = fin(F, 17) + (size_t)L * 256 * 256;
    bf16* WUQ = (bf16*)(ws_ + WS_WUQ); bf16* WUKV = (bf16*)(ws_ + WS_WUKV); bf16* WPW = (bf16*)(ws_ + WS_WPW);
    const int gt = F.vcu * 512 + F.tid, NGT = F.G * 512;
    constexpr int E_UQ = 512 * 256, E_UKV = 512 * 256, E_PW = 256 * 256, E_PAD = (PINP - PIN) * DM;
    for (int e = gt; e < E_UQ + E_UKV + E_PW + E_PAD; e += NGT) {
        int r = e;
        if (r < E_UQ) { const int n = r >> 8, k = r & 255; float v = 0.f;
            if (n < 384) { const int head = n / 96, d = n % 96; int od = d;
                if (d >= 64) { const int j = d - 64; od = 64 + (j < 16 ? (j & 1) * 8 + (j >> 1) : 16 + ((j - 16) & 1) * 8 + ((j - 16) >> 1)); }
                v = w_uq[(size_t)k * 384 + head * 96 + od] * g_q[k]; }
            WUQ[r] = (bf16)f2bf(v); continue; } r -= E_UQ;
        if (r < E_UKV) { const int n = r >> 8, k = r & 255; float v = 0.f; if (k < 128) v = w_ukv[(size_t)k * 512 + n] * g_kv[k]; WUKV[r] = (bf16)f2bf(v); continue; } r -= E_UKV;
        if (r < E_PW) { const int n = r >> 8, k = r & 255; WPW[r] = (bf16)f2bf(w_pw[(size_t)k * 256 + n]); continue; } r -= E_PW;
        WIN[(size_t)PIN * DM + r] = 0;
    }
}
__device__ __forceinline__ void mod_gemv(Frame& F) {
    unsigned char* const ws_ = wsl(F);
    LAS float* red = (LAS float*)F.lds;
    float* MOD = (float*)(ws_ + WS_MOD);
    const float* c = fin(F, 1); const float* cctx = fin(F, 3);
    for (int unit = F.vcu; unit < 192; unit += F.G) {
        const int L = unit / 96, n0 = (unit % 96) * 64;
        const float* W = fin(F, 4) + (size_t)L * DM * 6144; const float* bm = fin(F, 5) + L * 6144;
        const int cg = F.tid & 15, ks = F.tid >> 4;
        float acc[5][4];
#pragma unroll
        for (int v = 0; v < 5; ++v)
#pragma unroll
            for (int e = 0; e < 4; ++e) acc[v][e] = 0.f;
        for (int kk = 0; kk < 32; ++kk) { const int k = ks * 32 + kk;
            const f32x4 w = *(const GAS f32x4*)(W + (size_t)k * 6144 + n0 + cg * 4);
#pragma unroll
            for (int v = 0; v < 5; ++v) { const float cv = v < 4 ? c[v * DM + k] : cctx[k]; const float s = cv * sigmoidf_(cv);
#pragma unroll
                for (int e = 0; e < 4; ++e) acc[v][e] += s * w[e]; } }
        __syncthreads();
#pragma unroll
        for (int v = 0; v < 5; ++v)
#pragma unroll
            for (int e = 0; e < 4; ++e) red[(ks * 5 + v) * 64 + cg * 4 + e] = acc[v][e];
        __syncthreads();
        if (F.tid < 320) { const int v = F.tid >> 6, col = F.tid & 63; float s = 0.f;
            for (int j = 0; j < 32; ++j) s += red[(j * 5 + v) * 64 + col];
            MOD[((size_t)L * 5 + v) * 6144 + n0 + col] = s + bm[n0 + col]; }
        __syncthreads();
    }
}

__device__ __forceinline__ const float* xrow_src(Frame& F, int L, int row) {
    if (L == 0) return row < NLAT ? fin(F, 0) + (size_t)row * DM : fin(F, 2) + (size_t)(row - NLAT) * DM;
    return row < NLAT ? fout(F) + (size_t)row * DM : (const float*)(F.ws + WS_R0C) + (size_t)(row - NLAT) * DM;
}
__device__ __forceinline__ float* r0row(Frame& F, int row) { return row < NLAT ? fout(F) + (size_t)row * DM : (float*)(F.ws + WS_R0C) + (size_t)(row - NLAT) * DM; }
__device__ __forceinline__ void load_row(const float* p, int lane, f32x4 (&v)[4]) {
#pragma unroll
    for (int j = 0; j < 4; ++j) v[j] = *(const GAS f32x4*)(p + 4 * lane + 256 * j);
}
__device__ __forceinline__ float row_rstd(const f32x4 (&v)[4]) {
    float s = 0.f;
#pragma unroll
    for (int j = 0; j < 4; ++j) s += (v[j].x * v[j].x + v[j].y * v[j].y) + (v[j].z * v[j].z + v[j].w * v[j].w);
    return 1.0f / sqrtf(wave_sum(s) * (1.0f / DM) + EPS);
}
__device__ __forceinline__ void write_modnorm(const f32x4 (&x)[4], float rstd, const float* g, const float* sc, const float* sh, bf16* dst, int lane) {
#pragma unroll
    for (int j = 0; j < 4; ++j) { const int c = 4 * lane + 256 * j;
        const f32x4 gv = *(const GAS f32x4*)(g + c), scv = *(const GAS f32x4*)(sc + c), shv = *(const GAS f32x4*)(sh + c);
        const f32x4 h = (x[j] * rstd * gv) * (scv + 1.0f) + shv;
        v2u w; w.x = pk2(h.x, h.y); w.y = pk2(h.z, h.w);
        *(GAS v2u*)(dst + c) = w; }
}
__device__ __forceinline__ void load_row_bf(const bf16* p, int lane, f32x4 (&v)[4]) {
#pragma unroll
    for (int j = 0; j < 4; ++j) { const v2u w = *(const GAS v2u*)(p + 4 * lane + 256 * j); v[j] = (f32x4){bflo(w.x), bfhi(w.x), bflo(w.y), bfhi(w.y)}; }
}
__device__ __forceinline__ void load_slab4(const float* sl, int lane, f32x4 (&y)[4]) {
    f32x4 t[4]; load_row(sl, lane, y);
#pragma unroll
    for (int q = 1; q < 4; ++q) { load_row(sl + (size_t)q * NCTXR * DM, lane, t);
#pragma unroll
        for (int j = 0; j < 4; ++j) y[j] = y[j] + t[j]; }
}
__device__ __forceinline__ void pass_prep(Frame& F, int L) {
    unsigned char* const ws_ = wsl(F);
    const int gw = F.vcu * NWAVES + F.wave, NGW = F.G * NWAVES;
    const float* MOD = (const float*)(ws_ + WS_MOD) + (size_t)L * 5 * 6144;
    const float* g = fin(F, 6) + L * DM;
    f32x4 x[4], xn[4];
    if (gw < MALL) load_row(xrow_src(F, L, gw), F.lane, x);
    for (int row = gw; row < MALL; row += NGW) {
        const int nrow = row + NGW;
        if (nrow < MALL) load_row(xrow_src(F, L, nrow), F.lane, xn);
        const float rstd = row_rstd(x);
        const float* mv = MOD + (row < NLAT ? (row >> 12) : 4) * 6144;
        write_modnorm(x, rstd, g, mv + 1024, mv + 0, (bf16*)(ws_ + WS_R1 + (size_t)row * 4096), F.lane);
#pragma unroll
        for (int j = 0; j < 4; ++j) x[j] = xn[j];
    }
}
__device__ __forceinline__ void pass_postwo(Frame& F, int L, int nrows) {
    unsigned char* const ws_ = wsl(F);
    const int gw = F.vcu * NWAVES + F.wave, NGW = F.G * NWAVES;
    const float* MOD = (const float*)(ws_ + WS_MOD) + (size_t)L * 5 * 6144;
    const float* gpost = fin(F, 20) + L * DM; const float* gpre = fin(F, 21) + L * DM;
    f32x4 y[4], x[4], yn[4], xn[4];
#define PW_LOAD(row_, Y_, X_) do { bf16* yr_ = (bf16*)(ws_ + WS_R1 + (size_t)(row_) * 4096); \
        if ((row_) >= NLAT) load_slab4((const float*)(ws_ + WS_U) + (size_t)((row_) - NLAT) * DM, F.lane, Y_); else load_row_bf(yr_, F.lane, Y_); \
        load_row(xrow_src(F, L, (row_)), F.lane, X_); } while (0)
    if (gw < nrows) PW_LOAD(gw, y, x);
    for (int row = gw; row < nrows; row += NGW) {
        const int nrow = row + NGW;
        if (nrow < nrows) PW_LOAD(nrow, yn, xn);
        bf16* yrow = (bf16*)(ws_ + WS_R1 + (size_t)row * 4096);
        const float ry = row_rstd(y);
        const float* mv = MOD + (row < NLAT ? (row >> 12) : 4) * 6144;
#pragma unroll
        for (int j = 0; j < 4; ++j) { const int c = 4 * F.lane + 256 * j;
            const f32x4 gv = *(const GAS f32x4*)(gpost + c), ga = *(const GAS f32x4*)(mv + 2048 + c);
            x[j] = x[j] + ga * (y[j] * ry * gv); }
        float* xo = r0row(F, row);
#pragma unroll
        for (int j = 0; j < 4; ++j) *(GAS f32x4*)(xo + 4 * F.lane + 256 * j) = x[j];
        const float r1 = row_rstd(x);
        write_modnorm(x, r1, gpre, mv + 4096, mv + 3072, yrow, F.lane);
#pragma unroll
        for (int j = 0; j < 4; ++j) { y[j] = yn[j]; x[j] = xn[j]; }
    }
#undef PW_LOAD
}
__device__ __forceinline__ void pass_postmlp(Frame& F, int L, int nrows) {
    unsigned char* const ws_ = wsl(F);
    const int gw = F.vcu * NWAVES + F.wave, NGW = F.G * NWAVES;
    const float* MOD = (const float*)(ws_ + WS_MOD) + (size_t)L * 5 * 6144;
    const float* gpost = fin(F, 24) + L * DM;
    f32x4 y[4], x[4], yn[4], xn[4];
#define PM_LOAD(row_, Y_, X_) do { bf16* mr_ = (bf16*)(ws_ + WS_R1 + (size_t)(row_) * 4096); \
        if ((row_) >= NLAT) load_slab4((const float*)(ws_ + WS_KM) + (size_t)((row_) - NLAT) * DM, F.lane, Y_); else load_row_bf(mr_, F.lane, Y_); \
        load_row(r0row(F, (row_)), F.lane, X_); } while (0)
    if (gw < nrows) PM_LOAD(gw, y, x);
    for (int row = gw; row < nrows; row += NGW) {
        const int nrow = row + NGW;
        if (nrow < nrows) PM_LOAD(nrow, yn, xn);
        bf16* mrow = (bf16*)(ws_ + WS_R1 + (size_t)row * 4096);
        float* xo = r0row(F, row);
        const float ry = row_rstd(y);
        const float* mv = MOD + (row < NLAT ? (row >> 12) : 4) * 6144;
#pragma unroll
        for (int j = 0; j < 4; ++j) { const int c = 4 * F.lane + 256 * j;
            const f32x4 gv = *(const GAS f32x4*)(gpost + c), ga = *(const GAS f32x4*)(mv + 5120 + c);
            x[j] = x[j] + ga * (y[j] * ry * gv); }
#pragma unroll
        for (int j = 0; j < 4; ++j) *(GAS f32x4*)(xo + 4 * F.lane + 256 * j) = x[j];
        if (L == 0) {
            const float* mv1 = mv + 5 * 6144;
            const float r1 = row_rstd(x);
            write_modnorm(x, r1, fin(F, 6) + DM, mv1 + 1024, mv1 + 0, mrow, F.lane);
        }
#pragma unroll
        for (int j = 0; j < 4; ++j) { y[j] = yn[j]; x[j] = xn[j]; }
    }
#undef PM_LOAD
}

__device__ __forceinline__ void row_bk(int row, int& b, int& kk) { if (row < NLAT) { b = row >> 12; kk = row & 4095; } else { const int r2 = row - NLAT; b = r2 >> 8; kk = 4096 + (r2 & 255); } }
__device__ __forceinline__ void pass_mix(Frame& F, int L) {
    unsigned char* const ws_ = wsl(F);
    const bf16* U = (const bf16*)(ws_ + WS_U); bf16* Y = (bf16*)(ws_ + WS_Y);
    {
        const float* wsc = fin(F, 8) + L * 3 * 256;
        const int gt = F.vcu * 512 + F.tid, NGT = F.G * 512;
        for (int idx = gt; idx < MALL * 32; idx += NGT) {
            const int row = idx >> 5, c8 = idx & 31;
            int t, len; if (row < NLAT) { t = row & 4095; len = 4096; } else { t = (row - NLAT) & 255; len = 256; }
            const bf16* ur = U + (size_t)row * PINP + c8 * 8;
            float acc[8];
#pragma unroll
            for (int e = 0; e < 8; ++e) acc[e] = 0.f;
#pragma unroll
            for (int k = 0; k < 3; ++k) { const int tt = t + k - 1; if (tt < 0 || tt >= len) continue;
                const bf16* up = ur + (ptrdiff_t)(k - 1) * PINP;
                const v4u xi = *(const GAS v4u*)(up), cg = *(const GAS v4u*)(up + 512);
                const f32x4 w0 = *(const f32x4*)(wsc + k * 256 + c8 * 8), w1 = *(const f32x4*)(wsc + k * 256 + c8 * 8 + 4);
                acc[0] += w0.x * (bflo(xi.x) * bflo(cg.x)); acc[1] += w0.y * (bfhi(xi.x) * bfhi(cg.x));
                acc[2] += w0.z * (bflo(xi.y) * bflo(cg.y)); acc[3] += w0.w * (bfhi(xi.y) * bfhi(cg.y));
                acc[4] += w1.x * (bflo(xi.z) * bflo(cg.z)); acc[5] += w1.y * (bfhi(xi.z) * bfhi(cg.z));
                acc[6] += w1.z * (bflo(xi.w) * bflo(cg.w)); acc[7] += w1.w * (bfhi(xi.w) * bfhi(cg.w)); }
            const v4u bg = *(const GAS v4u*)(ur + 256);
            v4u o; o.x = pk2(acc[0] * bflo(bg.x), acc[1] * bfhi(bg.x)); o.y = pk2(acc[2] * bflo(bg.y), acc[3] * bfhi(bg.y));
            o.z = pk2(acc[4] * bflo(bg.z), acc[5] * bfhi(bg.z)); o.w = pk2(acc[6] * bflo(bg.w), acc[7] * bfhi(bg.w));
            *(GAS v4u*)(Y + (size_t)row * DM + c8 * 8) = o;
        }
    }
    {
        const int gw = F.vcu * NWAVES + F.wave, NGW = F.G * NWAVES;
        float* RSQ = (float*)(ws_ + WS_RSQ); float* RSKV = (float*)(ws_ + WS_RSKV); bf16* KM = (bf16*)(ws_ + WS_KM);
        for (int row = gw; row < MALL; row += NGW) {
            const bf16* ur = U + (size_t)row * PINP;
            float sq = 0.f, skv = 0.f;
            if (F.lane < 48) { const v4u w = *(const GAS v4u*)(ur + 768 + F.lane * 8);
                float s = bflo(w.x) * bflo(w.x) + bfhi(w.x) * bfhi(w.x) + bflo(w.y) * bflo(w.y) + bfhi(w.y) * bfhi(w.y) + bflo(w.z) * bflo(w.z) + bfhi(w.z) * bfhi(w.z) + bflo(w.w) * bflo(w.w) + bfhi(w.w) * bfhi(w.w);
                if (F.lane < 32) sq = s; else skv = s; }
            sq = wave_sum(sq); skv = wave_sum(skv);
            if (F.lane == 0) { RSQ[row] = 1.0f / sqrtf(sq * (1.0f / 256.0f) + EPS); RSKV[row] = 1.0f / sqrtf(skv * (1.0f / 128.0f) + EPS); }
            if (F.lane < 16) { const int part = F.lane >> 3, i = F.lane & 7;
                float x1 = bf1(ur[1152 + part * 16 + i]), x2 = bf1(ur[1152 + part * 16 + 8 + i]);
                int b, kk; row_bk(row, b, kk);
                if (row < NLAT) { const int t = row & 4095, pos = part ? (t & 63) : (t >> 6); const float c = ROPE_TAB[(pos * 8 + i) * 2], s = ROPE_TAB[(pos * 8 + i) * 2 + 1];
                    const float a = x1 * c - x2 * s, bb = x1 * s + x2 * c; x1 = a; x2 = bb; }
                const unsigned w = pk2(x1, x2);
#pragma unroll
                for (int h = 0; h < 4; ++h) *(unsigned*)(KM + ((size_t)((b * 4 + h) * KEYS + kk)) * 96 + 64 + part * 16 + 2 * i) = w; }
        }
    }
    {
        LAS float* Z = (LAS float*)F.lds;
        LAS float* YL = (LAS float*)(F.lds + 62 * 1024);
        bf16* SCF = (bf16*)(ws_ + WS_SCF);
        const float* wdw = fin(F, 13) + (size_t)L * 31 * 256; const float* bdw = fin(F, 14) + L * 256; const float* lng = fin(F, 15) + L * 256; const float* lnb = fin(F, 16) + L * 256;
        for (int tile = F.vcu; tile < MALL / 32; tile += F.G) {
            const int row0 = tile * 32;
            int t0, len, base; if (row0 < NLAT) { t0 = row0 & 4095; len = 4096; base = row0 - t0; } else { t0 = (row0 - NLAT) & 255; len = 256; base = row0 - t0; }
            __syncthreads();
            for (int idx = F.tid; idx < 62 * 32; idx += 512) { const int tt = idx >> 5, c8 = idx & 31; const int tp = t0 + tt - 15;
                float z[8];
                if (tp >= 0 && tp < len) { const bf16* ur = U + (size_t)(base + tp) * PINP + 1184 + c8 * 8;
                    const v4u a = *(const GAS v4u*)ur, gg = *(const GAS v4u*)(ur + 256);
                    z[0] = bflo(a.x) * sigmoidf_(bflo(gg.x)); z[1] = bfhi(a.x) * sigmoidf_(bfhi(gg.x)); z[2] = bflo(a.y) * sigmoidf_(bflo(gg.y)); z[3] = bfhi(a.y) * sigmoidf_(bfhi(gg.y));
                    z[4] = bflo(a.z) * sigmoidf_(bflo(gg.z)); z[5] = bfhi(a.z) * sigmoidf_(bfhi(gg.z)); z[6] = bflo(a.w) * sigmoidf_(bflo(gg.w)); z[7] = bfhi(a.w) * sigmoidf_(bfhi(gg.w));
                } else {
#pragma unroll
                    for (int e = 0; e < 8; ++e) z[e] = 0.f; }
                *(LAS f32x4*)(Z + tt * 256 + c8 * 8) = (f32x4){z[0], z[1], z[2], z[3]}; *(LAS f32x4*)(Z + tt * 256 + c8 * 8 + 4) = (f32x4){z[4], z[5], z[6], z[7]}; }
            __syncthreads();
            { const int c = F.tid & 255, half = F.tid >> 8; const float bias = bdw[c];
                float acc[16];
#pragma unroll
                for (int i = 0; i < 16; ++i) acc[i] = bias;
                for (int k = 0; k < 31; ++k) { const float w = wdw[k * 256 + c];
#pragma unroll
                    for (int i = 0; i < 16; ++i) acc[i] += w * Z[(half * 16 + i + k) * 256 + c]; }
#pragma unroll
                for (int i = 0; i < 16; ++i) YL[(half * 16 + i) * 256 + c] = acc[i]; }
            __syncthreads();
#pragma unroll
            for (int q = 0; q < 4; ++q) { const int tok = F.wave * 4 + q;
                const f32x4 v = *(const LAS f32x4*)(YL + tok * 256 + F.lane * 4);
                const float mean = wave_sum((v.x + v.y) + (v.z + v.w)) * (1.0f / 256.0f);
                const f32x4 dv = v - mean;
                const float var = wave_sum((dv.x * dv.x + dv.y * dv.y) + (dv.z * dv.z + dv.w * dv.w)) * (1.0f / 256.0f);
                const float rs = 1.0f / sqrtf(var + EPS);
                const f32x4 gv = *(const f32x4*)(lng + F.lane * 4), bv = *(const f32x4*)(lnb + F.lane * 4);
                f32x4 o = dv * rs * gv + bv;
                o.x = o.x * sigmoidf_(o.x); o.y = o.y * sigmoidf_(o.y); o.z = o.z * sigmoidf_(o.z); o.w = o.w * sigmoidf_(o.w);
                v2u w; w.x = pk2(o.x, o.y); w.y = pk2(o.z, o.w);
                *(GAS v2u*)(SCF + (size_t)(row0 + tok) * 256 + F.lane * 4) = w; }
        }
        __syncthreads();
    }
    {
        const int gw = F.vcu * NWAVES + F.wave, NGW = F.G * NWAVES;
        bf16* NVT = (bf16*)(ws_ + WS_NVT);
        for (int task = gw; task < (MALL / 64) * 32; task += NGW) {
            const int kb = task >> 5, ch = task & 31, h = ch >> 3, dv0 = (ch & 7) * 8;
            const int row = kb * 64 + F.lane; int b, kk; row_bk(row, b, kk);
            const v4u w = *(const GAS v4u*)(U + (size_t)row * PINP + 2208 + ch * 8);
            GAS bf16* vp = (GAS bf16*)(NVT + ((size_t)((b * 4 + h) * 64 + dv0)) * KEYS + kk);
            vp[0 * KEYS] = (bf16)(w.x & 0xffffu); vp[1 * KEYS] = (bf16)(w.x >> 16); vp[2 * KEYS] = (bf16)(w.y & 0xffffu); vp[3 * KEYS] = (bf16)(w.y >> 16);
            vp[4 * KEYS] = (bf16)(w.z & 0xffffu); vp[5 * KEYS] = (bf16)(w.z >> 16); vp[6 * KEYS] = (bf16)(w.w & 0xffffu); vp[7 * KEYS] = (bf16)(w.w >> 16);
        }
    }
}

__device__ __forceinline__ void pass_attn(Frame& F, int L) {
    unsigned char* const ws_ = wsl(F);
    const bf16* U = (const bf16*)(ws_ + WS_U); bf16* Y = (bf16*)(ws_ + WS_Y);
    const bf16* QM = (const bf16*)(ws_ + WS_QM); const bf16* KM = (const bf16*)(ws_ + WS_KM); const bf16* VTM = (const bf16*)(ws_ + WS_VTM); const bf16* NVT = (const bf16*)(ws_ + WS_NVT);
    for (int u = F.vcu; u < 256; u += F.G) {
        const int b = u >> 6, h = (u >> 4) & 3, qb = u & 15; const int row = b * 4096 + qb * 256 + F.wave * 32;
        AttnDesc d; d.q = QM + (size_t)row * 384 + h * 96; d.qpitch = 384; d.o = Y + (size_t)row * DM + 256 + h * 64;
        d.k0 = KM + (size_t)((b * 4 + h) * KEYS) * 96; d.k1 = d.k0; d.kpitch = 96; d.nseg0 = 68; d.nt = 68;
        d.v0 = VTM + (size_t)((b * 4 + h) * 64) * KEYS; d.v1 = d.v0; d.cq = 0; d.offr0 = 0; d.rpb = nullptr;
        attn_mla(F.lds, d, F.tid);
    }
    {
        LAS float* RP = (LAS float*)(F.lds + 4 * (64 * 72 * 2 + 64 * 68 * 2));
        const float* rpb = fin(F, 18) + (size_t)L * 4 * 15 * 31;
        __syncthreads();
        for (int i = F.tid; i < 4 * 15 * 31; i += 512) RP[i] = rpb[i] * LOG2E;
        for (int u = F.vcu; u < 256; u += F.G) {
            const int b = u >> 6, r = u & 63, h = F.wave >> 1, half = F.wave & 1; const int row = b * 4096 + r * 64 + half * 32;
            const int rs = min(max(r - 4, 0), 56);
            AttnDesc d; d.q = U + (size_t)row * PINP + 1696 + h * 64; d.qpitch = PINP; d.o = Y + (size_t)row * DM + 768 + h * 64;
            d.k0 = U + (size_t)(b * 4096 + rs * 64) * PINP + 1952 + h * 64; d.k1 = U + (size_t)(NLAT + b * 256) * PINP + 1952 + h * 64; d.kpitch = PINP; d.nseg0 = 8; d.nt = 12;
            d.v0 = NVT + (size_t)((b * 4 + h) * 64) * KEYS + rs * 64; d.v1 = NVT + (size_t)((b * 4 + h) * 64) * KEYS + 4096;
            d.cq = half * 32; d.offr0 = rs - r + 7; d.rpb = RP + h * 465;
            attn_unit<64, 4, 2>(F.lds, d, F.tid);
        }
    }
    if (L == 0) {
        for (int u = F.vcu; u < 32; u += F.G) {
            const int bh = u & 15, b = bh >> 2, h = bh & 3; const int row = NLAT + b * 256 + F.wave * 32;
            AttnDesc d; d.cq = 0; d.offr0 = 0; d.rpb = nullptr; d.nseg0 = 4; d.nt = 4;
            if (u < 16) {
                d.q = QM + (size_t)row * 384 + h * 96; d.qpitch = 384; d.o = Y + (size_t)row * DM + 256 + h * 64;
                d.k0 = KM + (size_t)((b * 4 + h) * KEYS + 4096) * 96; d.k1 = d.k0; d.kpitch = 96;
                d.v0 = VTM + (size_t)((b * 4 + h) * 64) * KEYS + 4096; d.v1 = d.v0;
                attn_mla(F.lds, d, F.tid);
            } else {
                d.q = U + (size_t)row * PINP + 1696 + h * 64; d.qpitch = PINP; d.o = Y + (size_t)row * DM + 768 + h * 64;
                d.k0 = U + (size_t)(NLAT + b * 256) * PINP + 1952 + h * 64; d.k1 = d.k0; d.kpitch = PINP;
                d.v0 = NVT + (size_t)((b * 4 + h) * 64) * KEYS + 4096; d.v1 = d.v0;
                attn_unit<64, 1, 1>(F.lds, d, F.tid);
            }
        }
    }
    __syncthreads();
}

__global__ void __launch_bounds__(NWAVES * 64, 2) hybrid_fwd(Args args) {
    extern __shared__ __attribute__((aligned(16))) unsigned char lds[];
    Frame F0;
    F0.lds = (LAS unsigned char*)lds;
    F0.tid = 0; F0.lane = 0; F0.wave = __builtin_amdgcn_readfirstlane((int)threadIdx.x >> 6);
    F0.G = gridDim.x; { const int bx = blockIdx.x; F0.vcu = (F0.G % 8 == 0) ? (bx % 8) * (F0.G / 8) + bx / 8 : bx; }
    F0.ws = args.ws;
    if (args.never) cooperative_groups::this_grid().sync();
    volatile LAS unsigned* MISC = (volatile LAS unsigned*)(F0.lds + MISC_OFF);
    for (int u = threadIdx.x; u < (LDS_BYTES - RING_BYTES) / 4; u += NWAVES * 64) ((LAS unsigned*)(F0.lds + RING_BYTES))[u] = 0u;
    __syncthreads();
    if (threadIdx.x == 0) { LAS unsigned* t = (LAS unsigned*)(F0.lds + PTAB_OFF);
#pragma unroll
        for (int i = 0; i < 25; ++i) { const unsigned long long p = (unsigned long long)args.in[i]; t[2 * i] = (unsigned)p; t[2 * i + 1] = (unsigned)(p >> 32); }
        const unsigned long long po = (unsigned long long)args.out; t[50] = (unsigned)po; t[51] = (unsigned)(po >> 32); }
    __syncthreads();
    unsigned* ctl = (unsigned*)(F0.ws + WS_CTL);
    XcdBarrier bar = xcd_barrier_post(ctl + CW_BAR, MISC + 8); bar.w0 = (F0.wave == 0) ? 1u : 0u;
#define GRID_BAR() xcd_barrier(bar)
    const int bx0 = (int)blockIdx.x;

#define MKFRAME() Frame F = F0; int bx = bx0; { unsigned z_ = 0u; asm volatile("" : "+v"(z_)); const int t_ = (F0.wave << 6) | (int)__builtin_amdgcn_mbcnt_hi(~0u, __builtin_amdgcn_mbcnt_lo(~0u, z_)); F.tid = t_; F.lane = t_ & 63; } \
        asm volatile("" : "+s"(F.wave), "+s"(F.vcu), "+s"(F.G), "+s"(F.ws), "+s"(bx)); LAS unsigned char* ring = F.lds; (void)ring; (void)bx
    constexpr int NPH = 20;
#pragma nounroll
    for (int ph = 0; ph < NPH; ++ph) {
        const int kind = ph < 2 ? ph : 2 + (ph - 2) % 9, L = ph < 2 ? 0 : (ph - 2) / 9;
        const int MR = (L == 0) ? MALL : NLAT;
        if (kind == 0) { MKFRAME(); mod_gemv(F); convert_weights(F, 0); }
        if (kind == 1) { MKFRAME(); pass_prep(F, 0); }
        if (kind == 3) { MKFRAME(); pass_mix(F, L); }
        if (kind == 4) {
            MKFRAME(); unsigned char* const ws_ = wsl(F);
            { pg8::Gemm g{(const pg8::bf16_t*)(ws_ + WS_U) + 768, (const pg8::bf16_t*)(ws_ + WS_WUQ), MALL, 512, 256, PINP, 256}; pg8::StaticOrder S; S.init(MALL, 512, F.G, bx);
              pg8::EpiUQ E{(pg8::bf16_t*)(ws_ + WS_QM), (const float*)(ws_ + WS_RSQ), ROPE_TAB, QSCALE};
              pg8::gemm_phase<pg8::EpiUQ, pg8::StaticOrder, true, true>(ring, g, S, E, F.tid); }
            { pg8::Gemm g{(const pg8::bf16_t*)(ws_ + WS_U) + 1024, (const pg8::bf16_t*)(ws_ + WS_WUKV), MALL, 512, 256, PINP, 256}; pg8::StaticOrder S; S.init(MALL, 512, F.G, (bx + 136) % F.G);
              pg8::EpiUKV E{(pg8::bf16_t*)(ws_ + WS_KM), (pg8::bf16_t*)(ws_ + WS_VTM), (const float*)(ws_ + WS_RSKV)};
              pg8::gemm_phase<pg8::EpiUKV, pg8::StaticOrder, true, true>(ring, g, S, E, F.tid); }
        }
        if (kind == 2 || kind == 4 || kind == 6 || kind == 8 || kind == 9) {
            MKFRAME(); unsigned char* const ws_ = wsl(F);
            pg8::Gemm g; pg8::EpiBf16 E; int c = bx;
            if (kind == 2) { g = pg8::Gemm{(const pg8::bf16_t*)(ws_ + WS_R1), (const pg8::bf16_t*)(ws_ + WS_WIN), MALL, PINP, DM, 2048, DM}; E = pg8::EpiBf16{(pg8::bf16_t*)(ws_ + WS_U), PINP, 0}; }
            else if (kind == 4) { g = pg8::Gemm{(const pg8::bf16_t*)(ws_ + WS_SCF), (const pg8::bf16_t*)(ws_ + WS_WPW), MALL, 256, 256, 256, 256}; E = pg8::EpiBf16{(pg8::bf16_t*)(ws_ + WS_Y) + 512, DM, 0}; c = (bx + 16) % F.G; }
            else if (kind == 6) { g = pg8::Gemm{(const pg8::bf16_t*)(ws_ + WS_Y), (const pg8::bf16_t*)(ws_ + WS_WOUT), NLAT, DM, DM, DM, DM}; E = pg8::EpiBf16{(pg8::bf16_t*)(ws_ + WS_R1), 2048, 0}; }
            else if (kind == 8) { g = pg8::Gemm{(const pg8::bf16_t*)(ws_ + WS_R1), (const pg8::bf16_t*)(ws_ + WS_W1), MR, FF, DM, 2048, DM}; E = pg8::EpiBf16{(pg8::bf16_t*)(ws_ + WS_A1), FF, 2}; }
            else { g = pg8::Gemm{(const pg8::bf16_t*)(ws_ + WS_A1), (const pg8::bf16_t*)(ws_ + WS_W2), NLAT, DM, FF, FF, FF}; E = pg8::EpiBf16{(pg8::bf16_t*)(ws_ + WS_R1), 2048, 0}; }
            pg8::StaticOrder S; S.init(g.M, g.N, F.G, c);
            pg8::gemm_phase<pg8::EpiBf16, pg8::StaticOrder, true, true>(ring, g, S, E, F.tid);
        }
        if (kind == 5) { MKFRAME(); pass_attn(F, L); }
        if ((kind == 6 || kind == 9) && L == 0) {
            MKFRAME(); unsigned char* const ws_ = wsl(F);
            const int K = (kind == 6) ? DM : FF;
            const int u = bx >> 2, slice = bx & 3, ks = K >> 2;
            pg8::OneUnit S1{64 + (u >> 2), u & 3, u < 16 ? 1 : 0};
            pg8::Gemm g2;
            if (kind == 6) g2 = pg8::Gemm{(const pg8::bf16_t*)(ws_ + WS_Y) + slice * ks, (const pg8::bf16_t*)(ws_ + WS_WOUT) + slice * ks, MALL, DM, ks, DM, DM};
            else g2 = pg8::Gemm{(const pg8::bf16_t*)(ws_ + WS_A1) + slice * ks, (const pg8::bf16_t*)(ws_ + WS_W2) + slice * ks, MALL, DM, ks, FF, FF};
            float* Cc = (float*)(ws_ + (kind == 6 ? WS_U : WS_KM)) + (size_t)slice * NCTXR * DM;
            pg8::EpiF32 E2{Cc - (size_t)NLAT * DM, DM};
            pg8::gemm_phase<pg8::EpiF32, pg8::OneUnit, true, true>(ring, g2, S1, E2, F.tid);
        }
        if (kind == 7) { MKFRAME(); pass_postwo(F, L, MR); }
        if (kind == 10) { MKFRAME(); pass_postmlp(F, L, MR); if (L == 0) convert_weights(F, 1); }
        if (ph + 1 < NPH) GRID_BAR();
    }
#undef GRID_BAR
}

extern "C" void kernel_launch(void* const* d_in, const int* in_sizes, int n_in, void* d_out, int out_size, void* d_ws, size_t ws_size, hipStream_t stream) {
    static int grid = 0;
    if (grid == 0) {
        if (n_in != 25 || out_size != NLAT * DM || ws_size < 256 * MiB) { fprintf(stderr, "kernel_launch: unexpected shapes (n_in %d out %d ws %zu)\n", n_in, out_size, ws_size); grid = -1; return; }
        int dev = 0, cus = 0;
        if (hipGetDevice(&dev) != hipSuccess || hipDeviceGetAttribute(&cus, hipDeviceAttributeMultiprocessorCount, dev) != hipSuccess) { grid = -1; return; }
        if (hipFuncSetAttribute((const void*)hybrid_fwd, hipFuncAttributeMaxDynamicSharedMemorySize, LDS_BYTES) != hipSuccess) { fprintf(stderr, "kernel_launch: hipFuncSetAttribute failed\n"); grid = -1; return; }
        (void)hipGetLastError();
        grid = cus;
    }
    if (grid < 0) return;
    if (hipMemsetAsync((char*)d_ws + WS_CTL, 0, CTL_ZERO_BYTES, stream) != hipSuccess) { fprintf(stderr, "kernel_launch: memset failed\n"); return; }
    Args a{};
    for (int i = 0; i < 25; ++i) a.in[i] = (const float*)d_in[i];
    a.out = (float*)d_out; a.ws = (unsigned char*)d_ws; a.never = 0; a.pad = 0;
    void* kargs[] = {&a};
    hipError_t e = hipLaunchCooperativeKernel((const void*)hybrid_fwd, dim3(grid), dim3(NWAVES * 64), kargs, LDS_BYTES, stream);
    if (e != hipSuccess) fprintf(stderr, "kernel_launch: cooperative launch failed: %s (grid %d)\n", hipGetErrorString(e), grid);
}
```
